# Optimizing an MI355X kernel written in HIP

```python
import jax
import jax.numpy as jnp
from jax import lax
import numpy as np

D_MODEL = 1024
BATCH = 32
SEQ = 2048
DEPTH = 4

MEM_LEN = 256
NORM_EPS = 1e-6
D_FF = 2816
A_HEADS = 8
A_HEAD_DIM = 64
A_WIDTH = A_HEADS * A_HEAD_DIM
A_RANK_W = 64
A_RANK_A = 64
A_RANK_G = 128
A_LN_EPS = 64e-5
B_HEADS = 8
B_QK_DIM = 64
B_V_DIM = 128
B_QK_WIDTH = B_HEADS * B_QK_DIM
B_V_WIDTH = B_HEADS * B_V_DIM
B_CHUNK = 128
B_GN_EPS = 1e-5
ROPE_BASE = 10000.0
X_HEADS = 4
X_HEAD_DIM = D_MODEL // X_HEADS
A_SHIFT_SIZES = (A_WIDTH, A_WIDTH, A_WIDTH, A_RANK_W, A_RANK_A, A_RANK_G)
A_SHIFT_WIDTH = sum(A_SHIFT_SIZES)
B_SIZES = (B_QK_WIDTH, B_QK_WIDTH, B_V_WIDTH, B_V_WIDTH)
B_IN_WIDTH = sum(B_SIZES)
IN_WIDTH = A_SHIFT_WIDTH + B_IN_WIDTH + 2 * D_MODEL

kernel_name = "hybrid_rwkv7_retention_macaron"


def _split(z, sizes):
    return jnp.split(z, [int(s) for s in np.cumsum(sizes)[:-1]], axis=-1)


def rms_norm(x, g):
    xf = x.astype(jnp.float32)
    y = xf * lax.rsqrt(jnp.mean(xf * xf, axis=-1, keepdims=True) + NORM_EPS)
    return (y * g.astype(jnp.float32)).astype(x.dtype)


def _standardize(x, eps):
    mu = jnp.mean(x, axis=-1, keepdims=True)
    xc = x - mu
    return xc * lax.rsqrt(jnp.mean(xc * xc, axis=-1, keepdims=True) + eps)


def swiglu_ffn(x, w_in, w_out):
    gate, up = jnp.split(x @ w_in, 2, axis=-1)
    return (jax.nn.silu(gate) * up) @ w_out


def token_shift(z):
    return jnp.pad(z[:, :-1], ((0, 0), (1, 0), (0, 0)))


def rotary(x, positions):
    half = x.shape[-1] // 2
    inv_freq = ROPE_BASE ** (-jnp.arange(half, dtype=jnp.float32) / half)
    ang = positions.astype(jnp.float32)[:, :, None] * inv_freq
    cos = jnp.cos(ang)[:, :, None, :]
    sin = jnp.sin(ang)[:, :, None, :]
    x1, x2 = x[..., :half], x[..., half:]
    return jnp.concatenate([x1 * cos - x2 * sin, x1 * sin + x2 * cos], axis=-1)


def rwkv7_scan(r, decay, k, v, kk, a):
    B, T, H, N = r.shape

    def step(S, inp):
        r_t, w_t, k_t, v_t, kk_t, a_t = inp
        sa = jnp.einsum('bhij,bhj->bhi', S, -kk_t)
        S = (S * w_t[:, :, None, :]
             + sa[..., None] * (kk_t * a_t)[:, :, None, :]
             + v_t[..., None] * k_t[:, :, None, :])
        return S, jnp.einsum('bhij,bhj->bhi', S, r_t)

    xs = tuple(jnp.moveaxis(t, 1, 0) for t in (r, decay, k, v, kk, a))
    _, y = lax.scan(step, jnp.zeros((B, H, N, N), jnp.float32), xs)
    return jnp.moveaxis(y, 0, 1)


def rwkv7_time_mix(z_a, w0, w_up, a0, a_up, g_up, k_k, k_a, r_k, ln):
    B, T, _ = z_a.shape
    dtype = z_a.dtype
    f32 = jnp.float32
    r, k, v, w_lo, a_lo, g_lo = _split(z_a.astype(f32), A_SHIFT_SIZES)
    w = w0.astype(f32) + jnp.tanh(w_lo) @ w_up.astype(f32)
    decay = jnp.exp(-jnp.exp(-jax.nn.softplus(-w) - 0.5))
    a = jax.nn.sigmoid(a0.astype(f32) + a_lo @ a_up.astype(f32))
    g = jax.nn.sigmoid(g_lo) @ g_up.astype(f32)

    def heads(t):
        return t.reshape(B, T, A_HEADS, A_HEAD_DIM)

    kk = heads(k * k_k.astype(f32))
    kk = kk / jnp.maximum(jnp.sqrt(jnp.sum(kk * kk, axis=-1, keepdims=True)), 1e-12)
    k = k * (1.0 + (a - 1.0) * k_a.astype(f32))
    rh, kh, vh = heads(r), heads(k), heads(v)
    y = rwkv7_scan(rh, heads(decay), kh, vh, kk, heads(a))
    ln = ln.astype(f32)
    y = _standardize(y, A_LN_EPS).reshape(B, T, A_WIDTH) * ln[0] + ln[1]
    bonus = jnp.sum(rh * kh * r_k.astype(f32), axis=-1, keepdims=True) * vh
    y = y + bonus.reshape(B, T, A_WIDTH)
    return (y * g).astype(dtype)


def retention_chunkwise(q, k, v):
    B, T, H, dk = q.shape
    dv = v.shape[-1]
    C = B_CHUNK
    nc = T // C
    log_gamma = jnp.log1p(-jnp.exp2(-5.0 - jnp.arange(H, dtype=jnp.float32)))
    qc = q.reshape(B, nc, C, H, dk)
    kc = k.reshape(B, nc, C, H, dk)
    vc = v.reshape(B, nc, C, H, dv)
    pos = jnp.arange(C, dtype=jnp.float32)
    diff = pos[:, None] - pos[None, :]
    inner_decay = jnp.where(diff[None] >= 0,
                            jnp.exp(jnp.maximum(diff, 0.0)[None] * log_gamma[:, None, None]),
                            0.0)
    scores = jnp.einsum('bnchd,bnshd->bnhcs', qc, kc) * inner_decay[None, None]
    inner = jnp.einsum('bnhcs,bnshe->bnche', scores, vc)
    q_decay = jnp.exp((pos + 1.0)[None, :] * log_gamma[:, None])
    k_decay = jnp.exp((C - 1.0 - pos)[None, :] * log_gamma[:, None])
    chunk_decay = jnp.exp(C * log_gamma)
    kv = jnp.einsum('bnshd,bnshe->bnhde', kc * k_decay.T[None, None, :, :, None], vc)

    def step(R, kv_n):
        return R * chunk_decay[None, :, None, None] + kv_n, R

    _, r_prev = lax.scan(step, jnp.zeros((B, H, dk, dv), jnp.float32), jnp.moveaxis(kv, 1, 0))
    r_prev = jnp.moveaxis(r_prev, 0, 1)
    cross = jnp.einsum('bnchd,bnhde->bnche', qc * q_decay.T[None, None, :, :, None], r_prev)
    return (inner + cross).reshape(B, T, H, dv)


def retention_mix(z_b, positions, gn):
    B, T, _ = z_b.shape
    dtype = z_b.dtype
    q, k, v, g = _split(z_b.astype(jnp.float32), B_SIZES)
    qh = rotary(q.reshape(B, T, B_HEADS, B_QK_DIM), positions)
    kh = rotary(k.reshape(B, T, B_HEADS, B_QK_DIM), positions) * (B_QK_DIM ** -0.5)
    y = retention_chunkwise(qh, kh, v.reshape(B, T, B_HEADS, B_V_DIM))
    y = _standardize(y, B_GN_EPS).reshape(B, T, B_V_WIDTH) * gn.astype(jnp.float32)
    return (y * jax.nn.silu(g)).astype(dtype)


def memory_cross_attn(hn, mem, mem_g, w_q, w_kv, w_o):
    B, T, _ = hn.shape
    q = (hn @ w_q).reshape(B, T, X_HEADS, X_HEAD_DIM)
    k, v = jnp.split(rms_norm(mem, mem_g) @ w_kv, 2, axis=-1)
    k = k.reshape(B, MEM_LEN, X_HEADS, X_HEAD_DIM)
    v = v.reshape(B, MEM_LEN, X_HEADS, X_HEAD_DIM)
    s = jnp.einsum('bthd,bmhd->bhtm', q, k).astype(jnp.float32) * (X_HEAD_DIM ** -0.5)
    p = jax.nn.softmax(s, axis=-1).astype(v.dtype)
    o = jnp.einsum('bhtm,bmhd->bthd', p, v).reshape(B, T, D_MODEL)
    return o @ w_o


def setup_inputs(seed: int = 0) -> dict:
    key = jax.random.key(seed)
    ks = jax.random.split(key, 32)
    f32 = jnp.float32

    def nrm(k, shape, scale):
        return jax.random.normal(k, shape, f32) * scale

    x = nrm(ks[0], (BATCH, SEQ, D_MODEL), 1.0)
    mem = nrm(ks[1], (BATCH, MEM_LEN, D_MODEL), 1.0)
    offset = jax.random.randint(ks[2], (BATCH, 1), 0, 4096, dtype=jnp.int32)
    positions = offset + jnp.arange(SEQ, dtype=jnp.int32)[None, :]
    return {
        "x": x,
        "mem": mem,
        "positions": positions,
        "norm_g": 1.0 + nrm(ks[3], (DEPTH, 4, D_MODEL), 0.02),
        "ffn_w_in": nrm(ks[4], (DEPTH, 2, D_MODEL, 2 * D_FF), D_MODEL ** -0.5),
        "ffn_w_out": nrm(ks[5], (DEPTH, 2, D_FF, D_MODEL), 0.5 * D_FF ** -0.5),
        "mix_w_in": nrm(ks[6], (DEPTH, D_MODEL, IN_WIDTH), D_MODEL ** -0.5),
        "mix_gate_b": nrm(ks[7], (DEPTH, 2, D_MODEL), 0.02),
        "shift_mu": jax.random.uniform(ks[8], (DEPTH, A_SHIFT_WIDTH), f32),
        "a_w0": jax.random.uniform(ks[9], (DEPTH, A_WIDTH), f32, -6.0, -1.0),
        "a_w_up": nrm(ks[10], (DEPTH, A_RANK_W, A_WIDTH), 0.1 * A_RANK_W ** -0.5),
        "a_a0": nrm(ks[11], (DEPTH, A_WIDTH), 0.1),
        "a_a_up": nrm(ks[12], (DEPTH, A_RANK_A, A_WIDTH), 0.1 * A_RANK_A ** -0.5),
        "a_g_up": nrm(ks[13], (DEPTH, A_RANK_G, A_WIDTH), A_RANK_G ** -0.5),
        "a_k_k": 0.85 + nrm(ks[14], (DEPTH, A_WIDTH), 0.05),
        "a_k_a": 1.0 + nrm(ks[15], (DEPTH, A_WIDTH), 0.05),
        "a_r_k": nrm(ks[16], (DEPTH, A_HEADS, A_HEAD_DIM), 0.1),
        "a_ln": jnp.stack([1.0 + nrm(ks[17], (DEPTH, A_WIDTH), 0.02),
                           nrm(ks[18], (DEPTH, A_WIDTH), 0.02)], axis=1),
        "b_gn": 1.0 + nrm(ks[19], (DEPTH, B_V_WIDTH), 0.02),
        "w_branch_a": nrm(ks[20], (DEPTH, A_WIDTH, D_MODEL), A_WIDTH ** -0.5),
        "w_branch_b": nrm(ks[21], (DEPTH, B_V_WIDTH, D_MODEL), B_V_WIDTH ** -0.5),
        "mix_w_out": nrm(ks[22], (DEPTH, D_MODEL, D_MODEL), 0.5 * D_MODEL ** -0.5),
        "mem_norm": 1.0 + nrm(ks[23], (DEPTH, D_MODEL), 0.02),
        "cross_w_q": nrm(ks[24], (DEPTH, D_MODEL, D_MODEL), D_MODEL ** -0.5),
        "cross_w_kv": nrm(ks[25], (DEPTH, D_MODEL, 2 * D_MODEL), D_MODEL ** -0.5),
        "cross_w_o": nrm(ks[26], (DEPTH, D_MODEL, D_MODEL), 0.5 * D_MODEL ** -0.5),
        "final_norm": 1.0 + nrm(ks[27], (D_MODEL,), 0.02),
    }


def reference(x, mem, positions, norm_g, ffn_w_in, ffn_w_out, mix_w_in, mix_gate_b, shift_mu,
              a_w0, a_w_up, a_a0, a_a_up, a_g_up, a_k_k, a_k_a, a_r_k, a_ln, b_gn,
              w_branch_a, w_branch_b, mix_w_out, mem_norm, cross_w_q, cross_w_kv, cross_w_o,
              final_norm):
    h = x
    for l in range(DEPTH):
        h = h + 0.5 * swiglu_ffn(rms_norm(h, norm_g[l, 0]), ffn_w_in[l, 0], ffn_w_out[l, 0])
        u = rms_norm(h, norm_g[l, 1])
        z = u @ mix_w_in[l]
        z_a = z[..., :A_SHIFT_WIDTH]
        z_a = z_a + (token_shift(z_a) - z_a) * shift_mu[l]
        z_b = z[..., A_SHIFT_WIDTH:A_SHIFT_WIDTH + B_IN_WIDTH]
        g_pre = z[..., A_SHIFT_WIDTH + B_IN_WIDTH:]
        y_a = rwkv7_time_mix(z_a, a_w0[l], a_w_up[l], a_a0[l], a_a_up[l], a_g_up[l],
                             a_k_k[l], a_k_a[l], a_r_k[l], a_ln[l])
        y_b = retention_mix(z_b, positions, b_gn[l])
        gates = jax.nn.sigmoid(g_pre.astype(jnp.float32)
                               + mix_gate_b[l].reshape(-1).astype(jnp.float32)).astype(h.dtype)
        gate_a, gate_b = jnp.split(gates, 2, axis=-1)
        merged = gate_a * (y_a @ w_branch_a[l]) + gate_b * (y_b @ w_branch_b[l])
        h = h + merged @ mix_w_out[l]
        h = h + memory_cross_attn(rms_norm(h, norm_g[l, 2]), mem, mem_norm[l],
                                  cross_w_q[l], cross_w_kv[l], cross_w_o[l])
        h = h + 0.5 * swiglu_ffn(rms_norm(h, norm_g[l, 3]), ffn_w_in[l, 1], ffn_w_out[l, 1])
    return rms_norm(h, final_norm)
```

```cpp
#include <hip/hip_runtime.h>
#include <cstdio>
#include <cstdint>

#define GAS __attribute__((address_space(1)))
#define LAS __attribute__((address_space(3)))
#define CAS __attribute__((address_space(4)))
typedef unsigned short u16;
typedef _Float16 h16x8 __attribute__((ext_vector_type(8)));
typedef _Float16 h16x4 __attribute__((ext_vector_type(4)));
typedef _Float16 h16x2 __attribute__((ext_vector_type(2)));
typedef float f32x4 __attribute__((ext_vector_type(4)));
typedef float f32x2 __attribute__((ext_vector_type(2)));
typedef unsigned u32x4 __attribute__((ext_vector_type(4)));
typedef unsigned u32x2 __attribute__((ext_vector_type(2)));

__device__ __forceinline__ unsigned pk2(float lo, float hi) { f32x2 v = {lo, hi}; h16x2 h = __builtin_convertvector(v, h16x2); return __builtin_bit_cast(unsigned, h); }
__device__ __forceinline__ u16 f2h(float f) { _Float16 h = (_Float16)f; return __builtin_bit_cast(u16, h); }
__device__ __forceinline__ float h2f(u16 u) { return (float)__builtin_bit_cast(_Float16, u); }
__device__ __forceinline__ float hlo(unsigned u) { return (float)__builtin_bit_cast(h16x2, u)[0]; }
__device__ __forceinline__ float hhi(unsigned u) { return (float)__builtin_bit_cast(h16x2, u)[1]; }
__device__ __forceinline__ float fsigmoid(float x) { return __builtin_amdgcn_rcpf(1.0f + __builtin_amdgcn_exp2f(-1.44269504089f * x)); }
__device__ __forceinline__ float fsilu(float x) { return x * fsigmoid(x); }
#define DPP_ADD_(v, ctrl, rmask) (v) += __builtin_bit_cast(float, __builtin_amdgcn_update_dpp(0, __builtin_bit_cast(int, (v)), (ctrl), (rmask), 0xf, false))
__device__ __forceinline__ float sum16(float v) {
    DPP_ADD_(v, 0xB1, 0xf); DPP_ADD_(v, 0x4E, 0xf); DPP_ADD_(v, 0x141, 0xf); DPP_ADD_(v, 0x140, 0xf); return v; }
__device__ __forceinline__ float wave_sum(float v) {
    v = sum16(v); DPP_ADD_(v, 0x142, 0xa); DPP_ADD_(v, 0x143, 0xc);
    return __builtin_bit_cast(float, __builtin_amdgcn_readlane(__builtin_bit_cast(int, v), 63)); }
__device__ __forceinline__ float xsum32(float v) {
    const unsigned u = __builtin_bit_cast(unsigned, v); auto r = __builtin_amdgcn_permlane32_swap(u, u, false, false); const unsigned a = r[0], b = r[1];
    return __builtin_bit_cast(float, a) + __builtin_bit_cast(float, b); }
__device__ __forceinline__ float xsum16(float v) {
    const unsigned u = __builtin_bit_cast(unsigned, v); auto r = __builtin_amdgcn_permlane16_swap(u, u, false, false); const unsigned a = r[0], b = r[1];
    return __builtin_bit_cast(float, a) + __builtin_bit_cast(float, b); }
__device__ __forceinline__ void pair16(float& a, float& b) {
    auto r = __builtin_amdgcn_permlane16_swap(__builtin_bit_cast(unsigned, a), __builtin_bit_cast(unsigned, b), false, false); const unsigned x = r[0], y = r[1];
    a = __builtin_bit_cast(float, x); b = __builtin_bit_cast(float, y); }
__device__ __forceinline__ float xmax32(float v) { const unsigned u = __builtin_bit_cast(unsigned, v); auto r = __builtin_amdgcn_permlane32_swap(u, u, false, false); const unsigned a = r[0], b = r[1];
    return fmaxf(__builtin_bit_cast(float, a), __builtin_bit_cast(float, b)); }
__device__ __forceinline__ float xmax16(float v) { const unsigned u = __builtin_bit_cast(unsigned, v); auto r = __builtin_amdgcn_permlane16_swap(u, u, false, false); const unsigned a = r[0], b = r[1];
    return fmaxf(__builtin_bit_cast(float, a), __builtin_bit_cast(float, b)); }
__device__ __forceinline__ int fresh_tid() { int t = threadIdx.x; asm volatile("" : "+v"(t)); return t; }
#define MFMA16(a, b, c) __builtin_amdgcn_mfma_f32_16x16x32_f16((a), (b), (c), 0, 0, 0)
typedef short s16x4 __attribute__((ext_vector_type(4)));
typedef short s16x8 __attribute__((ext_vector_type(8)));
__device__ __forceinline__ h16x8 lds_tr16(const __attribute__((address_space(3))) unsigned short* img, int pitch, int k0, int n0, int lane) {
    const int g = lane >> 4, q = (lane & 15) >> 2, p = lane & 3;
    const __attribute__((address_space(3))) unsigned short* a = img + (k0 + 8 * g + q) * pitch + n0 + 4 * p;
    const s16x4 r0 = __builtin_amdgcn_ds_read_tr16_b64_v4i16((__attribute__((address_space(3))) s16x4*)a);
    const s16x4 r1 = __builtin_amdgcn_ds_read_tr16_b64_v4i16((__attribute__((address_space(3))) s16x4*)(a + 4 * pitch));
    return __builtin_bit_cast(h16x8, __builtin_shufflevector(r0, r1, 0, 1, 2, 3, 4, 5, 6, 7));
}

namespace pg8 {
#ifndef PG8_ZC
#define PG8_ZC 1
#endif
#ifndef PG8_SPLIT
#define PG8_SPLIT false
#endif
constexpr int BM = 256, BK = 64, HALF = 128, HTB = HALF * BK * 2, STAGE_BYTES = 8 * HTB, NXCD = 8, WGM = 8;
__host__ __device__ __forceinline__ int lds_byte(int r, int c) { const int st = (r >> 4) * 2 + (c >> 5), rr = r & 15, cc = c & 31, ob = rr * 64 + cc * 2; return st * 1024 + (ob ^ (((ob >> 9) & 1) << 5)); }
__host__ __device__ __forceinline__ void stage_rc(int b, int& R, int& C) { const int st = b / 1024, sb = b % 1024, swz = sb ^ (((sb >> 9) & 1) << 5); R = (st >> 1) * 16 + swz / 64; C = (st & 1) * 32 + (swz % 64) / 2; }
__host__ __device__ __forceinline__ int perm32(int rho) { const int n = rho >> 4, i = rho & 15; return 8 * (i >> 2) + 4 * n + (i & 3); }
__host__ __device__ __forceinline__ size_t blk32(int row, int col, int K) { return ((size_t)(row >> 5) * (K >> 5) + (col >> 5)) * 1024 + (row & 31) * 32 + (col & 31); }
struct Unit { int pm, pn; };
struct Gemm { const u16* A; const u16* Bt; int M, N, K; int lda, asplit; unsigned aofs; };
struct StaticOrder {
    int nM, nN, nwg, G, c;
    __host__ __device__ void init(int M, int N, int G_, int c_) { nM = M / BM; nN = N / BM; nwg = nM * nN; G = G_; c = c_; }
    __host__ __device__ bool next(int i, Unit& u) const {
        const long L = (long)i * G + c; if (L >= nwg) return false;
        int wgid = (int)L; { const int q = nwg / NXCD, r = nwg % NXCD, xcd = wgid % NXCD, off = wgid / NXCD; wgid = (xcd < r ? xcd * (q + 1) : r * (q + 1) + (xcd - r) * q) + off; }
        const int nig = WGM * nN, gid = wgid / nig, fm = gid * WGM, gsz = (nM - fm) < WGM ? (nM - fm) : WGM;
        u.pm = fm + ((wgid % nig) % gsz); u.pn = (wgid % nig) / gsz; return true;
    }
    __device__ __forceinline__ void a_ready(const Unit&, int) const {}
    __device__ __forceinline__ void done(const Unit&) const {}
};
__device__ __forceinline__ void load_scales(LAS float* dst, const float* rsq, int pm, int tid) {
    const int r = tid >> 1, hf = tid & 1;
    const f32x4* p = (const f32x4*)(rsq + (size_t)pm * 4096) + (unsigned)(tid * 2);
    const f32x4 a = p[0], b = p[1]; const f32x4 t = a + b; float s = (t[0] + t[1]) + (t[2] + t[3]);
    s += __builtin_bit_cast(float, __builtin_amdgcn_update_dpp(0, __builtin_bit_cast(int, s), 0xB1, 0xF, 0xF, true));
    if (hf == 0) dst[(((r >> 6) & 1) * 16 + (r & 15)) * 8 + (r >> 7) * 4 + ((r >> 4) & 3)] = __builtin_amdgcn_rsqf(s * (1.0f / 1024.0f) + 1e-6f);
}
template <bool RS> struct EpiStoreH {
    static constexpr bool PERM = true, SPLIT = PG8_SPLIT, HALVES = true, RS_LDS = RS;
    static constexpr int NST = 8;
    u16* O; int ldc; int split_cols; size_t split_stride; const float* rsv;
    template <int AI> __device__ __forceinline__ void half(const f32x4 (&acc)[2][2][4][2], const Unit& u, int wr, int wc, int fr_in, int fq_in, const LAS float* rs) const {
        int fr = fr_in, fq = fq_in; asm volatile("" : "+v"(fr), "+v"(fq));
        const int row0 = u.pm * BM + wr * 64 + fr + AI * HALF; int colt = u.pn * BM; u16* base = O;
        if (split_cols) { const int t = colt / split_cols; base += (size_t)t * split_stride; colt -= t * split_cols; }
        const int col0 = colt + wc * 32 + 8 * fq;
        f32x4 rsa = {1.f, 1.f, 1.f, 1.f};
        if (RS) rsa = *(const LAS f32x4*)(rs + (wr * 16 + fr) * 8 + AI * 4);
        u16* p0 = base + blk32(row0, col0, ldc);
#pragma unroll
        for (int m = 0; m < 4; ++m) {
            const float rsc = rsa[m];
#pragma unroll
            for (int bj = 0; bj < 2; ++bj) { const f32x4 v0 = acc[AI][bj][m][0] * rsc, v1 = acc[AI][bj][m][1] * rsc;
                u32x4 w; w.x = pk2(v0[0], v0[1]); w.y = pk2(v0[2], v0[3]); w.z = pk2(v1[0], v1[1]); w.w = pk2(v1[2], v1[3]);
                __builtin_nontemporal_store(w, (u32x4*)(p0 + (size_t)(m >> 1) * (ldc >> 5) * 1024 + (m & 1) * 512 + bj * (HALF / 32) * 1024)); } }
    }
};
struct EpiSwiglu {
    static constexpr bool PERM = true, SPLIT = PG8_SPLIT, HALVES = true, RS_LDS = true;
    static constexpr int NST = 4;
    u16* O; int ldc; const float* rsv;
    template <int AI> __device__ __forceinline__ void half(const f32x4 (&acc)[2][2][4][2], const Unit& u, int wr, int wc, int fr_in, int fq_in, const LAS float* rs) const {
        int fr = fr_in, fq = fq_in; asm volatile("" : "+v"(fr), "+v"(fq));
        const int row0 = u.pm * BM + wr * 64 + fr + AI * HALF, col0 = u.pn * HALF + wc * 32 + 8 * fq;
        const f32x4 rsa = *(const LAS f32x4*)(rs + (wr * 16 + fr) * 8 + AI * 4);
        u16* p0 = O + blk32(row0, col0, ldc);
#pragma unroll
        for (int m = 0; m < 4; ++m) { u16* rowp = p0 + (size_t)(m >> 1) * (ldc >> 5) * 1024 + (m & 1) * 512;
            const float rsc = rsa[m]; const f32x2 rs2 = {rsc, rsc};
            unsigned ow[4];
#pragma unroll
            for (int p = 0; p < 4; ++p) {
                const f32x4 ga = acc[AI][0][m][p >> 1], ua = acc[AI][1][m][p >> 1];
                const f32x2 g2 = (f32x2){ga[2 * (p & 1)], ga[2 * (p & 1) + 1]} * rs2, u2 = (f32x2){ua[2 * (p & 1)], ua[2 * (p & 1) + 1]} * rs2;
                const f32x2 t2 = g2 * (f32x2){-1.44269504089f, -1.44269504089f};
                const f32x2 d2 = (f32x2){__builtin_amdgcn_exp2f(t2.x), __builtin_amdgcn_exp2f(t2.y)} + (f32x2){1.0f, 1.0f};
                const f32x2 o2 = (g2 * (f32x2){__builtin_amdgcn_rcpf(d2.x), __builtin_amdgcn_rcpf(d2.y)}) * u2;
                ow[p] = pk2(o2.x, o2.y); }
            u32x4 w; w.x = ow[0]; w.y = ow[1]; w.z = ow[2]; w.w = ow[3];
            __builtin_nontemporal_store(w, (u32x4*)rowp); }
    }
};
constexpr size_t H16_OFF = (size_t)127 << 20, RSQ_OFF = (size_t)255 << 20;
struct EpiResid {
    static constexpr bool PERM = true, SPLIT = false, HALVES = false, RS_LDS = false;
    static constexpr int NST = 0;
    static constexpr int ldc = 1024;
    static constexpr const float* rsv = nullptr;
    template <int AI> __device__ __forceinline__ void half(const f32x4 (&)[2][2][4][2], const Unit&, int, int, int, int, const LAS float*) const {}
    unsigned char* wsb; float scale;
    __device__ __forceinline__ void operator()(const f32x4 (&acc)[2][2][4][2], const Unit& u, int wr, int wc, int fr_in, int fq_in, int, const LAS float*) const {
        int fr = fr_in, fq = fq_in; asm volatile("" : "+v"(fr), "+v"(fq));
        const int row0 = u.pm * BM + wr * 64 + fr, col0 = u.pn * BM + wc * 32 + 8 * fq;
        u16* h16 = (u16*)(wsb + H16_OFF); float* rsq = (float*)(wsb + RSQ_OFF);
#pragma unroll
        for (int ai = 0; ai < 2; ++ai)
#pragma unroll
            for (int m = 0; m < 4; ++m) { const int rw = row0 + ai * HALF + m * 16; float sq = 0.f;
                u32x4 hv[2];
#pragma unroll
                for (int bj = 0; bj < 2; ++bj) hv[bj] = *(const u32x4*)(h16 + blk32(rw, col0 + bj * HALF, ldc));
#pragma unroll
                for (int bj = 0; bj < 2; ++bj) { unsigned ow[4];
#pragma unroll
                    for (int n = 0; n < 2; ++n) { const unsigned w0 = hv[bj][2 * n], w1 = hv[bj][2 * n + 1];
                        const f32x4 bs = {hlo(w0), hhi(w0), hlo(w1), hhi(w1)}; const f32x4 o = bs + acc[ai][bj][m][n] * scale;
                        ow[2 * n] = pk2(o[0], o[1]); ow[2 * n + 1] = pk2(o[2], o[3]);
                        sq += (o[0] * o[0] + o[1] * o[1]) + (o[2] * o[2] + o[3] * o[3]); }
                    u32x4 w; w.x = ow[0]; w.y = ow[1]; w.z = ow[2]; w.w = ow[3]; *(u32x4*)(h16 + blk32(rw, col0 + bj * HALF, ldc)) = w; }
                sq = xsum16(sq); sq = xsum32(sq);
                if (fq == 0) rsq[(size_t)(row0 + ai * HALF + m * 16) * 16 + 4 * u.pn + wc] = sq;
                asm volatile("" ::: "memory"); }
    }
};
struct EpiGate {
    static constexpr bool PERM = true, SPLIT = false, HALVES = false, RS_LDS = true;
    static constexpr int NST = 0;
    template <int AI> __device__ __forceinline__ void half(const f32x4 (&)[2][2][4][2], const Unit&, int, int, int, int, const LAS float*) const {}
    const float* ba; const float* bb; const u16* tA; const u16* tB; u16* O; int ldc; const float* rsv;
    __device__ __forceinline__ void operator()(const f32x4 (&acc)[2][2][4][2], const Unit& u, int wr, int wc, int fr_in, int fq_in, int ui, const LAS float* rs) const {
        int fr = fr_in, fq = fq_in; asm volatile("" : "+v"(fr), "+v"(fq));
        const int row0 = u.pm * BM + wr * 64 + fr, col0 = u.pn * HALF + wc * 32 + 8 * fq;
        float va[8], vb[8];
#pragma unroll
        for (int j = 0; j < 8; ++j) { va[j] = ba[col0 + j]; vb[j] = bb[col0 + j]; }
        f32x4 rsa[2]; { const LAS f32x4* rp = (const LAS f32x4*)(rs + (wr * 16 + fr) * 8); rsa[0] = rp[0]; rsa[1] = rp[1]; }
#pragma unroll
        for (int ai = 0; ai < 2; ++ai)
#pragma unroll
            for (int m = 0; m < 4; ++m) { const size_t off = (size_t)(row0 + ai * HALF + m * 16) * ldc + col0;
                const size_t boff = blk32(row0 + ai * HALF + m * 16, col0, ldc); const u32x4 a4 = *(const u32x4*)(tA + boff), b4 = *(const u32x4*)(tB + boff);
                const float rs = rsa[ai][m];
                const f32x2 rs2 = {rs, rs}; unsigned ow[4];
#pragma unroll
                for (int p = 0; p < 4; ++p) {
                    const f32x4 xa = acc[ai][0][m][p >> 1], xb = acc[ai][1][m][p >> 1]; const int e = 2 * p;
                    const f32x2 pa = (f32x2){xa[2 * (p & 1)], xa[2 * (p & 1) + 1]} * rs2 + (f32x2){va[e], va[e + 1]}, pb = (f32x2){xb[2 * (p & 1)], xb[2 * (p & 1) + 1]} * rs2 + (f32x2){vb[e], vb[e + 1]};
                    const f32x2 ta2 = pa * (f32x2){-1.44269504089f, -1.44269504089f}, tb2 = pb * (f32x2){-1.44269504089f, -1.44269504089f};
                    const f32x2 da = (f32x2){__builtin_amdgcn_exp2f(ta2.x), __builtin_amdgcn_exp2f(ta2.y)} + (f32x2){1.0f, 1.0f}, db = (f32x2){__builtin_amdgcn_exp2f(tb2.x), __builtin_amdgcn_exp2f(tb2.y)} + (f32x2){1.0f, 1.0f};
                    const f32x2 tA = {hlo(a4[p]), hhi(a4[p])}, tB = {hlo(b4[p]), hhi(b4[p])};
                    const f32x2 o2 = (f32x2){__builtin_amdgcn_rcpf(da.x), __builtin_amdgcn_rcpf(da.y)} * tA + (f32x2){__builtin_amdgcn_rcpf(db.x), __builtin_amdgcn_rcpf(db.y)} * tB;
                    ow[p] = pk2(o2.x, o2.y); }
                u32x4 w; w.x = ow[0]; w.y = ow[1]; w.z = ow[2]; w.w = ow[3];
                __builtin_nontemporal_store(w, (u32x4*)(O + blk32(row0 + ai * HALF + m * 16, col0, ldc))); }
    }
};

template <bool ABLK, bool BBLK, class Epi, class Sched>
__device__ __forceinline__ void gemm_phase(LAS unsigned char* lds, const Gemm g, const Sched& S, const Epi& E) {
    const int tid = fresh_tid(), wid = __builtin_amdgcn_readfirstlane(tid >> 6), lane = tid & 63, wr = wid >> 2, wc = wid & 3, fr = lane & 15, fq = lane >> 4;
    const int K = g.K, KA = g.lda ? g.lda : K; int nt = K / BK; asm volatile("" : "+s"(nt));
    unsigned voffA, voffB;
    { int R, C; stage_rc(tid * 16, R, C); const int Rb = Epi::PERM ? ((R & ~31) + perm32(R & 31)) : R;
      voffA = ABLK ? (unsigned)blk32(R, C, KA) * 2u : (unsigned)(R * KA + C) * 2u; voffB = BBLK ? (unsigned)blk32(Rb, C, K) * 2u : (unsigned)(Rb * K + C) * 2u; }
    const size_t sA = (size_t)64 * KA * 2, sB = (size_t)64 * K * 2;
    const size_t kstepA = ABLK ? (size_t)4096 : (size_t)(BK * 2), kstepB = BBLK ? (size_t)4096 : (size_t)(BK * 2);
    const size_t hstep = (size_t)HALF * K * 2, hstepA = (size_t)HALF * KA * 2;
    const size_t tstep = 2 * hstep, tstepA = 2 * hstepA;
    const unsigned ldsw = (unsigned)wid * 1024u;
    const int aoff = lds_byte(wr * 64 + fr, fq * 8), boff = lds_byte(wc * 32 + fr, fq * 8);
#define PG8_SA(b, h) (((b) * 2 + (h)) * HTB)
#define PG8_SB(b, h) ((4 + (b) * 2 + (h)) * HTB)
#define PG8_STAGE(bufoff, gbase, voff) do { _Pragma("unroll") for (int _i = 0; _i < 2; ++_i) \
        __builtin_amdgcn_global_load_lds((const unsigned*)((const char*)(gbase) + _i * PG8_STEP_##voff + (voff)), (LAS unsigned*)(lds + (bufoff) + ldsw + _i * 8192), 16, 0, 0); } while (0)
#define PG8_STEP_voffA sA
#define PG8_STEP_voffB sB
#define PG8_LDA(dst, b, h) do { _Pragma("unroll") for (int m = 0; m < 4; ++m) _Pragma("unroll") for (int k = 0; k < 2; ++k) dst[m][k] = *(const LAS h16x8*)(lds + PG8_SA(b, h) + aoff + m * 2048 + k * 1024); } while (0)
#define PG8_LDB(dst, b, h) do { _Pragma("unroll") for (int n = 0; n < 2; ++n) _Pragma("unroll") for (int k = 0; k < 2; ++k) dst[n][k] = *(const LAS h16x8*)(lds + PG8_SB(b, h) + boff + n * 2048 + k * 1024); } while (0)
#define PG8_MMA(ai, bj, At, Bt) do { __builtin_amdgcn_s_setprio(1); _Pragma("unroll") for (int m = 0; m < 4; ++m) _Pragma("unroll") for (int n = 0; n < 2; ++n) _Pragma("unroll") for (int k = 0; k < 2; ++k) \
        acc[ai][bj][m][n] = MFMA16(Bt[n][k], At[m][k], acc[ai][bj][m][n]); __builtin_amdgcn_s_setprio(0); } while (0)
#define PG8_MMAZ(ai, bj, At, Bt) do { __builtin_amdgcn_s_setprio(1); _Pragma("unroll") for (int m = 0; m < 4; ++m) _Pragma("unroll") for (int n = 0; n < 2; ++n) { \
        acc[ai][bj][m][n] = MFMA16(Bt[n][0], At[m][0], zero4); acc[ai][bj][m][n] = MFMA16(Bt[n][1], At[m][1], acc[ai][bj][m][n]); } __builtin_amdgcn_s_setprio(0); } while (0)
#define PG8_WAIT_V(n) asm volatile("s_waitcnt vmcnt(" #n ")" ::: "memory")
#define PG8_WAIT_VN(n) asm volatile("s_waitcnt vmcnt(%0)" :: "n"(n) : "memory")
#define PG8_WAIT_L(n) asm volatile("s_waitcnt lgkmcnt(" #n ")" ::: "memory")
#define PG8_BAR __builtin_amdgcn_s_barrier()
#define PG8_SCHED __builtin_amdgcn_sched_barrier(0)
#define PG8_H1P E.template half<1>(acc, prv, wr, wc, fr, fq, rsl + psb * 256)
#define PG8_H0C E.template half<0>(acc, cur, wr, wc, fr, fq, rsl + sb * 256)
#define PG8_ZERO(a) do { _Pragma("unroll") for (int b_ = 0; b_ < 2; ++b_) _Pragma("unroll") for (int m_ = 0; m_ < 4; ++m_) _Pragma("unroll") for (int n_ = 0; n_ < 2; ++n_) acc[a][b_][m_][n_] = zero4; } while (0)
    Unit cur, nxt, prv; int ui = 0; prv.pm = 0; prv.pn = 0;
    if (!S.next(0, cur)) return;
    f32x4 acc[2][2][4][2]; const f32x4 zero4 = {0.f, 0.f, 0.f, 0.f};
    PG8_ZERO(0); PG8_ZERO(1);
    h16x8 At[4][2], B0[2][2], B1[2][2];
    LAS float* rsl = (LAS float*)(lds + STAGE_BYTES);
    int sb = 0, psb = 0;
    if (Epi::RS_LDS) load_scales(rsl, E.rsv, cur.pm, tid);
    const char* cA = (const char*)g.A + (size_t)cur.pm * tstepA + ((g.asplit && cur.pn >= g.asplit) ? g.aofs : 0u); const char* cB = (const char*)g.Bt + (size_t)cur.pn * tstep;
    S.a_ready(cur, 0);
    PG8_STAGE(PG8_SB(0, 0), cB, voffB); PG8_STAGE(PG8_SB(0, 1), cB + hstep, voffB); PG8_STAGE(PG8_SA(0, 0), cA, voffA); PG8_STAGE(PG8_SA(0, 1), cA + hstepA, voffA);
    if (wr == 1) PG8_BAR;
    PG8_WAIT_V(2); PG8_BAR;
    PG8_STAGE(PG8_SB(1, 0), cB + kstepB, voffB); PG8_STAGE(PG8_SA(1, 0), cA + kstepA, voffA); PG8_STAGE(PG8_SB(1, 1), cB + hstep + kstepB, voffB);
    PG8_WAIT_V(6); PG8_BAR;
    for (;;) {
        const bool has_next = S.next(ui + 1, nxt);
        const char* nA = has_next ? (const char*)g.A + (size_t)nxt.pm * tstepA + ((g.asplit && nxt.pn >= g.asplit) ? g.aofs : 0u) : cA; const char* nB = has_next ? (const char*)g.Bt + (size_t)nxt.pn * tstep : cB;
        for (int t = 0; t < nt; t += 2) {
            const bool last = (t == nt - 2), fe = Epi::SPLIT && t == 0 && ui > 0;
            const char* a1 = cA + (size_t)(t + 1) * kstepA;
            const char* a2 = last ? nA : cA + (size_t)(t + 2) * kstepA; const char* b2 = last ? nB : cB + (size_t)(t + 2) * kstepB;
            const char* a3 = a2 + kstepA; const char* b3 = b2 + kstepB;
            PG8_LDB(B0, 0, 0); PG8_LDB(B1, 0, 1); PG8_SCHED; PG8_LDA(At, 0, 0); PG8_STAGE(PG8_SA(1, 1), a1 + hstepA, voffA);
            if (fe) { PG8_H1P; PG8_ZERO(1); PG8_WAIT_VN(8 + 2 * Epi::NST); } else PG8_WAIT_V(8);
            PG8_WAIT_L(0); PG8_BAR; PG8_MMA(0, 0, At, B0); PG8_MMA(0, 1, At, B1); PG8_BAR; PG8_SCHED;
            PG8_LDA(At, 0, 1); PG8_STAGE(PG8_SB(0, 0), b2, voffB); PG8_STAGE(PG8_SB(0, 1), b2 + hstep, voffB); PG8_STAGE(PG8_SA(0, 0), a2, voffA);
            if (fe) PG8_WAIT_VN(8 + 2 * Epi::NST); else PG8_WAIT_V(8);
            PG8_WAIT_L(0); PG8_BAR; PG8_MMA(1, 0, At, B0); PG8_MMA(1, 1, At, B1); PG8_BAR; PG8_SCHED;
            PG8_LDB(B0, 1, 0); PG8_LDB(B1, 1, 1); PG8_SCHED; PG8_LDA(At, 1, 0); PG8_STAGE(PG8_SA(0, 1), a2 + hstepA, voffA);
            if (fe) PG8_WAIT_VN(8 + Epi::NST); else PG8_WAIT_V(8);
            PG8_WAIT_L(0); PG8_BAR; PG8_MMA(0, 0, At, B0); PG8_MMA(0, 1, At, B1); PG8_BAR; PG8_SCHED;
            PG8_LDA(At, 1, 1); PG8_STAGE(PG8_SB(1, 0), b3, voffB); PG8_STAGE(PG8_SB(1, 1), b3 + hstep, voffB); PG8_STAGE(PG8_SA(1, 0), a3, voffA);
            if (Epi::SPLIT && last) { PG8_SCHED; PG8_H0C; PG8_ZERO(0); PG8_WAIT_VN(8 + Epi::NST); } else PG8_WAIT_V(8);
            PG8_WAIT_L(0); PG8_BAR; PG8_MMA(1, 0, At, B0); PG8_MMA(1, 1, At, B1); PG8_BAR; PG8_SCHED;
        }
        if constexpr (!Epi::SPLIT) {
            if (wr == 0) PG8_BAR;
            if constexpr (Epi::HALVES) { E.template half<0>(acc, cur, wr, wc, fr, fq, rsl + sb * 256); E.template half<1>(acc, cur, wr, wc, fr, fq, rsl + sb * 256); } else E(acc, cur, wr, wc, fr, fq, ui, rsl + sb * 256);
            if (!has_next) break;
            if (Epi::RS_LDS && nxt.pm != cur.pm) { sb ^= 1; load_scales(rsl + sb * 256, E.rsv, nxt.pm, tid); }
            cur = nxt; cA = nA; cB = nB; ++ui;
            if (wr == 1) PG8_BAR;
            PG8_SCHED; PG8_ZERO(0); PG8_ZERO(1); PG8_SCHED;
        } else {
            if (!has_next) { E.template half<1>(acc, cur, wr, wc, fr, fq, rsl + sb * 256); break; }
            prv = cur; psb = sb;
            if (Epi::RS_LDS && nxt.pm != cur.pm) { sb ^= 1; load_scales(rsl + sb * 256, E.rsv, nxt.pm, tid); }
            cur = nxt; cA = nA; cB = nB; ++ui;
        }
    }
    if (Epi::SPLIT) { if (wr == 0) PG8_BAR; }
    PG8_WAIT_V(0);
    PG8_BAR;
#undef PG8_ZERO
#undef PG8_H1P
#undef PG8_H0C
#undef PG8_NONE
#undef PG8_SA
#undef PG8_SB
#undef PG8_STAGE
#undef PG8_STEP_voffA
#undef PG8_STEP_voffB
#undef PG8_LDA
#undef PG8_LDB
#undef PG8_MMA
#undef PG8_MMAZ
#undef PG8_WAIT_V
#undef PG8_WAIT_VN
#undef PG8_WAIT_L
#undef PG8_BAR
#undef PG8_SCHED
}
}

#ifndef REP_CONV
#define REP_CONV 1
#endif
#ifndef REP_RMS
#define REP_RMS 1
#endif
#ifndef REP_MASK
#define REP_MASK 0
#endif
#define REPG(i) ((((REP_MASK) >> (i)) & 1) + 1)
#ifndef REP_G
#define REP_G 1
#endif
#ifndef REP_PREP
#define REP_PREP 1
#endif
#ifndef REP_PA
#define REP_PA 1
#endif
#ifndef REP_PB
#define REP_PB 1
#endif
#ifndef REP_POST
#define REP_POST 1
#endif
#ifndef REP_RET
#define REP_RET 1
#endif
#ifndef REP_XATT
#define REP_XATT 1
#endif
#ifndef REP_BAR
#define REP_BAR 1
#endif
constexpr int NWAVES = 8;
constexpr int D = 1024, NBATCH = 32, T = 2048, DEPTH = 4, M = NBATCH * T, MEML = 256, MM = NBATCH * MEML, DFF = 2816;
constexpr int AW = 512, INW = 6912, CH = 32, NCH = T / CH;
constexpr size_t MiB = 1u << 20;
constexpr size_t WS_CTL = 0, CTL_ZERO_BYTES = 1 * MiB;
constexpr size_t WS_WB = 1 * MiB;
constexpr size_t WB_WIN = 0, WB_WOUT = WB_WIN + 2 * (size_t)5632 * 1024 * 2, WB_WA = WB_WOUT + 2 * (size_t)1024 * 2816 * 2, WB_WBM = WB_WA + (size_t)1792 * 1024 * 2,
                 WB_WG = WB_WBM + (size_t)3072 * 1024 * 2, WB_WLR = WB_WG + (size_t)2048 * 1024 * 2, WB_PA = WB_WLR + (size_t)1536 * 256 * 2, WB_PB = WB_PA + (size_t)1024 * 512 * 2,
                 WB_WMO = WB_PB + 2 * MiB, WB_WQ = WB_WMO + 2 * MiB, WB_WK = WB_WQ + 2 * MiB, WB_WV = WB_WK + 2 * MiB, WB_WO = WB_WV + 2 * MiB, WB_END = WB_WO + 2 * MiB;
static_assert(WB_END <= 62 * MiB, "weights region");
static_assert(pg8::H16_OFF == 127 * MiB && pg8::RSQ_OFF == 255 * MiB, "EpiResid offsets");
constexpr size_t WS_MEMN = 63 * MiB, WS_KM = 79 * MiB, WS_VTM = 95 * MiB, WS_COS = 111 * MiB, WS_SIN = 119 * MiB, WS_XN = 127 * MiB, WS_RSQ = 255 * MiB, WS_AR = 259 * MiB;
constexpr size_t AR_ZA = 0, AR_YS = 192 * MiB, AR_ALR = 224 * MiB, AR_WAG = 256 * MiB, AR_PAO = 448 * MiB, AR_ST = 641 * MiB, AR_YA = 645 * MiB, AR_END = 709 * MiB;
constexpr size_t AR_ZB = 0, AR_YB = 384 * MiB, AR_TMPA = 0, AR_TMPB = 128 * MiB, AR_MRG = 256 * MiB, AR_Q = 0, AR_O = 128 * MiB, AR_ACT = 0;
constexpr size_t WS_END = WS_AR + AR_END;
constexpr int CW_BAR = 4096;
constexpr int LDS_BYTES = 163840, LDSCTL_OFF = LDS_BYTES - 256, LDS_RS_OFF = 131072;

__constant__ float c_invfreq[32] = {
    1.0f, 0.7498942093324559f, 0.5623413251903491f, 0.4216965034285822f, 0.31622776601683794f, 0.23713737056616552f, 0.1778279410038923f, 0.1333521432163324f,
    0.1f, 0.07498942093324559f, 0.05623413251903491f, 0.04216965034285822f, 0.031622776601683794f, 0.023713737056616552f, 0.01778279410038923f, 0.01333521432163324f,
    0.01f, 0.007498942093324559f, 0.005623413251903491f, 0.004216965034285822f, 0.0031622776601683794f, 0.0023713737056616554f, 0.001778279410038923f, 0.001333521432163324f,
    0.001f, 0.0007498942093324559f, 0.0005623413251903491f, 0.0004216965034285822f, 0.00031622776601683794f, 0.00023713737056616554f, 0.0001778279410038923f, 0.0001333521432163324f };

#define XB_TMO      128
#define XB_XCNT(j)  (256  + 64 * (j))
#define XB_XSUB(j)  (1280 + 64 * (j))
#define XB_XGEN(j)  (2304 + 64 * (j))
#define XB_TOP      3328
#define XB_TOPGEN   3392
#define XCD_BAR_WORDS 3456
#define XB_SPIN_CAP (1u << 18)
__device__ __forceinline__ unsigned xb_ld(unsigned* p)              { return __hip_atomic_load(p, __ATOMIC_RELAXED, __HIP_MEMORY_SCOPE_AGENT); }
__device__ __forceinline__ unsigned xb_add(unsigned* p, unsigned v) { return __hip_atomic_fetch_add(p, v, __ATOMIC_RELAXED, __HIP_MEMORY_SCOPE_AGENT); }
__device__ __forceinline__ unsigned xb_xcc_id() { return (unsigned)__builtin_amdgcn_s_getreg((3 << 11) | 20) & 0xFu; }
#define XB_SPIN(cond, bar) do { unsigned _sp = 0; while (cond) { __builtin_amdgcn_s_sleep(1); \
    if ((++_sp & 255u) == 0u) { if (xb_ld(&(bar)[XB_TMO])) break; if (_sp > XB_SPIN_CAP) { atomicAdd(&(bar)[XB_TMO], 1u); break; } } } } while (0)
struct XcdBarrier { unsigned* bar; unsigned x; volatile LAS unsigned* st; };
__device__ __forceinline__ XcdBarrier xcd_barrier_post(unsigned* bar, volatile LAS unsigned* st) {
    XcdBarrier b; b.bar = bar; b.x = xb_xcc_id(); b.st = st;
    if (threadIdx.x == 0) (void)xb_add(&bar[XB_XCNT(b.x)], 1u);
    return b;
}
__device__ __forceinline__ void xcd_barrier_complete(unsigned* bar, unsigned x, unsigned& nloc, unsigned& nx) {
    const unsigned G = gridDim.x * gridDim.y * gridDim.z;
    unsigned sum, cnt, mine, sp = 0u;
    for (;;) {
        sum = 0u; cnt = 0u; mine = 0u;
#pragma unroll
        for (unsigned j = 0; j < 16; ++j) { const unsigned c = xb_ld(&bar[XB_XCNT(j)]); sum += c; cnt += (c > 0u) ? 1u : 0u; mine = (j == x) ? c : mine; }
        if (sum == G) break;
        __builtin_amdgcn_s_sleep(1);
        if ((++sp & 255u) == 0u) { if (xb_ld(&bar[XB_TMO])) break; if (sp > XB_SPIN_CAP) { atomicAdd(&bar[XB_TMO], 1u); break; } }
    }
    nloc = mine > 0u ? mine : 1u; nx = cnt > 0u ? cnt : 1u;
}
__device__ __forceinline__ void xcd_barrier(const XcdBarrier& b) {
    asm volatile("s_waitcnt vmcnt(0)" ::: "memory");
    __syncthreads();
    if (threadIdx.x == 0) {
        unsigned* bar = b.bar;
        __builtin_amdgcn_s_waitcnt(0);
        unsigned nloc = b.st[0], nx = b.st[1];
        if (nloc == 0u) { xcd_barrier_complete(bar, b.x, nloc, nx); b.st[0] = nloc; b.st[1] = nx; }
        const unsigned old = xb_add(&bar[XB_XSUB(b.x)], 1u);
        const unsigned gen = old / nloc;
        if (old + 1u == (gen + 1u) * nloc) {
            __builtin_amdgcn_fence(__ATOMIC_RELEASE, "agent");
            asm volatile("s_waitcnt vmcnt(0)" ::: "memory");
            const unsigned og = xb_add(&bar[XB_TOP], 1u);
            const unsigned tg = og / nx;
            if (og + 1u == (tg + 1u) * nx) xb_add(&bar[XB_TOPGEN], 1u);
            else XB_SPIN(xb_ld(&bar[XB_TOPGEN]) == tg, bar);
            __builtin_amdgcn_fence(__ATOMIC_ACQUIRE, "agent");
            xb_add(&bar[XB_XGEN(b.x)], 1u);
            asm volatile("s_waitcnt vmcnt(0)" ::: "memory");
        } else {
            XB_SPIN(xb_ld(&bar[XB_XGEN(b.x)]) == gen, bar);
            __builtin_amdgcn_fence(__ATOMIC_ACQUIRE, "agent");
            asm volatile("s_waitcnt vmcnt(0)" ::: "memory");
        }
    }
    __syncthreads();
}

struct Args { const void* in[27]; float* out; unsigned char* ws; int pad0, pad1; };
#define KBASE() const CAS char* kbase_ = (const CAS char*)__builtin_amdgcn_kernarg_segment_ptr(); asm volatile("" : "+s"(kbase_))
#define KARG(k) (*(void* const CAS*)(kbase_ + 8 * (k)))
struct Frame { LAS unsigned char* lds; int G; };
#define PHASE_IDS() KBASE(); const int tid = fresh_tid(), lane = tid & 63, wave = __builtin_amdgcn_readfirstlane(tid >> 6), gw = (int)blockIdx.x * NWAVES + wave, NGW = F.G * NWAVES; (void)lane; (void)gw; (void)NGW
#define LDS_WAIT() asm volatile("s_waitcnt lgkmcnt(0)" ::: "memory")
#define LDS_BARRIER() do { asm volatile("s_waitcnt lgkmcnt(0)" ::: "memory"); __builtin_amdgcn_s_barrier(); asm volatile("" ::: "memory"); } while (0)

__device__ __forceinline__ void conv_matrix(const Frame& F, const float* W, int ldw, int coff, int K, int N, u16* WT, int mode, int NH, const float* gain) {
    for (int rep = 0; rep < REP_CONV; ++rep) {
    PHASE_IDS();
    LAS float* scr = (LAS float*)(F.lds + wave * 8448);
    const int nblk = N / 32, nitems = (K / 64) * nblk;
    for (int item = gw; item < nitems; item += NGW) {
        const int kb = item / nblk, nb = item % nblk, k0 = 64 * kb, n0 = 32 * nb;
        int d0 = n0;
        if (mode == 1) { d0 = (n0 < NH) ? (n0 / 128) * 256 + (n0 % 128) : ((n0 - NH) / 128) * 256 + 128 + ((n0 - NH) % 128); }
#pragma unroll
        for (int i = 0; i < 8; ++i) { const int kk = 8 * i + (lane >> 3), n4 = 4 * (lane & 7);
            f32x4 w4 = *(const f32x4*)(W + (size_t)(k0 + kk) * ldw + coff + n0 + n4); if (gain) w4 = w4 * gain[k0 + kk];
            scr[kk * 33 + n4] = w4[0]; scr[kk * 33 + n4 + 1] = w4[1]; scr[kk * 33 + n4 + 2] = w4[2]; scr[kk * 33 + n4 + 3] = w4[3]; }
        LDS_WAIT(); asm volatile("" ::: "memory");
        const int c = lane & 7;
#pragma unroll
        for (int j = 0; j < 4; ++j) { const int n = (lane >> 3) + 8 * j; const LAS float* s = scr + (8 * c) * 33 + n;
            u32x4 o; o.x = pk2(s[0 * 33], s[1 * 33]); o.y = pk2(s[2 * 33], s[3 * 33]); o.z = pk2(s[4 * 33], s[5 * 33]); o.w = pk2(s[6 * 33], s[7 * 33]);
            *(u32x4*)(WT + pg8::blk32(d0 + n, k0 + 8 * c, K)) = o; }
        LDS_WAIT(); asm volatile("" ::: "memory");
    }
    }
}
__device__ __forceinline__ void rms_row_h(const float* xrow, const float* g, u16* obase, int row, int lane) {
    const f32x4* xr = (const f32x4*)xrow + lane; const f32x4* gr = (const f32x4*)g + lane;
    f32x4 v[4]; float s = 0.f;
#pragma unroll
    for (int j = 0; j < 4; ++j) { v[j] = xr[64 * j]; s += (v[j].x * v[j].x + v[j].y * v[j].y) + (v[j].z * v[j].z + v[j].w * v[j].w); }
    const float r = __builtin_amdgcn_rsqf(wave_sum(s) * (1.f / D) + 1e-6f);
#pragma unroll
    for (int j = 0; j < 4; ++j) { const f32x4 gg = gr[64 * j]; u32x2 w; w.x = pk2(v[j].x * r * gg.x, v[j].y * r * gg.y); w.y = pk2(v[j].z * r * gg.z, v[j].w * r * gg.w); *(u32x2*)(obase + pg8::blk32(row, 4 * lane + 256 * j, D)) = w; }
}
__device__ __forceinline__ void rms_phase(const Frame& F, const float* src, const float* g, u16* dst, int rows) {
    for (int rep = 0; rep < REP_RMS; ++rep) {
    PHASE_IDS();
    for (int m = gw; m < rows; m += NGW) rms_row_h(src + (size_t)m * D, g, dst, m, lane);
    }
}


typedef float f32x8 __attribute__((ext_vector_type(8)));
typedef float f32x16 __attribute__((ext_vector_type(16)));
#define SLOAD8(dst, base, off) asm volatile("s_load_dwordx8 %0, %1, " #off : "=s"(dst) : "s"(base))
#define SLOAD16(dst, base, off) asm volatile("s_load_dwordx16 %0, %1, " #off : "=s"(dst) : "s"(base))
__device__ __forceinline__ int rsv_index(int row) { const int pm = row >> 8, R = row & 255; return ((pm * 2 + ((R >> 6) & 1)) * 16 + (R & 15)) * 8 + (R >> 7) * 4 + ((R >> 4) & 3); }
#define RS_PASS() do { KBASE(); for (int m_ = (int)blockIdx.x * (NWAVES * 64) + fresh_tid(); m_ < M; m_ += F.G * NWAVES * 64) { const f32x4* p_ = (const f32x4*)(RSQ + (size_t)m_ * 16); \
        const f32x4 a_ = p_[0], b_ = p_[1], c_ = p_[2], d_ = p_[3]; const f32x4 t_ = (a_ + b_) + (c_ + d_); \
        RSV[rsv_index(m_)] = __builtin_amdgcn_rsqf(((t_[0] + t_[1]) + (t_[2] + t_[3])) * (1.0f / 1024.0f) + 1e-6f); } } while (0)
__device__ __forceinline__ size_t za_idx(int m, int col) { return (size_t)(col >> 8) * ((size_t)M * 256) + (size_t)m * 256 + (col & 255); }


#define x_in        ((const float*)KARG(0))
#define mem_in      ((const float*)KARG(1))
#define pos_in      ((const int*)KARG(2))
#define norm_g      ((const float*)KARG(3))
#define ffn_w_in    ((const float*)KARG(4))
#define ffn_w_out   ((const float*)KARG(5))
#define mix_w_in    ((const float*)KARG(6))
#define mix_gate_b  ((const float*)KARG(7))
#define shift_mu    ((const float*)KARG(8))
#define a_w0        ((const float*)KARG(9))
#define a_w_up      ((const float*)KARG(10))
#define a_a0        ((const float*)KARG(11))
#define a_a_up      ((const float*)KARG(12))
#define a_g_up      ((const float*)KARG(13))
#define a_k_k       ((const float*)KARG(14))
#define a_k_a       ((const float*)KARG(15))
#define a_r_k       ((const float*)KARG(16))
#define a_ln        ((const float*)KARG(17))
#define b_gn        ((const float*)KARG(18))
#define w_branch_a  ((const float*)KARG(19))
#define w_branch_b  ((const float*)KARG(20))
#define mix_w_out   ((const float*)KARG(21))
#define mem_norm    ((const float*)KARG(22))
#define cross_w_q   ((const float*)KARG(23))
#define cross_w_kv  ((const float*)KARG(24))
#define cross_w_o   ((const float*)KARG(25))
#define final_norm  ((const float*)KARG(26))
#define WSP(TY, off) ((TY*)((unsigned char*)KARG(28) + (off)))
#define W_in_t  WSP(u16, WS_WB + WB_WIN)
#define W_out_t WSP(u16, WS_WB + WB_WOUT)
#define W_A_t   WSP(u16, WS_WB + WB_WA)
#define W_B_t   WSP(u16, WS_WB + WB_WBM)
#define W_G_t   WSP(u16, WS_WB + WB_WG)
#define W_LR_t  WSP(u16, WS_WB + WB_WLR)
#define P_A_t   WSP(u16, WS_WB + WB_PA)
#define P_B_t   WSP(u16, WS_WB + WB_PB)
#define W_MO_t  WSP(u16, WS_WB + WB_WMO)
#define W_Q_t   WSP(u16, WS_WB + WB_WQ)
#define W_K_t   WSP(u16, WS_WB + WB_WK)
#define W_V_t   WSP(u16, WS_WB + WB_WV)
#define W_O_t   WSP(u16, WS_WB + WB_WO)
#define MEMN    WSP(u16, WS_MEMN)
#define KM      WSP(u16, WS_KM)
#define VTM     WSP(u16, WS_VTM)
#define COS     WSP(float, WS_COS)
#define SIN     WSP(float, WS_SIN)
#define H16     WSP(u16, WS_XN)
#define YS      WSP(u16, WS_AR + AR_YS)
#define RSQ     WSP(float, WS_RSQ)
#define RSV     WSP(float, WS_CTL + 512 * 1024)
#define ZA      WSP(u16, WS_AR + AR_ZA)
#define ALR     WSP(u16, WS_AR + AR_ALR)
#define WAG     WSP(u16, WS_AR + AR_WAG)
#define YA      WSP(u16, WS_AR + AR_YA)
#define ZB      WSP(u16, WS_AR + AR_ZB)
#define YB      WSP(u16, WS_AR + AR_YB)
#define TMPA    WSP(u16, WS_AR + AR_TMPA)
#define TMPB    WSP(u16, WS_AR + AR_TMPB)
#define MRG     WSP(u16, WS_AR + AR_MRG)
#define QX      WSP(u16, WS_AR + AR_Q)
#define OX      WSP(u16, WS_AR + AR_O)
#define ACT     WSP(u16, WS_AR + AR_ACT)
#define H       ((float*)KARG(27))

__global__ void __launch_bounds__(NWAVES * 64, 2) fwd_kernel(Args args) {
    extern __shared__ __attribute__((aligned(16))) unsigned char lds_raw[];
    Frame F;
    F.lds = (LAS unsigned char*)lds_raw;
    F.G = gridDim.x;
    volatile LAS unsigned* MISC = (volatile LAS unsigned*)(F.lds + LDSCTL_OFF);
    for (int u = threadIdx.x; u < 64; u += NWAVES * 64) MISC[u] = 0u;
    __syncthreads();
    XcdBarrier bar; { KBASE(); bar = xcd_barrier_post((unsigned*)((unsigned char*)KARG(28) + WS_CTL) + CW_BAR, MISC + 8); }
#define GRID_BAR() do { for (int rb_ = 0; rb_ < REP_BAR; ++rb_) xcd_barrier(bar); } while (0)


    { KBASE();
    for (int i = blockIdx.x * (NWAVES * 64) + threadIdx.x; i < M * 32; i += F.G * NWAVES * 64) {
        const int m = i >> 5, f = i & 31;
        const double a = (double)pos_in[m] * (double)c_invfreq[f] * 0.15915494309189535;
        const float fr = (float)(a - __builtin_rint(a));
        COS[i] = __builtin_amdgcn_cosf(fr); SIN[i] = __builtin_amdgcn_sinf(fr);
    }
    }

    {
        PHASE_IDS();
        for (int m = gw; m < M; m += NGW) {
            const f32x4* xr = (const f32x4*)(x_in + (size_t)m * D) + lane; float sq = 0.f;
#pragma unroll
            for (int j = 0; j < 4; ++j) { const f32x4 v = xr[64 * j]; sq += (v.x * v.x + v.y * v.y) + (v.z * v.z + v.w * v.w); u32x2 w; w.x = pk2(v.x, v.y); w.y = pk2(v.z, v.w); *(u32x2*)(H16 + pg8::blk32(m, 4 * lane + 256 * j, D)) = w; }
            sq = wave_sum(sq);
            if (lane < 16) RSQ[(size_t)m * 16 + lane] = (lane == 0) ? sq : 0.f;
        }
    }
    for (int l = 0; l < DEPTH; ++l) {
        { KBASE();
            for (int s = 0; s < 2; ++s) {
                conv_matrix(F, ffn_w_in + ((size_t)l * 2 + s) * D * 2 * DFF, 2 * DFF, 0, D, 2 * DFF, W_in_t + (size_t)s * 5632 * 1024, 1, DFF, norm_g + ((size_t)l * 4 + 3 * s) * D);
                conv_matrix(F, ffn_w_out + ((size_t)l * 2 + s) * DFF * D, D, 0, DFF, D, W_out_t + (size_t)s * 1024 * 2816, 0, 0, nullptr);
            }
            const float* mw = mix_w_in + (size_t)l * D * INW;
            conv_matrix(F, mw, INW, 0, D, 1792, W_A_t, 0, 0, norm_g + ((size_t)l * 4 + 1) * D);
            conv_matrix(F, mw, INW, 1792, D, 3072, W_B_t, 0, 0, norm_g + ((size_t)l * 4 + 1) * D);
            conv_matrix(F, mw, INW, 4864, D, 2048, W_G_t, 1, 1024, norm_g + ((size_t)l * 4 + 1) * D);
            conv_matrix(F, w_branch_a + (size_t)l * AW * D, D, 0, AW, D, P_A_t, 0, 0, nullptr);
            conv_matrix(F, w_branch_b + (size_t)l * D * D, D, 0, D, D, P_B_t, 0, 0, nullptr);
            conv_matrix(F, mix_w_out + (size_t)l * D * D, D, 0, D, D, W_MO_t, 0, 0, nullptr);
            conv_matrix(F, cross_w_q + (size_t)l * D * D, D, 0, D, D, W_Q_t, 0, 0, norm_g + ((size_t)l * 4 + 2) * D);
            conv_matrix(F, cross_w_kv + (size_t)l * D * 2 * D, 2 * D, 0, D, D, W_K_t, 0, 0, nullptr);
            conv_matrix(F, cross_w_kv + (size_t)l * D * 2 * D, 2 * D, D, D, D, W_V_t, 0, 0, nullptr);
            conv_matrix(F, cross_w_o + (size_t)l * D * D, D, 0, D, D, W_O_t, 0, 0, nullptr);
            for (int i = blockIdx.x * (NWAVES * 64) + fresh_tid(); i < 1536 * 128; i += F.G * NWAVES * 64) {
                const int n = i >> 7, k = i & 127; float v = 0.f;
                if (n < 512) { if (k < 64) v = a_w_up[((size_t)l * 64 + k) * 512 + n]; }
                else if (n < 1024) { if (k >= 64) v = a_a_up[((size_t)l * 64 + (k - 64)) * 512 + (n - 512)]; }
                else v = a_g_up[((size_t)l * 128 + k) * 512 + (n - 1024)];
                W_LR_t[pg8::blk32(n, k, 128)] = f2h(v);
            }
            rms_phase(F, mem_in, mem_norm + (size_t)l * D, MEMN, MM);
        }
        GRID_BAR();
        {
            { KBASE(); pg8::Gemm g{H16, W_in_t, M, 2 * DFF, D}; pg8::StaticOrder S; S.init(M, 2 * DFF, F.G, (int)blockIdx.x); pg8::EpiSwiglu E{ACT, DFF, RSQ};
              for (int rep = 0; rep < REPG(0); ++rep) pg8::gemm_phase<true, true>(F.lds, g, S, E); }
            { KBASE(); pg8::Gemm g{MEMN, W_K_t, MM, D, D}; pg8::StaticOrder S; S.init(MM, D, F.G, (int)blockIdx.x); pg8::EpiStoreH<false> E{KM, D, 0, 0, nullptr};
              for (int rep = 0; rep < REPG(1); ++rep) pg8::gemm_phase<true, true>(F.lds, g, S, E); }
            { KBASE(); pg8::Gemm g{W_V_t, MEMN, D, MM, D}; pg8::StaticOrder S; S.init(D, MM, F.G, (int)((blockIdx.x + 128) % F.G)); pg8::EpiStoreH<false> E{VTM, MM, 0, 0, nullptr};
              for (int rep = 0; rep < REPG(2); ++rep) pg8::gemm_phase<true, true>(F.lds, g, S, E); }
        }
        GRID_BAR();
        { KBASE(); pg8::Gemm g{ACT, W_out_t, M, D, DFF}; pg8::StaticOrder S; S.init(M, D, F.G, (int)blockIdx.x); pg8::EpiResid E{(unsigned char*)KARG(28), 0.5f};
          pg8::gemm_phase<true, true>(F.lds, g, S, E); }
        GRID_BAR();
        { KBASE(); pg8::Gemm g{H16, W_A_t, M, 1792, D}; pg8::StaticOrder S; S.init(M, 1792, F.G, (int)blockIdx.x); pg8::EpiStoreH<true> E{ZA, 256, 256, (size_t)M * 256, RSQ};
          for (int rep = 0; rep < REPG(3); ++rep) pg8::gemm_phase<true, true>(F.lds, g, S, E); }
        GRID_BAR();
        {
            PHASE_IDS();
            const u16* T6 = ZA + (size_t)6 * M * 256; const float* mu = shift_mu + (size_t)l * 1792 + 1536;
            for (int m = gw; m < M; m += NGW) {
                const int c0 = 4 * lane; const bool first = (m % T) == 0;
                const u32x2 zc = *(const u32x2*)(T6 + pg8::blk32(m, c0, 256));
                u32x2 zp = {0u, 0u}; if (!first) zp = *(const u32x2*)(T6 + pg8::blk32(m - 1, c0, 256));
                const f32x4 mm = *(const f32x4*)(mu + c0);
                float v[4] = {hlo(zc.x), hhi(zc.x), hlo(zc.y), hhi(zc.y)}; const float p[4] = {hlo(zp.x), hhi(zp.x), hlo(zp.y), hhi(zp.y)};
#pragma unroll
                for (int j = 0; j < 4; ++j) { float s = v[j] + (p[j] - v[j]) * mm[j];
                    if (c0 < 64) { const float e = __builtin_amdgcn_exp2f(2.88539008178f * s); s = 1.0f - 2.0f * __builtin_amdgcn_rcpf(1.0f + e); }
                    else if (c0 >= 128) s = fsigmoid(s);
                    v[j] = s; }
                u32x2 o; o.x = pk2(v[0], v[1]); o.y = pk2(v[2], v[3]);
                *(u32x2*)(ALR + pg8::blk32(m, c0, 256)) = o;
            }
        }
        GRID_BAR();
        { KBASE(); pg8::Gemm g{ALR, W_LR_t, M, 1536, 128, 256, 4, 8192u}; pg8::StaticOrder S; S.init(M, 1536, F.G, (int)blockIdx.x); pg8::EpiStoreH<false> E{WAG, 1536, 0, 0, nullptr};
          for (int rep = 0; rep < REPG(4); ++rep) pg8::gemm_phase<true, true>(F.lds, g, S, E); }
        GRID_BAR();
        {
            for (int rep = 0; rep < REP_PA; ++rep) {
                PHASE_IDS();
                const int fr_o = lane & 15, fq_o = lane >> 4;
                LAS u16* Bh = (LAS u16*)F.lds;  LAS u16* Kh = Bh + 32 * 72; LAS u16* Kt = Kh + 32 * 72; LAS u16* Rt = Kt + 32 * 72;
                LAS u16* Ktx = Rt + 32 * 72;    LAS u16* Rx = Ktx + 32 * 72;
                LAS u16* BgT = Rx + 32 * 72;    LAS u16* VT = BgT + 64 * 40; LAS u16* KgT = VT + 64 * 40;
                LAS u16* AbrT = KgT + 64 * 40;  LAS u16* AkkT = AbrT + 32 * 40; LAS u16* AkrT = AkkT + 32 * 40;
                LAS float* ATt = (LAS float*)(F.lds + 50688);
                LAS float* Uf = (LAS float*)(F.lds + 55296);
                LAS u16* Zh = (LAS u16*)(F.lds + 64512);
                LAS float* YL = (LAS float*)(F.lds + 69632);
                LAS u16* Sh = (LAS u16*)(F.lds + 78336);
                LAS float* Lgrp = (LAS float*)(F.lds + 87552);
                LAS float* gC = Lgrp + 512;
                LAS float* CVl = (LAS float*)(F.lds + 89856);
                LAS float* GGl = (LAS float*)(F.lds + 107264);
                for (int bh = blockIdx.x; bh < NBATCH * 8; bh += F.G) {
                    const int b = bh >> 3, h = bh & 7, jj = tid & 63, col = 64 * h + jj;
                    const u16* zrp = ZA + (size_t)(col >> 8) * M * 256; const u16* zkp = zrp + (size_t)2 * M * 256; const u16* zvp = zrp + (size_t)4 * M * 256;
                    u16 nzr[5], nzk[5], nzv[5], nwd[4], nad[4], ngd[4];
#define PA_LOAD(cc_) do { const int t1_ = CH * (cc_) + 4 * wave; int m1_ = b * T + t1_; asm volatile("" : "+v"(m1_)); \
        const size_t zb_ = pg8::blk32(m1_, col & 255, 256), zp_ = (m1_ & 31) ? zb_ - 32 : zb_ - 8 * 1024 + 31 * 32;     \
        const bool ok_ = t1_ > 0; nzr[0] = ok_ ? zrp[zp_] : (u16)0; nzk[0] = ok_ ? zkp[zp_] : (u16)0; nzv[0] = ok_ ? zvp[zp_] : (u16)0; \
        _Pragma("unroll") for (int u = 1; u < 5; ++u) { nzr[u] = zrp[zb_ + (u - 1) * 32]; nzk[u] = zkp[zb_ + (u - 1) * 32]; nzv[u] = zvp[zb_ + (u - 1) * 32]; } \
        const size_t wb_ = pg8::blk32(m1_, col, 1536); \
        _Pragma("unroll") for (int u = 0; u < 4; ++u) { nwd[u] = WAG[wb_ + u * 32]; nad[u] = WAG[wb_ + u * 32 + (size_t)16 * 1024]; ngd[u] = WAG[wb_ + u * 32 + (size_t)32 * 1024]; } } while (0)
                    float lw[4], bb[4], kp[4], rr[4], vv[4], kq[4], c[4], cvv[4], ggv[4];
                    const float* mu = shift_mu + (size_t)l * 1792;
                    const float mur = mu[col], muk = mu[512 + col], muv = mu[1024 + col], w0c = a_w0[(size_t)l * 512 + col], a0c = a_a0[(size_t)l * 512 + col];
                    const float kkc = a_k_k[(size_t)l * 512 + col], kac = a_k_a[(size_t)l * 512 + col], rkc = a_r_k[(size_t)l * 512 + col];
                    const f32x4 ln0 = *(const f32x4*)(a_ln + ((size_t)l * 2 + 0) * 512 + 64 * h + 4 * (tid & 15)), ln1 = *(const f32x4*)(a_ln + ((size_t)l * 2 + 1) * 512 + 64 * h + 4 * (tid & 15));
#define PA_FIRST() do { \
        float zr[5], zk[5], zv[5]; \
        _Pragma("unroll") for (int u = 0; u < 5; ++u) { zr[u] = h2f(nzr[u]); zk[u] = h2f(nzk[u]); zv[u] = h2f(nzv[u]); } \
        _Pragma("unroll") for (int u = 0; u < 4; ++u) { \
            rr[u] = zr[u + 1] + (zr[u] - zr[u + 1]) * mur; const float kx = zk[u + 1] + (zk[u] - zk[u + 1]) * muk; vv[u] = zv[u + 1] + (zv[u] - zv[u + 1]) * muv; \
            const float a = fsigmoid(a0c + h2f(nad[u])); \
            lw[u] = -0.60653065971f * 1.44269504089f * fsigmoid(w0c + h2f(nwd[u]));            \
            float kk = kx * kkc; kk = kk * __builtin_amdgcn_rsqf(fmaxf(wave_sum(kk * kk), 1e-24f)); \
            kq[u] = kk; bb[u] = kk * a; kp[u] = kx * (1.0f + (a - 1.0f) * kac); \
            cvv[u] = wave_sum(rr[u] * kp[u] * rkc) * vv[u]; ggv[u] = h2f(ngd[u]); }       \
        c[0] = lw[0]; c[1] = c[0] + lw[1]; c[2] = c[1] + lw[2]; c[3] = c[2] + lw[3]; \
        Lgrp[wave * 64 + jj] = c[3]; } while (0)
                    PA_LOAD(0);
                    for (int e = tid; e < 64 * 72; e += NWAVES * 64) Sh[e] = 0;
                    f32x4 Sreg[2] = {{0.f, 0.f, 0.f, 0.f}, {0.f, 0.f, 0.f, 0.f}};
                    PA_FIRST();
                    LDS_BARRIER();
                    for (int cc = 0; cc < NCH; ++cc) {
                        int fr = fr_o, fq = fq_o, jl = jj; asm volatile("" : "+v"(fr), "+v"(fq), "+v"(jl));
                        LAS float* CVc = CVl + (cc & 1) * 2176; LAS float* GGc = GGl + (cc & 1) * 2176;
                        const int ib = wave >> 1, hb = wave & 1;
                        {
                            const int j = jl, g = wave;
                            if (cc + 1 < NCH) PA_LOAD(cc + 1);
                            float pre = 0.f, Lmid = 0.f, Lend = 0.f;
#pragma unroll
                            for (int g2 = 0; g2 < 8; ++g2) { const float x = Lgrp[g2 * 64 + j]; if (g2 < g) pre += x; if (g2 < 4) Lmid += x; Lend += x; }
                            const float cM = __builtin_amdgcn_exp2f(-Lmid), cMi = __builtin_amdgcn_exp2f(Lmid), cE = __builtin_amdgcn_exp2f(Lend);
                            float xg[4], xk[4], x1[4], x2[4], x3[4], x4[4], x5[4], x6[4]; float e4 = __builtin_amdgcn_exp2f(pre);
#pragma unroll
                            for (int u = 0; u < 4; ++u) { const int sT = 4 * g + u; const float L = pre + c[u];
                                const float e5 = __builtin_amdgcn_exp2f(L), r5 = __builtin_amdgcn_rcpf(e5);
                                const float e3 = e5 * cM, e2 = e4 * cM, e1 = fminf(cMi * r5, 8192.f), e6 = cE * r5;
                                x1[u] = bb[u] * e1; x2[u] = kp[u] * e1; x3[u] = kq[u] * e2; x4[u] = rr[u] * e3; x5[u] = kq[u] * e4; x6[u] = rr[u] * e5;
                                xg[u] = bb[u] * e6; xk[u] = kp[u] * e6; e4 = e5;
                                CVc[sT * 68 + j] = cvv[u]; GGc[sT * 68 + j] = ggv[u]; }
                            {
                                u32x2 w; w.x = pk2(xg[0], xg[1]); w.y = pk2(xg[2], xg[3]); *(LAS u32x2*)(BgT + j * 40 + 4 * g) = w;
                                w.x = pk2(x1[0], x1[1]); w.y = pk2(x1[2], x1[3]); *(LAS u32x2*)(Bh + j * 36 + 4 * g) = w;
                                w.x = pk2(x2[0], x2[1]); w.y = pk2(x2[2], x2[3]); *(LAS u32x2*)(Kh + j * 36 + 4 * g) = w;
                                w.x = pk2(x3[0], x3[1]); w.y = pk2(x3[2], x3[3]); *(LAS u32x2*)(Kt + j * 36 + 4 * g) = w;
                                w.x = pk2(x4[0], x4[1]); w.y = pk2(x4[2], x4[3]); *(LAS u32x2*)(Rt + j * 36 + 4 * g) = w;
                                w.x = pk2(x5[0], x5[1]); w.y = pk2(x5[2], x5[3]); *(LAS u32x2*)(Ktx + j * 36 + 4 * g) = w;
                                w.x = pk2(x6[0], x6[1]); w.y = pk2(x6[2], x6[3]); *(LAS u32x2*)(Rx + j * 36 + 4 * g) = w;
                                w.x = pk2(vv[0], vv[1]); w.y = pk2(vv[2], vv[3]); *(LAS u32x2*)(VT + j * 40 + 4 * g) = w;
                                w.x = pk2(xk[0], xk[1]); w.y = pk2(xk[2], xk[3]); *(LAS u32x2*)(KgT + j * 40 + 4 * g) = w; }
                            if (g == 0) gC[j] = cE;
                        }
                        LDS_BARRIER();
                        f32x4 accU = {0.f, 0.f, 0.f, 0.f}, accY = {0.f, 0.f, 0.f, 0.f}, accS[2] = {{0.f, 0.f, 0.f, 0.f}, {0.f, 0.f, 0.f, 0.f}};
                        h16x8 aV;
                        {
                            const int mt = wave >> 2, sb = (wave >> 1) & 1, tb = wave & 1;
                            const LAS u16* X = mt ? Kh : Bh;
                            const h16x8 a0 = lds_tr16(X, 36, 0, 16 * sb, lane), a1 = lds_tr16(X, 36, 32, 16 * sb, lane);
                            const h16x8 k0 = lds_tr16(Kt, 36, 0, 16 * tb, lane), k1 = lds_tr16(Kt, 36, 32, 16 * tb, lane);
                            const h16x8 r0 = lds_tr16(Rt, 36, 0, 16 * tb, lane), r1 = lds_tr16(Rt, 36, 32, 16 * tb, lane);
                            const h16x8 s0 = *(const LAS h16x8*)(Sh + (16 * ib + fr) * 72 + 8 * fq), s1 = *(const LAS h16x8*)(Sh + (16 * ib + fr) * 72 + 32 + 8 * fq);
                            const h16x8 x0 = lds_tr16(Ktx, 36, 0, 16 * hb, lane), x1 = lds_tr16(Ktx, 36, 32, 16 * hb, lane);
                            const h16x8 y0 = lds_tr16(Rx, 36, 0, 16 * hb, lane), y1 = lds_tr16(Rx, 36, 32, 16 * hb, lane);
                            aV = *(const LAS h16x8*)(VT + (16 * ib + fr) * 40 + 8 * fq);
                            const h16x8 g0 = *(const LAS h16x8*)(KgT + (16 * (2 * hb) + fr) * 40 + 8 * fq), g1 = *(const LAS h16x8*)(KgT + (16 * (2 * hb + 1) + fr) * 40 + 8 * fq);
                            f32x4 aK = {0.f, 0.f, 0.f, 0.f}, aR = {0.f, 0.f, 0.f, 0.f};
                            aK = MFMA16(a0, k0, aK); aK = MFMA16(a1, k1, aK); aR = MFMA16(a0, r0, aR); aR = MFMA16(a1, r1, aR);
                            accU = MFMA16(s0, x0, accU); accU = MFMA16(s1, x1, accU); accY = MFMA16(s0, y0, accY); accY = MFMA16(s1, y1, accY);
                            accS[0] = MFMA16(aV, g0, accS[0]); accS[1] = MFMA16(aV, g1, accS[1]);
                            const int t = 16 * tb + fr, s0i = 16 * sb + 4 * fq;
#pragma unroll
                            for (int rg = 0; rg < 4; ++rg) { if (s0i + rg >= t) aK[rg] = 0.f; if (s0i + rg > t) aR[rg] = 0.f; }
                            u32x2 wK, wR; wK.x = pk2(aK[0], aK[1]); wK.y = pk2(aK[2], aK[3]); wR.x = pk2(aR[0], aR[1]); wR.y = pk2(aR[2], aR[3]);
                            if (mt == 0) {
#pragma unroll
                                for (int rg = 0; rg < 4; ++rg) ATt[(s0i + rg) * 36 + t] = aK[rg];
                                *(LAS u32x2*)(AbrT + t * 40 + s0i) = wR; }
                            else { *(LAS u32x2*)(AkkT + t * 40 + s0i) = wK; *(LAS u32x2*)(AkrT + t * 40 + s0i) = wR; }
                        }
                        LDS_BARRIER();
                        {
                            const h16x8 bK = *(const LAS h16x8*)(AkkT + (16 * hb + fr) * 40 + 8 * fq), bR = *(const LAS h16x8*)(AkrT + (16 * hb + fr) * 40 + 8 * fq);
                            accU = MFMA16(aV, bK, accU); accY = MFMA16(aV, bR, accY);
#pragma unroll
                            for (int rg = 0; rg < 4; ++rg) Uf[(16 * ib + 4 * fq + rg) * 36 + 16 * hb + fr] = accU[rg];
                        }
                        LDS_BARRIER();
                        if (wave == 0) {
                            float z[32];
#pragma unroll
                            for (int q = 0; q < 8; ++q) { const f32x4 v = *(const LAS f32x4*)(Uf + lane * 36 + 4 * q); z[4 * q] = v[0]; z[4 * q + 1] = v[1]; z[4 * q + 2] = v[2]; z[4 * q + 3] = v[3]; }
#pragma unroll
                            for (int sx = 0; sx < 31; ++sx) {
#pragma unroll
                                for (int q = (sx + 1) / 4; q < 8; ++q) { const f32x4 a4 = *(const LAS f32x4*)(ATt + sx * 36 + 4 * q);
#pragma unroll
                                    for (int i = 0; i < 4; ++i) if (4 * q + i > sx) z[4 * q + i] = fmaf(-z[sx], a4[i], z[4 * q + i]); }
                            }
#pragma unroll
                            for (int q = 0; q < 4; ++q) { u32x4 w; w.x = pk2(-z[8 * q], -z[8 * q + 1]); w.y = pk2(-z[8 * q + 2], -z[8 * q + 3]); w.z = pk2(-z[8 * q + 4], -z[8 * q + 5]); w.w = pk2(-z[8 * q + 6], -z[8 * q + 7]);
                                *(LAS u32x4*)(Zh + lane * 40 + 8 * q) = w; }
                        }
                        if (cc + 1 < NCH) PA_FIRST();
                        LDS_BARRIER();
                        {
                            const h16x8 aZ = *(const LAS h16x8*)(Zh + (16 * ib + fr) * 40 + 8 * fq);
                            const h16x8 bA = *(const LAS h16x8*)(AbrT + (16 * hb + fr) * 40 + 8 * fq);
                            const h16x8 b0 = *(const LAS h16x8*)(BgT + (16 * (2 * hb) + fr) * 40 + 8 * fq), b1 = *(const LAS h16x8*)(BgT + (16 * (2 * hb + 1) + fr) * 40 + 8 * fq);
                            const float gc0 = gC[16 * (2 * hb) + fr], gc1 = gC[16 * (2 * hb + 1) + fr];
                            accY = MFMA16(aZ, bA, accY); accS[0] = MFMA16(aZ, b0, accS[0]); accS[1] = MFMA16(aZ, b1, accS[1]);
                            const int i0 = 16 * ib + 4 * fq;
                            *(LAS f32x4*)(YL + (16 * hb + fr) * 68 + i0) = accY;
                            Sreg[0] = Sreg[0] * gc0 + accS[0]; Sreg[1] = Sreg[1] * gc1 + accS[1];
#pragma unroll
                            for (int rg = 0; rg < 4; ++rg) { Sh[(i0 + rg) * 72 + 16 * (2 * hb) + fr] = f2h(Sreg[0][rg]); Sh[(i0 + rg) * 72 + 16 * (2 * hb + 1) + fr] = f2h(Sreg[1][rg]); }
                        }
                        LDS_BARRIER();
                        {
                            const int t = tid >> 4, i4 = 4 * (tid & 15), colo = 64 * h + i4;
                            const f32x4 y4 = *(const LAS f32x4*)(YL + t * 68 + i4), cv4 = *(const LAS f32x4*)(CVc + t * 68 + i4), g4 = *(const LAS f32x4*)(GGc + t * 68 + i4);
                            const float mean = sum16((y4[0] + y4[1]) + (y4[2] + y4[3])) * (1.f / 64.f); const f32x4 d4 = y4 - mean;
                            const float rstd = __builtin_amdgcn_rsqf(sum16((d4[0] * d4[0] + d4[1] * d4[1]) + (d4[2] * d4[2] + d4[3] * d4[3])) * (1.f / 64.f) + 64e-5f);
                            const f32x4 o4 = (d4 * rstd * ln0 + ln1 + cv4) * g4;
                            u32x2 w; w.x = pk2(o4[0], o4[1]); w.y = pk2(o4[2], o4[3]);
                            *(u32x2*)(YA + pg8::blk32(b * T + CH * cc + t, colo, 512)) = w;
                        }
                    }
                    LDS_BARRIER();
#undef PA_LOAD
#undef PA_FIRST
                }
            }
            GRID_BAR();
        }
        { KBASE(); pg8::Gemm g{H16, W_B_t, M, 3072, D}; pg8::StaticOrder S; S.init(M, 3072, F.G, (int)blockIdx.x); pg8::EpiStoreH<true> E{ZB, 3072, 0, 0, RSQ};
          for (int rep = 0; rep < REPG(5); ++rep) pg8::gemm_phase<true, true>(F.lds, g, S, E); }
        GRID_BAR();
        for (int rep = 0; rep < REP_RET; ++rep) {
            PHASE_IDS();
            LAS u16* Qd = (LAS u16*)(F.lds + 0);
            LAS u16* Kd = (LAS u16*)(F.lds + 18432);
            LAS u16* RTL = (LAS u16*)(F.lds + 36864);
            LAS u16* Vr = (LAS u16*)(F.lds + 72704);
            LAS u16* PL = (LAS u16*)(F.lds + 107520);
            const int fr = lane & 15, fq = lane >> 4;
            for (int bh = blockIdx.x; bh < NBATCH * 8; bh += F.G) {
                const int b = bh >> 3, h = bh & 7;
                const float lg = __builtin_log2f(1.0f - __builtin_amdgcn_exp2f(-5.0f - (float)h));
                const float gC = __builtin_amdgcn_exp2f(128.0f * lg);
                f32x4 rt[4];
#pragma unroll
                for (int i = 0; i < 4; ++i) rt[i] = (f32x4){0.f, 0.f, 0.f, 0.f};
                u32x4 nq1, nq2, nk1, nk2, nv8[4]; f32x4 nc0, nc1, ns0, ns1;
#define RET_LOAD(n_) do { const int s_ = 16 * wave + (lane >> 2), ci_ = lane & 3;     const size_t tok_ = (size_t)b * T + 128 * (n_) + s_; const u16* zp_ = ZB + pg8::blk32((int)tok_, 64 * h + 8 * ci_, 3072); \
        nq1 = *(const u32x4*)(zp_); nq2 = *(const u32x4*)(zp_ + 1024); nk1 = *(const u32x4*)(zp_ + 16 * 1024); nk2 = *(const u32x4*)(zp_ + 17 * 1024); \
        const float* cp_ = COS + tok_ * 32 + 8 * ci_; const float* sp_ = SIN + tok_ * 32 + 8 * ci_; nc0 = *(const f32x4*)cp_; nc1 = *(const f32x4*)(cp_ + 4); ns0 = *(const f32x4*)sp_; ns1 = *(const f32x4*)(sp_ + 4); \
        const u16* vp_ = ZB + pg8::blk32((int)tok_, 1024 + 128 * h + 8 * ci_, 3072); _Pragma("unroll") for (int i = 0; i < 4; ++i) nv8[i] = *(const u32x4*)(vp_ + i * 1024); } while (0)
                RET_LOAD(0);
                for (int n = 0; n < T / 128; ++n) {
                    const int m0 = b * T + 128 * n;
                    {
                        const int s = 16 * wave + (lane >> 2), ci = lane & 3;
                        const u32x4 q1 = nq1, q2 = nq2, k1 = nk1, k2 = nk2; const f32x4 c0 = nc0, c1 = nc1, s0 = ns0, s1 = ns1;
                        u32x4 cv8[4];
#pragma unroll
                        for (int i = 0; i < 4; ++i) cv8[i] = nv8[i];
                        if (n + 1 < T / 128) RET_LOAD(n + 1);
                        const float fqs = __builtin_amdgcn_exp2f((float)(s + 1) * lg), fks = 0.125f * __builtin_amdgcn_exp2f(-(float)(s + 1) * lg);
                        float qa[8], qb[8], ka[8], kbv[8];
#pragma unroll
                        for (int j = 0; j < 8; ++j) { const float cs = (j < 4) ? c0[j & 3] : c1[j & 3], sn = (j < 4) ? s0[j & 3] : s1[j & 3];
                            const float x1 = (j & 1) ? hhi(q1[j >> 1]) : hlo(q1[j >> 1]), x2 = (j & 1) ? hhi(q2[j >> 1]) : hlo(q2[j >> 1]);
                            const float y1 = (j & 1) ? hhi(k1[j >> 1]) : hlo(k1[j >> 1]), y2 = (j & 1) ? hhi(k2[j >> 1]) : hlo(k2[j >> 1]);
                            qa[j] = (x1 * cs - x2 * sn) * fqs; qb[j] = (x1 * sn + x2 * cs) * fqs; ka[j] = (y1 * cs - y2 * sn) * fks; kbv[j] = (y1 * sn + y2 * cs) * fks; }
                        u32x4 w;
                        w.x = pk2(qa[0], qa[1]); w.y = pk2(qa[2], qa[3]); w.z = pk2(qa[4], qa[5]); w.w = pk2(qa[6], qa[7]); *(LAS u32x4*)(Qd + s * 72 + 8 * ci) = w;
                        w.x = pk2(qb[0], qb[1]); w.y = pk2(qb[2], qb[3]); w.z = pk2(qb[4], qb[5]); w.w = pk2(qb[6], qb[7]); *(LAS u32x4*)(Qd + s * 72 + 32 + 8 * ci) = w;
                        w.x = pk2(ka[0], ka[1]); w.y = pk2(ka[2], ka[3]); w.z = pk2(ka[4], ka[5]); w.w = pk2(ka[6], ka[7]); *(LAS u32x4*)(Kd + s * 72 + 8 * ci) = w;
                        w.x = pk2(kbv[0], kbv[1]); w.y = pk2(kbv[2], kbv[3]); w.z = pk2(kbv[4], kbv[5]); w.w = pk2(kbv[6], kbv[7]); *(LAS u32x4*)(Kd + s * 72 + 32 + 8 * ci) = w;
#pragma unroll
                        for (int i = 0; i < 4; ++i) *(LAS u32x4*)(Vr + s * 136 + 8 * (ci + 4 * i)) = cv8[i];
#pragma unroll
                        for (int db = 0; db < 4; ++db)
#pragma unroll
                            for (int r = 0; r < 4; ++r) RTL[(16 * wave + 4 * fq + r) * 72 + 16 * db + fr] = f2h(rt[db][r]);
                    }
                    LDS_BARRIER();
                    {
                        const h16x8 bq0 = *(const LAS h16x8*)(Qd + (16 * wave + fr) * 72 + 8 * fq), bq1 = *(const LAS h16x8*)(Qd + (16 * wave + fr) * 72 + 32 + 8 * fq);
#pragma unroll
                        for (int sb = 0; sb < 8; ++sb) {
                            u32x2 pw = {0u, 0u};
                            if (sb <= wave) {
                                f32x4 acc = {0.f, 0.f, 0.f, 0.f};
                                const h16x8 a0 = *(const LAS h16x8*)(Kd + (16 * sb + fr) * 72 + 8 * fq), a1 = *(const LAS h16x8*)(Kd + (16 * sb + fr) * 72 + 32 + 8 * fq);
                                acc = MFMA16(a0, bq0, acc); acc = MFMA16(a1, bq1, acc);
                                const int cc = 16 * wave + fr, s0i = 16 * sb + 4 * fq;
#pragma unroll
                                for (int r = 0; r < 4; ++r) if (s0i + r > cc) acc[r] = 0.f;
                                pw.x = pk2(acc[0], acc[1]); pw.y = pk2(acc[2], acc[3]);
                            }
                            *(LAS u32x2*)(PL + (16 * wave + fr) * 136 + 16 * sb + 4 * fq) = pw;
                        }
                    }
                    asm volatile("" ::: "memory");
                    {
                        h16x8 pf[4], qf[2];
#pragma unroll
                        for (int ks = 0; ks < 4; ++ks) pf[ks] = *(const LAS h16x8*)(PL + (16 * wave + fr) * 136 + 32 * ks + 8 * fq);
#pragma unroll
                        for (int ks = 0; ks < 2; ++ks) qf[ks] = *(const LAS h16x8*)(Qd + (16 * wave + fr) * 72 + 32 * ks + 8 * fq);
                        f32x4 oacc[8];
#pragma unroll
                        for (int eb = 0; eb < 8; ++eb) { f32x4 acc = {0.f, 0.f, 0.f, 0.f};
#pragma unroll
                            for (int ks = 0; ks < 4; ++ks) { const h16x8 a = lds_tr16(Vr, 136, 32 * ks, 16 * eb, lane); acc = MFMA16(a, pf[ks], acc); }
#pragma unroll
                            for (int ks = 0; ks < 2; ++ks) { const h16x8 a = *(const LAS h16x8*)(RTL + (16 * eb + fr) * 72 + 32 * ks + 8 * fq); acc = MFMA16(a, qf[ks], acc); }
                            oacc[eb] = acc; }
                        float sm = 0.f;
#pragma unroll
                        for (int eb = 0; eb < 8; ++eb) sm += (oacc[eb][0] + oacc[eb][1]) + (oacc[eb][2] + oacc[eb][3]);
                        sm = xsum16(sm); sm = xsum32(sm);
                        const float mean = sm * (1.f / 128.f); float vs = 0.f;
#pragma unroll
                        for (int eb = 0; eb < 8; ++eb)
#pragma unroll
                            for (int r = 0; r < 4; ++r) { const float dd = oacc[eb][r] - mean; vs += dd * dd; }
                        vs = xsum16(vs); vs = xsum32(vs);
                        const float inv = __builtin_amdgcn_rsqf(vs * (1.f / 128.f) + 1e-5f);
                        const int m = m0 + 16 * wave + fr, eo = 16 * (fq & 1) + 8 * (fq >> 1);
                        const u16* gp = ZB + pg8::blk32(m, 2048 + 128 * h + eo, 3072); u16* yp = YB + pg8::blk32(m, 128 * h + eo, 1024);
#pragma unroll
                        for (int p = 0; p < 4; ++p) {
                            f32x4 xa = oacc[2 * p], xb = oacc[2 * p + 1];
#pragma unroll
                            for (int r = 0; r < 4; ++r) { float pa_ = xa[r], pb_ = xb[r]; pair16(pa_, pb_); xa[r] = pa_; xb[r] = pb_; }
                            const int e0 = 16 * (2 * p + (fq & 1)) + 8 * (fq >> 1);
                            const u32x4 g4 = *(const u32x4*)(gp + p * 1024);
                            const f32x4 gn0 = *(const f32x4*)(b_gn + (size_t)l * 1024 + 128 * h + e0), gn1 = *(const f32x4*)(b_gn + (size_t)l * 1024 + 128 * h + e0 + 4);
                            float o[8];
#pragma unroll
                            for (int r = 0; r < 4; ++r) { const float ga = (r & 1) ? hhi(g4[r >> 1]) : hlo(g4[r >> 1]), gb = (r & 1) ? hhi(g4[2 + (r >> 1)]) : hlo(g4[2 + (r >> 1)]);
                                o[r] = (xa[r] - mean) * inv * gn0[r] * fsilu(ga); o[4 + r] = (xb[r] - mean) * inv * gn1[r] * fsilu(gb); }
                            u32x4 w; w.x = pk2(o[0], o[1]); w.y = pk2(o[2], o[3]); w.z = pk2(o[4], o[5]); w.w = pk2(o[6], o[7]);
                            *(u32x4*)(yp + p * 1024) = w; }
                    }
                    {
#pragma unroll
                        for (int ks = 0; ks < 4; ++ks) { const h16x8 a = lds_tr16(Vr, 136, 32 * ks, 16 * wave, lane);
#pragma unroll
                            for (int db = 0; db < 4; ++db) { const h16x8 bb = lds_tr16(Kd, 72, 32 * ks, 16 * db, lane); rt[db] = MFMA16(a, bb, rt[db]); } }
#pragma unroll
                        for (int db = 0; db < 4; ++db) rt[db] = rt[db] * gC;
                    }
                    LDS_BARRIER();
                }
            }
        }
        #undef RET_LOAD
        GRID_BAR();
        {
            { KBASE(); pg8::Gemm g{YA, P_A_t, M, D, AW}; pg8::StaticOrder S; S.init(M, D, F.G, (int)blockIdx.x); pg8::EpiStoreH<false> E{TMPA, D, 0, 0, nullptr}; for (int rep = 0; rep < REPG(6); ++rep) pg8::gemm_phase<true, true>(F.lds, g, S, E); }
            { KBASE(); pg8::Gemm g{YB, P_B_t, M, D, D}; pg8::StaticOrder S; S.init(M, D, F.G, (int)blockIdx.x); pg8::EpiStoreH<false> E{TMPB, D, 0, 0, nullptr}; for (int rep = 0; rep < REPG(7); ++rep) pg8::gemm_phase<true, true>(F.lds, g, S, E); }
        }
        GRID_BAR();
        { KBASE(); pg8::Gemm g{H16, W_G_t, M, 2048, D}; pg8::StaticOrder S; S.init(M, 2048, F.G, (int)blockIdx.x);
          pg8::EpiGate E{mix_gate_b + (size_t)l * 2048, mix_gate_b + (size_t)l * 2048 + 1024, TMPA, TMPB, MRG, D, RSQ};
          for (int rep = 0; rep < REPG(8); ++rep) pg8::gemm_phase<true, true>(F.lds, g, S, E); }
        GRID_BAR();
        { KBASE(); pg8::Gemm g{MRG, W_MO_t, M, D, D}; pg8::StaticOrder S; S.init(M, D, F.G, (int)blockIdx.x); pg8::EpiResid E{(unsigned char*)KARG(28), 1.0f}; pg8::gemm_phase<true, true>(F.lds, g, S, E); }
        GRID_BAR();
        { KBASE(); pg8::Gemm g{H16, W_Q_t, M, D, D}; pg8::StaticOrder S; S.init(M, D, F.G, (int)blockIdx.x); pg8::EpiStoreH<true> E{QX, D, 0, 0, RSQ}; for (int rep = 0; rep < REPG(9); ++rep) pg8::gemm_phase<true, true>(F.lds, g, S, E); }
        GRID_BAR();
        for (int rep = 0; rep < REP_XATT; ++rep) {
            PHASE_IDS();
            LAS unsigned char* TB = F.lds;
            LAS u16* PL = (LAS u16*)(F.lds + 65536);
            const int fr_o = lane & 15, fq_o = lane >> 4;
            const int NU = NBATCH * 4 * 16, per = (NU + F.G - 1) / F.G;
            const unsigned vofk = (unsigned)pg8::blk32(4 * wave + (lane >> 4), 8 * ((lane & 15) ^ ((4 * wave + (lane >> 4)) & 15)), D) * 2u;
            const unsigned vofv = (unsigned)pg8::blk32(2 * wave + (lane >> 5), 8 * ((lane & 31) ^ ((2 * wave + (lane >> 5)) & 15)), MM) * 2u;
#define XA_DMA_K(buf_, hh_, kq_) do { const char* g_ = (const char*)(KM + pg8::blk32(b * MEML + 128 * (kq_), 256 * hx + 128 * (hh_), D)); \
        _Pragma("unroll") for (int i_ = 0; i_ < 4; ++i_) __builtin_amdgcn_global_load_lds((const unsigned*)(g_ + (size_t)i_ * ((D / 32) * 2048) + vofk), (LAS unsigned*)(TB + (buf_) * 32768 + (8 * i_ + wave) * 1024), 16, 0, 0); } while (0)
#define XA_DMA_V(buf_, dh_, vq_) do { const char* g_ = (const char*)(VTM + pg8::blk32(256 * hx + 128 * (dh_) + 64 * (vq_), b * MEML, MM)); \
        _Pragma("unroll") for (int i_ = 0; i_ < 4; ++i_) __builtin_amdgcn_global_load_lds((const unsigned*)(g_ + (size_t)(i_ >> 1) * ((MM / 32) * 2048) + (i_ & 1) * 1024 + vofv), (LAS unsigned*)(TB + (buf_) * 32768 + (8 * i_ + wave) * 1024), 16, 0, 0); } while (0)
#define XA_TILE_READY() do { asm volatile("s_waitcnt vmcnt(0)" ::: "memory"); __syncthreads(); } while (0)
            for (int uj = 0; uj < per;) {
                const int un = (int)blockIdx.x * per + uj; if (un >= NU) break;
                const bool two = (uj + 1 < per) && (un + 1 < NU) && (((un + 1) >> 4) == (un >> 4));
                uj += two ? 2 : 1;
                int fr = fr_o, fq = fq_o; asm volatile("" : "+v"(fr), "+v"(fq));
                const int b = un >> 6, hx = (un >> 4) & 3, qtA = un & 15, qtB = two ? qtA + 1 : qtA;
                const int mqA = b * T + qtA * 128 + 16 * wave + fr, mqB = b * T + qtB * 128 + 16 * wave + fr;
                f32x4 sA[16], sB[16];
#pragma unroll
                for (int kb2 = 0; kb2 < 16; ++kb2) { sA[kb2] = (f32x4){0.f, 0.f, 0.f, 0.f}; sB[kb2] = (f32x4){0.f, 0.f, 0.f, 0.f}; }
                __syncthreads();
                XA_DMA_K(0, 0, 0);
#pragma unroll 1
                for (int hh = 0; hh < 2; ++hh) {
                    h16x8 qfA[4], qfB[4];
                    const u16* qpa = QX + pg8::blk32(mqA, 256 * hx + 128 * hh + 8 * fq, D); const u16* qpb = QX + pg8::blk32(mqB, 256 * hx + 128 * hh + 8 * fq, D);
#pragma unroll
                    for (int k4 = 0; k4 < 4; ++k4) { qfA[k4] = *(const h16x8*)(qpa + k4 * 1024); qfB[k4] = *(const h16x8*)(qpb + k4 * 1024); }
#pragma unroll
                    for (int kq = 0; kq < 2; ++kq) {
                        XA_TILE_READY();
                        if (kq == 0) XA_DMA_K(1, hh, 1); else if (hh == 0) XA_DMA_K(0, 1, 0); else XA_DMA_V(0, 0, 0);
                        const LAS unsigned char* tb = TB + kq * 32768;
#pragma unroll
                        for (int kl = 0; kl < 8; ++kl)
#pragma unroll
                            for (int k4 = 0; k4 < 4; ++k4) { const h16x8 a = *(const LAS h16x8*)(tb + (16 * kl + fr) * 256 + 16 * ((4 * k4 + fq) ^ fr));
                                sA[8 * kq + kl] = MFMA16(a, qfA[k4], sA[8 * kq + kl]); sB[8 * kq + kl] = MFMA16(a, qfB[k4], sB[8 * kq + kl]); }
                    }
                }
                h16x8 pfA[8], pfB[8]; float isA, isB;
#define XA_SOFTMAX(sacc, pf, isum_) do { float mx = -3.0e38f; \
        _Pragma("unroll") for (int kb2 = 0; kb2 < 16; ++kb2) mx = fmaxf(mx, fmaxf(fmaxf(sacc[kb2][0], sacc[kb2][1]), fmaxf(sacc[kb2][2], sacc[kb2][3]))); \
        mx = xmax16(mx); mx = xmax32(mx); float sum = 0.f; const float sc = 0.0625f * 1.44269504089f; \
        _Pragma("unroll") for (int kb2 = 0; kb2 < 16; ++kb2) { float p[4]; \
            _Pragma("unroll") for (int r = 0; r < 4; ++r) { p[r] = __builtin_amdgcn_exp2f((sacc[kb2][r] - mx) * sc); sum += p[r]; } \
            u32x2 w; w.x = pk2(p[0], p[1]); w.y = pk2(p[2], p[3]); *(LAS u32x2*)(PL + (16 * wave + fr) * 264 + 16 * kb2 + 4 * fq) = w; } \
        sum = xsum16(sum); sum = xsum32(sum); isum_ = __builtin_amdgcn_rcpf(sum); \
        asm volatile("" ::: "memory"); \
        _Pragma("unroll") for (int ks = 0; ks < 8; ++ks) pf[ks] = *(const LAS h16x8*)(PL + (16 * wave + fr) * 264 + 32 * ks + 8 * fq); \
        asm volatile("" ::: "memory"); } while (0)
                XA_SOFTMAX(sA, pfA, isA);
                XA_SOFTMAX(sB, pfB, isB);
#undef XA_SOFTMAX
#pragma unroll 1
                for (int dh = 0; dh < 2; ++dh) {
                    u16* opa = OX + pg8::blk32(mqA, 256 * hx + 128 * dh + 16 * (fq & 1) + 8 * (fq >> 1), D); u16* opb = OX + pg8::blk32(mqB, 256 * hx + 128 * dh + 16 * (fq & 1) + 8 * (fq >> 1), D);
#pragma unroll
                    for (int vq = 0; vq < 2; ++vq) {
                        XA_TILE_READY();
                        if (vq == 0) XA_DMA_V(1, dh, 1); else if (dh == 0) XA_DMA_V(0, 1, 0);
                        const LAS unsigned char* tb = TB + vq * 32768;
#pragma unroll
                        for (int dl = 0; dl < 2; ++dl) {
                            const int dp = 2 * vq + dl;
                            f32x4 xa = {0.f, 0.f, 0.f, 0.f}, xb = {0.f, 0.f, 0.f, 0.f}, ya = {0.f, 0.f, 0.f, 0.f}, yb = {0.f, 0.f, 0.f, 0.f};
#pragma unroll
                            for (int ks = 0; ks < 8; ++ks) { const h16x8 a = *(const LAS h16x8*)(tb + (16 * (2 * dl) + fr) * 512 + 16 * ((4 * ks + fq) ^ fr)); xa = MFMA16(a, pfA[ks], xa); ya = MFMA16(a, pfB[ks], ya); }
#pragma unroll
                            for (int ks = 0; ks < 8; ++ks) { const h16x8 a = *(const LAS h16x8*)(tb + (16 * (2 * dl + 1) + fr) * 512 + 16 * ((4 * ks + fq) ^ fr)); xb = MFMA16(a, pfA[ks], xb); yb = MFMA16(a, pfB[ks], yb); }
#pragma unroll
                            for (int r = 0; r < 4; ++r) { float pa_ = xa[r], pb_ = xb[r]; pair16(pa_, pb_); xa[r] = pa_; xb[r] = pb_; float qa_ = ya[r], qb_ = yb[r]; pair16(qa_, qb_); ya[r] = qa_; yb[r] = qb_; }
                            u32x4 w; w.x = pk2(xa[0] * isA, xa[1] * isA); w.y = pk2(xa[2] * isA, xa[3] * isA); w.z = pk2(xb[0] * isA, xb[1] * isA); w.w = pk2(xb[2] * isA, xb[3] * isA);
                            *(u32x4*)(opa + dp * 1024) = w;
                            if (two) { u32x4 v; v.x = pk2(ya[0] * isB, ya[1] * isB); v.y = pk2(ya[2] * isB, ya[3] * isB); v.z = pk2(yb[0] * isB, yb[1] * isB); v.w = pk2(yb[2] * isB, yb[3] * isB);
                                *(u32x4*)(opb + dp * 1024) = v; }
                        }
                    }
                }
            }
            __syncthreads();
#undef XA_DMA_K
#undef XA_DMA_V
#undef XA_TILE_READY
        }
        GRID_BAR();
        { KBASE(); pg8::Gemm g{OX, W_O_t, M, D, D}; pg8::StaticOrder S; S.init(M, D, F.G, (int)blockIdx.x); pg8::EpiResid E{(unsigned char*)KARG(28), 1.0f}; pg8::gemm_phase<true, true>(F.lds, g, S, E); }
        GRID_BAR();
        { KBASE(); pg8::Gemm g{H16, W_in_t + (size_t)5632 * 1024, M, 2 * DFF, D}; pg8::StaticOrder S; S.init(M, 2 * DFF, F.G, (int)blockIdx.x); pg8::EpiSwiglu E{ACT, DFF, RSQ};
          for (int rep = 0; rep < REPG(10); ++rep) pg8::gemm_phase<true, true>(F.lds, g, S, E); }
        GRID_BAR();
        { KBASE(); pg8::Gemm g{ACT, W_out_t + (size_t)1024 * 2816, M, D, DFF}; pg8::StaticOrder S; S.init(M, D, F.G, (int)blockIdx.x); pg8::EpiResid E{(unsigned char*)KARG(28), 0.5f};
          pg8::gemm_phase<true, true>(F.lds, g, S, E); }
        GRID_BAR();
    }
    PHASE_IDS();
    for (int m = gw; m < M; m += NGW) {
        f32x4* xr = (f32x4*)(H + (size_t)m * D) + lane; const f32x4* gr = (const f32x4*)final_norm + lane;
        f32x4 v[4]; float ss = 0.f;
#pragma unroll
        for (int j = 0; j < 4; ++j) { const u32x2 w = *(const u32x2*)(H16 + pg8::blk32(m, 4 * lane + 256 * j, D)); v[j] = (f32x4){hlo(w.x), hhi(w.x), hlo(w.y), hhi(w.y)}; ss += (v[j].x * v[j].x + v[j].y * v[j].y) + (v[j].z * v[j].z + v[j].w * v[j].w); }
        const float r = __builtin_amdgcn_rsqf(wave_sum(ss) * (1.f / D) + 1e-6f);
#pragma unroll
        for (int j = 0; j < 4; ++j) xr[64 * j] = v[j] * r * gr[64 * j];
    }
}

extern "C" void kernel_launch(void* const* d_in, const int* in_sizes, int n_in, void* d_out, int out_size, void* d_ws, size_t ws_size, hipStream_t stream) {
    static int grid = 0;
    if (grid == 0) {
        if (n_in != 27 || out_size != M * D || ws_size < WS_END) { fprintf(stderr, "kernel_launch: unexpected problem (n_in %d, out %d, ws %zu < %zu)\n", n_in, out_size, ws_size, (size_t)WS_END); grid = -1; return; }
        int dev = 0, cus = 0, per_cu = 0;
        if (hipGetDevice(&dev) != hipSuccess || hipDeviceGetAttribute(&cus, hipDeviceAttributeMultiprocessorCount, dev) != hipSuccess) { grid = -1; return; }
        if (hipFuncSetAttribute((const void*)fwd_kernel, hipFuncAttributeMaxDynamicSharedMemorySize, LDS_BYTES) != hipSuccess) { fprintf(stderr, "kernel_launch: hipFuncSetAttribute failed\n"); grid = -1; return; }
        if (hipOccupancyMaxActiveBlocksPerMultiprocessor(&per_cu, (const void*)fwd_kernel, NWAVES * 64, LDS_BYTES) != hipSuccess || per_cu < 1) { fprintf(stderr, "kernel_launch: occupancy query says %d\n", per_cu); }
        (void)hipGetLastError();
        grid = cus;
    }
    if (grid < 0) return;
    if (hipMemsetAsync((char*)d_ws + WS_CTL, 0, CTL_ZERO_BYTES, stream) != hipSuccess) return;
    Args a{};
    for (int i = 0; i < 27; ++i) a.in[i] = d_in[i];
    a.out = (float*)d_out; a.ws = (unsigned char*)d_ws; a.pad0 = 0; a.pad1 = 0;
    hipLaunchKernelGGL(fwd_kernel, dim3(grid), dim3(NWAVES * 64), LDS_BYTES, stream, a);
}
```

```cpp
#include <hip/hip_runtime.h>
#include <cstdio>
#include <cstdint>

#define GAS __attribute__((address_space(1)))
#define LAS __attribute__((address_space(3)))
#define CAS __attribute__((address_space(4)))
typedef unsigned short u16;
typedef _Float16 h16x8 __attribute__((ext_vector_type(8)));
typedef _Float16 h16x4 __attribute__((ext_vector_type(4)));
typedef _Float16 h16x2 __attribute__((ext_vector_type(2)));
typedef float f32x4 __attribute__((ext_vector_type(4)));
typedef float f32x2 __attribute__((ext_vector_type(2)));
typedef unsigned u32x4 __attribute__((ext_vector_type(4)));
typedef unsigned u32x2 __attribute__((ext_vector_type(2)));

__device__ __forceinline__ unsigned pk2(float lo, float hi) { f32x2 v = {lo, hi}; h16x2 h = __builtin_convertvector(v, h16x2); return __builtin_bit_cast(unsigned, h); }
typedef __bf16 b16x2 __attribute__((ext_vector_type(2)));
__device__ __forceinline__ unsigned pk2b(float lo, float hi) { f32x2 v = {lo, hi}; b16x2 h = __builtin_convertvector(v, b16x2); return __builtin_bit_cast(unsigned, h); }
__device__ __forceinline__ u16 f2b(float f) { return (u16)(pk2b(f, 0.f) & 0xffffu); }
__device__ __forceinline__ float blo(unsigned u) { return __builtin_bit_cast(float, u << 16); }
__device__ __forceinline__ float bhi(unsigned u) { return __builtin_bit_cast(float, u & 0xffff0000u); }
__device__ __forceinline__ u16 f2h(float f) { _Float16 h = (_Float16)f; return __builtin_bit_cast(u16, h); }
__device__ __forceinline__ float h2f(u16 u) { return (float)__builtin_bit_cast(_Float16, u); }
__device__ __forceinline__ float hlo(unsigned u) { return (float)__builtin_bit_cast(h16x2, u)[0]; }
__device__ __forceinline__ float hhi(unsigned u) { return (float)__builtin_bit_cast(h16x2, u)[1]; }
__device__ __forceinline__ float fsigmoid(float x) { return __builtin_amdgcn_rcpf(1.0f + __builtin_amdgcn_exp2f(-1.44269504089f * x)); }
__device__ __forceinline__ float fsilu(float x) { return x * fsigmoid(x); }
#define DPP_ADD_(v, ctrl, rmask) (v) += __builtin_bit_cast(float, __builtin_amdgcn_update_dpp(0, __builtin_bit_cast(int, (v)), (ctrl), (rmask), 0xf, false))
__device__ __forceinline__ float sum16(float v) {
    DPP_ADD_(v, 0xB1, 0xf); DPP_ADD_(v, 0x4E, 0xf); DPP_ADD_(v, 0x141, 0xf); DPP_ADD_(v, 0x140, 0xf); return v; }
__device__ __forceinline__ float wave_sum(float v) {
    v = sum16(v); DPP_ADD_(v, 0x142, 0xa); DPP_ADD_(v, 0x143, 0xc);
    return __builtin_bit_cast(float, __builtin_amdgcn_readlane(__builtin_bit_cast(int, v), 63)); }
__device__ __forceinline__ float xsum32(float v) {
    const unsigned u = __builtin_bit_cast(unsigned, v); auto r = __builtin_amdgcn_permlane32_swap(u, u, false, false); const unsigned a = r[0], b = r[1];
    return __builtin_bit_cast(float, a) + __builtin_bit_cast(float, b); }
__device__ __forceinline__ float xsum16(float v) {
    const unsigned u = __builtin_bit_cast(unsigned, v); auto r = __builtin_amdgcn_permlane16_swap(u, u, false, false); const unsigned a = r[0], b = r[1];
    return __builtin_bit_cast(float, a) + __builtin_bit_cast(float, b); }
__device__ __forceinline__ void pair16(float& a, float& b) {
    auto r = __builtin_amdgcn_permlane16_swap(__builtin_bit_cast(unsigned, a), __builtin_bit_cast(unsigned, b), false, false); const unsigned x = r[0], y = r[1];
    a = __builtin_bit_cast(float, x); b = __builtin_bit_cast(float, y); }
__device__ __forceinline__ float xmax32(float v) { const unsigned u = __builtin_bit_cast(unsigned, v); auto r = __builtin_amdgcn_permlane32_swap(u, u, false, false); const unsigned a = r[0], b = r[1];
    return fmaxf(__builtin_bit_cast(float, a), __builtin_bit_cast(float, b)); }
__device__ __forceinline__ float xmax16(float v) { const unsigned u = __builtin_bit_cast(unsigned, v); auto r = __builtin_amdgcn_permlane16_swap(u, u, false, false); const unsigned a = r[0], b = r[1];
    return fmaxf(__builtin_bit_cast(float, a), __builtin_bit_cast(float, b)); }
__device__ __forceinline__ int fresh_tid() { int t = threadIdx.x; asm volatile("" : "+v"(t)); return t; }
#define MFMA16(a, b, c) __builtin_amdgcn_mfma_f32_16x16x32_f16((a), (b), (c), 0, 0, 0)
typedef short s16x4 __attribute__((ext_vector_type(4)));
typedef short s16x8 __attribute__((ext_vector_type(8)));
__device__ __forceinline__ h16x8 lds_tr16(const __attribute__((address_space(3))) unsigned short* img, int pitch, int k0, int n0, int lane) {
    const int g = lane >> 4, q = (lane & 15) >> 2, p = lane & 3;
    const __attribute__((address_space(3))) unsigned short* a = img + (k0 + 8 * g + q) * pitch + n0 + 4 * p;
    const s16x4 r0 = __builtin_amdgcn_ds_read_tr16_b64_v4i16((__attribute__((address_space(3))) s16x4*)a);
    const s16x4 r1 = __builtin_amdgcn_ds_read_tr16_b64_v4i16((__attribute__((address_space(3))) s16x4*)(a + 4 * pitch));
    return __builtin_bit_cast(h16x8, __builtin_shufflevector(r0, r1, 0, 1, 2, 3, 4, 5, 6, 7));
}

namespace pg8 {
#ifndef PG8_ZC
#define PG8_ZC 1
#endif
#ifndef PG8_SPLIT
#define PG8_SPLIT false
#endif
constexpr int BM = 256, BK = 64, HALF = 128, HTB = HALF * BK * 2, STAGE_BYTES = 8 * HTB, NXCD = 8, WGM = 8;
__host__ __device__ __forceinline__ int lds_byte(int r, int c) { const int st = (r >> 4) * 2 + (c >> 5), rr = r & 15, cc = c & 31, ob = rr * 64 + cc * 2; return st * 1024 + (ob ^ (((ob >> 9) & 1) << 5)); }
__host__ __device__ __forceinline__ void stage_rc(int b, int& R, int& C) { const int st = b / 1024, sb = b % 1024, swz = sb ^ (((sb >> 9) & 1) << 5); R = (st >> 1) * 16 + swz / 64; C = (st & 1) * 32 + (swz % 64) / 2; }
__host__ __device__ __forceinline__ int perm32(int rho) { const int n = rho >> 4, i = rho & 15; return 8 * (i >> 2) + 4 * n + (i & 3); }
__host__ __device__ __forceinline__ size_t blk32(int row, int col, int K) { return ((size_t)(row >> 5) * (K >> 5) + (col >> 5)) * 1024 + (row & 31) * 32 + (col & 31); }
struct Unit { int pm, pn; };
struct Gemm { const u16* A; const u16* Bt; int M, N, K; int lda, asplit; unsigned aofs; };
struct StaticOrder {
    int nM, nN, nwg, G, c;
    __host__ __device__ void init(int M, int N, int G_, int c_) { nM = M / BM; nN = N / BM; nwg = nM * nN; G = G_; c = c_; }
    __host__ __device__ bool next(int i, Unit& u) const {
        const long L = (long)i * G + c; if (L >= nwg) return false;
        int wgid = (int)L; { const int q = nwg / NXCD, r = nwg % NXCD, xcd = wgid % NXCD, off = wgid / NXCD; wgid = (xcd < r ? xcd * (q + 1) : r * (q + 1) + (xcd - r) * q) + off; }
        const int nig = WGM * nN, gid = wgid / nig, fm = gid * WGM, gsz = (nM - fm) < WGM ? (nM - fm) : WGM;
        u.pm = fm + ((wgid % nig) % gsz); u.pn = (wgid % nig) / gsz; return true;
    }
    __device__ __forceinline__ void a_ready(const Unit&, int) const {}
    __device__ __forceinline__ void done(const Unit&) const {}
};
__device__ __forceinline__ void load_scales(LAS float* dst, const float* rsq, int pm, int tid) {
    const int r = tid >> 1, hf = tid & 1;
    const f32x4* p = (const f32x4*)(rsq + (size_t)pm * 4096) + (unsigned)(tid * 2);
    const f32x4 a = p[0], b = p[1]; const f32x4 t = a + b; float s = (t[0] + t[1]) + (t[2] + t[3]);
    s += __builtin_bit_cast(float, __builtin_amdgcn_update_dpp(0, __builtin_bit_cast(int, s), 0xB1, 0xF, 0xF, true));
    if (hf == 0) dst[(((r >> 6) & 1) * 16 + (r & 15)) * 8 + (r >> 7) * 4 + ((r >> 4) & 3)] = __builtin_amdgcn_rsqf(s * (1.0f / 1024.0f) + 1e-6f);
}
template <bool RS> struct EpiStoreH {
    static constexpr bool PERM = true, SPLIT = PG8_SPLIT, HALVES = true, RS_LDS = RS;
    static constexpr int NST = 8;
    u16* O; int ldc; int split_cols; size_t split_stride; const float* rsv;
    template <int AI> __device__ __forceinline__ void half(const f32x4 (&acc)[2][2][4][2], const Unit& u, int wr, int wc, int fr_in, int fq_in, const LAS float* rs) const {
        int fr = fr_in, fq = fq_in; asm volatile("" : "+v"(fr), "+v"(fq));
        const int row0 = u.pm * BM + wr * 64 + fr + AI * HALF; int colt = u.pn * BM; u16* base = O;
        if (split_cols) { const int t = colt / split_cols; base += (size_t)t * split_stride; colt -= t * split_cols; }
        const int col0 = colt + wc * 32 + 8 * fq;
        f32x4 rsa = {1.f, 1.f, 1.f, 1.f};
        if (RS) rsa = *(const LAS f32x4*)(rs + (wr * 16 + fr) * 8 + AI * 4);
        u16* p0 = base + blk32(row0, col0, ldc);
#pragma unroll
        for (int m = 0; m < 4; ++m) {
            const float rsc = rsa[m];
#pragma unroll
            for (int bj = 0; bj < 2; ++bj) { const f32x4 v0 = acc[AI][bj][m][0] * rsc, v1 = acc[AI][bj][m][1] * rsc;
                u32x4 w; w.x = pk2(v0[0], v0[1]); w.y = pk2(v0[2], v0[3]); w.z = pk2(v1[0], v1[1]); w.w = pk2(v1[2], v1[3]);
                __builtin_nontemporal_store(w, (u32x4*)(p0 + (size_t)(m >> 1) * (ldc >> 5) * 1024 + (m & 1) * 512 + bj * (HALF / 32) * 1024)); } }
    }
};
struct EpiSwiglu {
    static constexpr bool PERM = true, SPLIT = PG8_SPLIT, HALVES = true, RS_LDS = true;
    static constexpr int NST = 4;
    u16* O; int ldc; const float* rsv;
    template <int AI> __device__ __forceinline__ void half(const f32x4 (&acc)[2][2][4][2], const Unit& u, int wr, int wc, int fr_in, int fq_in, const LAS float* rs) const {
        int fr = fr_in, fq = fq_in; asm volatile("" : "+v"(fr), "+v"(fq));
        const int row0 = u.pm * BM + wr * 64 + fr + AI * HALF, col0 = u.pn * HALF + wc * 32 + 8 * fq;
        const f32x4 rsa = *(const LAS f32x4*)(rs + (wr * 16 + fr) * 8 + AI * 4);
        u16* p0 = O + blk32(row0, col0, ldc);
#pragma unroll
        for (int m = 0; m < 4; ++m) { u16* rowp = p0 + (size_t)(m >> 1) * (ldc >> 5) * 1024 + (m & 1) * 512;
            const float rsc = rsa[m]; const f32x2 rs2 = {rsc, rsc};
            unsigned ow[4];
#pragma unroll
            for (int p = 0; p < 4; ++p) {
                const f32x4 ga = acc[AI][0][m][p >> 1], ua = acc[AI][1][m][p >> 1];
                const f32x2 g2 = (f32x2){ga[2 * (p & 1)], ga[2 * (p & 1) + 1]} * rs2, u2 = (f32x2){ua[2 * (p & 1)], ua[2 * (p & 1) + 1]} * rs2;
                const f32x2 t2 = g2 * (f32x2){-1.44269504089f, -1.44269504089f};
                const f32x2 d2 = (f32x2){__builtin_amdgcn_exp2f(t2.x), __builtin_amdgcn_exp2f(t2.y)} + (f32x2){1.0f, 1.0f};
                const f32x2 o2 = (g2 * (f32x2){__builtin_amdgcn_rcpf(d2.x), __builtin_amdgcn_rcpf(d2.y)}) * u2;
                ow[p] = pk2b(o2.x, o2.y); }
            u32x4 w; w.x = ow[0]; w.y = ow[1]; w.z = ow[2]; w.w = ow[3];
            __builtin_nontemporal_store(w, (u32x4*)rowp); }
    }
};
constexpr size_t H16_OFF = (size_t)127 << 20, RSQ_OFF = (size_t)255 << 20;
struct EpiResid {
    static constexpr bool PERM = true, SPLIT = false, HALVES = false, RS_LDS = false;
    static constexpr int NST = 0;
    static constexpr int ldc = 1024;
    static constexpr const float* rsv = nullptr;
    template <int AI> __device__ __forceinline__ void half(const f32x4 (&)[2][2][4][2], const Unit&, int, int, int, int, const LAS float*) const {}
    unsigned char* wsb; float scale;
    __device__ __forceinline__ void operator()(const f32x4 (&acc)[2][2][4][2], const Unit& u, int wr, int wc, int fr_in, int fq_in, int, const LAS float*) const {
        int fr = fr_in, fq = fq_in; asm volatile("" : "+v"(fr), "+v"(fq));
        const int row0 = u.pm * BM + wr * 64 + fr, col0 = u.pn * BM + wc * 32 + 8 * fq;
        u16* h16 = (u16*)(wsb + H16_OFF); float* rsq = (float*)(wsb + RSQ_OFF);
#pragma unroll
        for (int ai = 0; ai < 2; ++ai)
#pragma unroll
            for (int m = 0; m < 4; ++m) { const int rw = row0 + ai * HALF + m * 16; float sq = 0.f;
                u32x4 hv[2];
#pragma unroll
                for (int bj = 0; bj < 2; ++bj) hv[bj] = *(const u32x4*)(h16 + blk32(rw, col0 + bj * HALF, ldc));
#pragma unroll
                for (int bj = 0; bj < 2; ++bj) { unsigned ow[4];
#pragma unroll
                    for (int n = 0; n < 2; ++n) { const unsigned w0 = hv[bj][2 * n], w1 = hv[bj][2 * n + 1];
                        const f32x4 bs = {blo(w0), bhi(w0), blo(w1), bhi(w1)}; const f32x4 o = bs + acc[ai][bj][m][n] * scale;
                        ow[2 * n] = pk2b(o[0], o[1]); ow[2 * n + 1] = pk2b(o[2], o[3]);
                        sq += (o[0] * o[0] + o[1] * o[1]) + (o[2] * o[2] + o[3] * o[3]); }
                    u32x4 w; w.x = ow[0]; w.y = ow[1]; w.z = ow[2]; w.w = ow[3]; *(u32x4*)(h16 + blk32(rw, col0 + bj * HALF, ldc)) = w; }
                sq = xsum16(sq); sq = xsum32(sq);
                if (fq == 0) rsq[(size_t)(row0 + ai * HALF + m * 16) * 16 + 4 * u.pn + wc] = sq;
                asm volatile("" ::: "memory"); }
    }
};
struct EpiGate {
    static constexpr bool PERM = true, SPLIT = false, HALVES = false, RS_LDS = true;
    static constexpr int NST = 0;
    template <int AI> __device__ __forceinline__ void half(const f32x4 (&)[2][2][4][2], const Unit&, int, int, int, int, const LAS float*) const {}
    const float* ba; const float* bb; const u16* tA; const u16* tB; u16* O; int ldc; const float* rsv;
    __device__ __forceinline__ void operator()(const f32x4 (&acc)[2][2][4][2], const Unit& u, int wr, int wc, int fr_in, int fq_in, int ui, const LAS float* rs) const {
        int fr = fr_in, fq = fq_in; asm volatile("" : "+v"(fr), "+v"(fq));
        const int row0 = u.pm * BM + wr * 64 + fr, col0 = u.pn * HALF + wc * 32 + 8 * fq;
        float va[8], vb[8];
#pragma unroll
        for (int j = 0; j < 8; ++j) { va[j] = ba[col0 + j]; vb[j] = bb[col0 + j]; }
        f32x4 rsa[2]; { const LAS f32x4* rp = (const LAS f32x4*)(rs + (wr * 16 + fr) * 8); rsa[0] = rp[0]; rsa[1] = rp[1]; }
#pragma unroll
        for (int ai = 0; ai < 2; ++ai)
#pragma unroll
            for (int m = 0; m < 4; ++m) { const size_t off = (size_t)(row0 + ai * HALF + m * 16) * ldc + col0;
                const size_t boff = blk32(row0 + ai * HALF + m * 16, col0, ldc); const u32x4 a4 = *(const u32x4*)(tA + boff), b4 = *(const u32x4*)(tB + boff);
                const float rs = rsa[ai][m];
                const f32x2 rs2 = {rs, rs}; unsigned ow[4];
#pragma unroll
                for (int p = 0; p < 4; ++p) {
                    const f32x4 xa = acc[ai][0][m][p >> 1], xb = acc[ai][1][m][p >> 1]; const int e = 2 * p;
                    const f32x2 pa = (f32x2){xa[2 * (p & 1)], xa[2 * (p & 1) + 1]} * rs2 + (f32x2){va[e], va[e + 1]}, pb = (f32x2){xb[2 * (p & 1)], xb[2 * (p & 1) + 1]} * rs2 + (f32x2){vb[e], vb[e + 1]};
                    const f32x2 ta2 = pa * (f32x2){-1.44269504089f, -1.44269504089f}, tb2 = pb * (f32x2){-1.44269504089f, -1.44269504089f};
                    const f32x2 da = (f32x2){__builtin_amdgcn_exp2f(ta2.x), __builtin_amdgcn_exp2f(ta2.y)} + (f32x2){1.0f, 1.0f}, db = (f32x2){__builtin_amdgcn_exp2f(tb2.x), __builtin_amdgcn_exp2f(tb2.y)} + (f32x2){1.0f, 1.0f};
                    const f32x2 tA = {hlo(a4[p]), hhi(a4[p])}, tB = {hlo(b4[p]), hhi(b4[p])};
                    const f32x2 o2 = (f32x2){__builtin_amdgcn_rcpf(da.x), __builtin_amdgcn_rcpf(da.y)} * tA + (f32x2){__builtin_amdgcn_rcpf(db.x), __builtin_amdgcn_rcpf(db.y)} * tB;
                    ow[p] = pk2b(o2.x, o2.y); }
                u32x4 w; w.x = ow[0]; w.y = ow[1]; w.z = ow[2]; w.w = ow[3];
                __builtin_nontemporal_store(w, (u32x4*)(O + blk32(row0 + ai * HALF + m * 16, col0, ldc))); }
    }
};

typedef __bf16 bf16x8 __attribute__((ext_vector_type(8)));
#define MFMA16B(a, b, c) __builtin_amdgcn_mfma_f32_16x16x32_bf16(__builtin_bit_cast(bf16x8, (a)), __builtin_bit_cast(bf16x8, (b)), (c), 0, 0, 0)
template <bool ABLK, bool BBLK, class Epi, class Sched>
__device__ __forceinline__ void gemm_phase(LAS unsigned char* lds, const Gemm g, const Sched& S, const Epi& E) {
    const int tid = fresh_tid(), wid = __builtin_amdgcn_readfirstlane(tid >> 6), lane = tid & 63, wr = wid >> 2, wc = wid & 3, fr = lane & 15, fq = lane >> 4;
    const int K = g.K, KA = g.lda ? g.lda : K; int nt = K / BK; asm volatile("" : "+s"(nt));
    unsigned voffA, voffB;
    { int R, C; stage_rc(tid * 16, R, C); const int Rb = Epi::PERM ? ((R & ~31) + perm32(R & 31)) : R;
      voffA = ABLK ? (unsigned)blk32(R, C, KA) * 2u : (unsigned)(R * KA + C) * 2u; voffB = BBLK ? (unsigned)blk32(Rb, C, K) * 2u : (unsigned)(Rb * K + C) * 2u; }
    const size_t sA = (size_t)64 * KA * 2, sB = (size_t)64 * K * 2;
    const size_t kstepA = ABLK ? (size_t)4096 : (size_t)(BK * 2), kstepB = BBLK ? (size_t)4096 : (size_t)(BK * 2);
    const size_t hstep = (size_t)HALF * K * 2, hstepA = (size_t)HALF * KA * 2;
    const size_t tstep = 2 * hstep, tstepA = 2 * hstepA;
    const unsigned ldsw = (unsigned)wid * 1024u;
    const int aoff = lds_byte(wr * 64 + fr, fq * 8), boff = lds_byte(wc * 32 + fr, fq * 8);
#define PG8_SA(b, h) (((b) * 2 + (h)) * HTB)
#define PG8_SB(b, h) ((4 + (b) * 2 + (h)) * HTB)
#define PG8_STAGE(bufoff, gbase, voff) do { _Pragma("unroll") for (int _i = 0; _i < 2; ++_i) \
        __builtin_amdgcn_global_load_lds((const unsigned*)((const char*)(gbase) + _i * PG8_STEP_##voff + (voff)), (LAS unsigned*)(lds + (bufoff) + ldsw + _i * 8192), 16, 0, 0); } while (0)
#define PG8_STEP_voffA sA
#define PG8_STEP_voffB sB
#define PG8_LDA(dst, b, h) do { _Pragma("unroll") for (int m = 0; m < 4; ++m) _Pragma("unroll") for (int k = 0; k < 2; ++k) dst[m][k] = *(const LAS h16x8*)(lds + PG8_SA(b, h) + aoff + m * 2048 + k * 1024); } while (0)
#define PG8_LDB(dst, b, h) do { _Pragma("unroll") for (int n = 0; n < 2; ++n) _Pragma("unroll") for (int k = 0; k < 2; ++k) dst[n][k] = *(const LAS h16x8*)(lds + PG8_SB(b, h) + boff + n * 2048 + k * 1024); } while (0)
#define PG8_MMA(ai, bj, At, Bt) do { __builtin_amdgcn_s_setprio(1); _Pragma("unroll") for (int m = 0; m < 4; ++m) _Pragma("unroll") for (int n = 0; n < 2; ++n) _Pragma("unroll") for (int k = 0; k < 2; ++k) \
        acc[ai][bj][m][n] = MFMA16B(Bt[n][k], At[m][k], acc[ai][bj][m][n]); __builtin_amdgcn_s_setprio(0); } while (0)
#define PG8_MMAZ(ai, bj, At, Bt) do { __builtin_amdgcn_s_setprio(1); _Pragma("unroll") for (int m = 0; m < 4; ++m) _Pragma("unroll") for (int n = 0; n < 2; ++n) { \
        acc[ai][bj][m][n] = MFMA16B(Bt[n][0], At[m][0], zero4); acc[ai][bj][m][n] = MFMA16B(Bt[n][1], At[m][1], acc[ai][bj][m][n]); } __builtin_amdgcn_s_setprio(0); } while (0)
#define PG8_WAIT_V(n) asm volatile("s_waitcnt vmcnt(" #n ")" ::: "memory")
#define PG8_WAIT_VN(n) asm volatile("s_waitcnt vmcnt(%0)" :: "n"(n) : "memory")
#define PG8_WAIT_L(n) asm volatile("s_waitcnt lgkmcnt(" #n ")" ::: "memory")
#define PG8_BAR __builtin_amdgcn_s_barrier()
#define PG8_SCHED __builtin_amdgcn_sched_barrier(0)
#define PG8_H1P E.template half<1>(acc, prv, wr, wc, fr, fq, rsl + psb * 256)
#define PG8_H0C E.template half<0>(acc, cur, wr, wc, fr, fq, rsl + sb * 256)
#define PG8_ZERO(a) do { _Pragma("unroll") for (int b_ = 0; b_ < 2; ++b_) _Pragma("unroll") for (int m_ = 0; m_ < 4; ++m_) _Pragma("unroll") for (int n_ = 0; n_ < 2; ++n_) acc[a][b_][m_][n_] = zero4; } while (0)
    Unit cur, nxt, prv; int ui = 0; prv.pm = 0; prv.pn = 0;
    if (!S.next(0, cur)) return;
    f32x4 acc[2][2][4][2]; const f32x4 zero4 = {0.f, 0.f, 0.f, 0.f};
    PG8_ZERO(0); PG8_ZERO(1);
    h16x8 At[4][2], B0[2][2], B1[2][2];
    LAS float* rsl = (LAS float*)(lds + STAGE_BYTES);
    int sb = 0, psb = 0;
    if (Epi::RS_LDS) load_scales(rsl, E.rsv, cur.pm, tid);
    const char* cA = (const char*)g.A + (size_t)cur.pm * tstepA + ((g.asplit && cur.pn >= g.asplit) ? g.aofs : 0u); const char* cB = (const char*)g.Bt + (size_t)cur.pn * tstep;
    S.a_ready(cur, 0);
    PG8_STAGE(PG8_SB(0, 0), cB, voffB); PG8_STAGE(PG8_SB(0, 1), cB + hstep, voffB); PG8_STAGE(PG8_SA(0, 0), cA, voffA); PG8_STAGE(PG8_SA(0, 1), cA + hstepA, voffA);
    if (wr == 1) PG8_BAR;
    PG8_WAIT_V(2); PG8_BAR;
    PG8_STAGE(PG8_SB(1, 0), cB + kstepB, voffB); PG8_STAGE(PG8_SA(1, 0), cA + kstepA, voffA); PG8_STAGE(PG8_SB(1, 1), cB + hstep + kstepB, voffB);
    PG8_WAIT_V(6); PG8_BAR;
    for (;;) {
        const bool has_next = S.next(ui + 1, nxt);
        const char* nA = has_next ? (const char*)g.A + (size_t)nxt.pm * tstepA + ((g.asplit && nxt.pn >= g.asplit) ? g.aofs : 0u) : cA; const char* nB = has_next ? (const char*)g.Bt + (size_t)nxt.pn * tstep : cB;
        for (int t = 0; t < nt; t += 2) {
            const bool last = (t == nt - 2), fe = Epi::SPLIT && t == 0 && ui > 0;
            const char* a1 = cA + (size_t)(t + 1) * kstepA;
            const char* a2 = last ? nA : cA + (size_t)(t + 2) * kstepA; const char* b2 = last ? nB : cB + (size_t)(t + 2) * kstepB;
            const char* a3 = a2 + kstepA; const char* b3 = b2 + kstepB;
            PG8_LDB(B0, 0, 0); PG8_LDB(B1, 0, 1); PG8_SCHED; PG8_LDA(At, 0, 0); PG8_STAGE(PG8_SA(1, 1), a1 + hstepA, voffA);
            if (fe) { PG8_H1P; PG8_ZERO(1); PG8_WAIT_VN(8 + 2 * Epi::NST); } else PG8_WAIT_V(8);
            PG8_WAIT_L(0); PG8_BAR; PG8_MMA(0, 0, At, B0); PG8_MMA(0, 1, At, B1); PG8_BAR; PG8_SCHED;
            PG8_LDA(At, 0, 1); PG8_STAGE(PG8_SB(0, 0), b2, voffB); PG8_STAGE(PG8_SB(0, 1), b2 + hstep, voffB); PG8_STAGE(PG8_SA(0, 0), a2, voffA);
            if (fe) PG8_WAIT_VN(8 + 2 * Epi::NST); else PG8_WAIT_V(8);
            PG8_WAIT_L(0); PG8_BAR; PG8_MMA(1, 0, At, B0); PG8_MMA(1, 1, At, B1); PG8_BAR; PG8_SCHED;
            PG8_LDB(B0, 1, 0); PG8_LDB(B1, 1, 1); PG8_SCHED; PG8_LDA(At, 1, 0); PG8_STAGE(PG8_SA(0, 1), a2 + hstepA, voffA);
            if (fe) PG8_WAIT_VN(8 + Epi::NST); else PG8_WAIT_V(8);
            PG8_WAIT_L(0); PG8_BAR; PG8_MMA(0, 0, At, B0); PG8_MMA(0, 1, At, B1); PG8_BAR; PG8_SCHED;
            PG8_LDA(At, 1, 1); PG8_STAGE(PG8_SB(1, 0), b3, voffB); PG8_STAGE(PG8_SB(1, 1), b3 + hstep, voffB); PG8_STAGE(PG8_SA(1, 0), a3, voffA);
            if (Epi::SPLIT && last) { PG8_SCHED; PG8_H0C; PG8_ZERO(0); PG8_WAIT_VN(8 + Epi::NST); } else PG8_WAIT_V(8);
            PG8_WAIT_L(0); PG8_BAR; PG8_MMA(1, 0, At, B0); PG8_MMA(1, 1, At, B1); PG8_BAR; PG8_SCHED;
        }
        if constexpr (!Epi::SPLIT) {
            if (wr == 0) PG8_BAR;
            if constexpr (Epi::HALVES) { E.template half<0>(acc, cur, wr, wc, fr, fq, rsl + sb * 256); E.template half<1>(acc, cur, wr, wc, fr, fq, rsl + sb * 256); } else E(acc, cur, wr, wc, fr, fq, ui, rsl + sb * 256);
            if (!has_next) break;
            if (Epi::RS_LDS && nxt.pm != cur.pm) { sb ^= 1; load_scales(rsl + sb * 256, E.rsv, nxt.pm, tid); }
            cur = nxt; cA = nA; cB = nB; ++ui;
            if (wr == 1) PG8_BAR;
            PG8_SCHED; PG8_ZERO(0); PG8_ZERO(1); PG8_SCHED;
        } else {
            if (!has_next) { E.template half<1>(acc, cur, wr, wc, fr, fq, rsl + sb * 256); break; }
            prv = cur; psb = sb;
            if (Epi::RS_LDS && nxt.pm != cur.pm) { sb ^= 1; load_scales(rsl + sb * 256, E.rsv, nxt.pm, tid); }
            cur = nxt; cA = nA; cB = nB; ++ui;
        }
    }
    if (Epi::SPLIT) { if (wr == 0) PG8_BAR; }
    PG8_WAIT_V(0);
    PG8_BAR;
#undef PG8_ZERO
#undef PG8_H1P
#undef PG8_H0C
#undef PG8_NONE
#undef PG8_SA
#undef PG8_SB
#undef PG8_STAGE
#undef PG8_STEP_voffA
#undef PG8_STEP_voffB
#undef PG8_LDA
#undef PG8_LDB
#undef PG8_MMA
#undef PG8_MMAZ
#undef PG8_WAIT_V
#undef PG8_WAIT_VN
#undef PG8_WAIT_L
#undef PG8_BAR
#undef PG8_SCHED
}
}

#ifndef REP_CONV
#define REP_CONV 1
#endif
#ifndef REP_RMS
#define REP_RMS 1
#endif
#ifndef REP_MASK
#define REP_MASK 0
#endif
#define REPG(i) ((((REP_MASK) >> (i)) & 1) + 1)
#ifndef REP_G
#define REP_G 1
#endif
#ifndef REP_PREP
#define REP_PREP 1
#endif
#ifndef REP_PA
#define REP_PA 1
#endif
#ifndef REP_PB
#define REP_PB 1
#endif
#ifndef REP_POST
#define REP_POST 1
#endif
#ifndef REP_RET
#define REP_RET 1
#endif
#ifndef REP_XATT
#define REP_XATT 1
#endif
#ifndef REP_BAR
#define REP_BAR 1
#endif
constexpr int NWAVES = 8;
constexpr int D = 1024, NBATCH = 32, T = 2048, DEPTH = 4, M = NBATCH * T, MEML = 256, MM = NBATCH * MEML, DFF = 2816;
constexpr int AW = 512, INW = 6912, CH = 32, NCH = T / CH;
constexpr size_t MiB = 1u << 20;
constexpr size_t WS_CTL = 0, CTL_ZERO_BYTES = 1 * MiB;
constexpr size_t WS_WB = 1 * MiB;
constexpr size_t WB_WIN = 0, WB_WOUT = WB_WIN + 2 * (size_t)5632 * 1024 * 2, WB_WA = WB_WOUT + 2 * (size_t)1024 * 2816 * 2, WB_WBM = WB_WA + (size_t)1792 * 1024 * 2,
                 WB_WG = WB_WBM + (size_t)3072 * 1024 * 2, WB_WLR = WB_WG + (size_t)2048 * 1024 * 2, WB_PA = WB_WLR + (size_t)1536 * 256 * 2, WB_PB = WB_PA + (size_t)1024 * 512 * 2,
                 WB_WMO = WB_PB + 2 * MiB, WB_WQ = WB_WMO + 2 * MiB, WB_WK = WB_WQ + 2 * MiB, WB_WV = WB_WK + 2 * MiB, WB_WO = WB_WV + 2 * MiB, WB_END = WB_WO + 2 * MiB;
static_assert(WB_END <= 62 * MiB, "weights region");
static_assert(pg8::H16_OFF == 127 * MiB && pg8::RSQ_OFF == 255 * MiB, "EpiResid offsets");
constexpr size_t WS_MEMN = 63 * MiB, WS_KM = 79 * MiB, WS_VTM = 95 * MiB, WS_COS = 111 * MiB, WS_SIN = 119 * MiB, WS_XN = 127 * MiB, WS_RSQ = 255 * MiB, WS_AR = 259 * MiB;
constexpr size_t AR_ZA = 0, AR_YS = 192 * MiB, AR_ALR = 224 * MiB, AR_WAG = 256 * MiB, AR_PAO = 448 * MiB, AR_ST = 641 * MiB, AR_YA = 645 * MiB, AR_END = 709 * MiB;
constexpr size_t AR_ZB = 0, AR_YB = 384 * MiB, AR_TMPA = 0, AR_TMPB = 128 * MiB, AR_MRG = 256 * MiB, AR_Q = 0, AR_O = 128 * MiB, AR_ACT = 0;
constexpr size_t WS_END = WS_AR + AR_END;
constexpr int CW_BAR = 4096;
constexpr int LDS_BYTES = 163840, LDSCTL_OFF = LDS_BYTES - 256, LDS_RS_OFF = 131072;

__constant__ float c_invfreq[32] = {
    1.0f, 0.7498942093324559f, 0.5623413251903491f, 0.4216965034285822f, 0.31622776601683794f, 0.23713737056616552f, 0.1778279410038923f, 0.1333521432163324f,
    0.1f, 0.07498942093324559f, 0.05623413251903491f, 0.04216965034285822f, 0.031622776601683794f, 0.023713737056616552f, 0.01778279410038923f, 0.01333521432163324f,
    0.01f, 0.007498942093324559f, 0.005623413251903491f, 0.004216965034285822f, 0.0031622776601683794f, 0.0023713737056616554f, 0.001778279410038923f, 0.001333521432163324f,
    0.001f, 0.0007498942093324559f, 0.0005623413251903491f, 0.0004216965034285822f, 0.00031622776601683794f, 0.00023713737056616554f, 0.0001778279410038923f, 0.0001333521432163324f };

#define XB_TMO      128
#define XB_XCNT(j)  (256  + 64 * (j))
#define XB_XSUB(j)  (1280 + 64 * (j))
#define XB_XGEN(j)  (2304 + 64 * (j))
#define XB_TOP      3328
#define XB_TOPGEN   3392
#define XCD_BAR_WORDS 3456
#define XB_SPIN_CAP (1u << 18)
__device__ __forceinline__ unsigned xb_ld(unsigned* p)              { return __hip_atomic_load(p, __ATOMIC_RELAXED, __HIP_MEMORY_SCOPE_AGENT); }
__device__ __forceinline__ unsigned xb_add(unsigned* p, unsigned v) { return __hip_atomic_fetch_add(p, v, __ATOMIC_RELAXED, __HIP_MEMORY_SCOPE_AGENT); }
__device__ __forceinline__ unsigned xb_xcc_id() { return (unsigned)__builtin_amdgcn_s_getreg((3 << 11) | 20) & 0xFu; }
#define XB_SPIN(cond, bar) do { unsigned _sp = 0; while (cond) { __builtin_amdgcn_s_sleep(1); \
    if ((++_sp & 255u) == 0u) { if (xb_ld(&(bar)[XB_TMO])) break; if (_sp > XB_SPIN_CAP) { atomicAdd(&(bar)[XB_TMO], 1u); break; } } } } while (0)
struct XcdBarrier { unsigned* bar; unsigned x; volatile LAS unsigned* st; };
__device__ __forceinline__ XcdBarrier xcd_barrier_post(unsigned* bar, volatile LAS unsigned* st) {
    XcdBarrier b; b.bar = bar; b.x = xb_xcc_id(); b.st = st;
    if (threadIdx.x == 0) (void)xb_add(&bar[XB_XCNT(b.x)], 1u);
    return b;
}
__device__ __forceinline__ void xcd_barrier_complete(unsigned* bar, unsigned x, unsigned& nloc, unsigned& nx) {
    const unsigned G = gridDim.x * gridDim.y * gridDim.z;
    unsigned sum, cnt, mine, sp = 0u;
    for (;;) {
        sum = 0u; cnt = 0u; mine = 0u;
#pragma unroll
        for (unsigned j = 0; j < 16; ++j) { const unsigned c = xb_ld(&bar[XB_XCNT(j)]); sum += c; cnt += (c > 0u) ? 1u : 0u; mine = (j == x) ? c : mine; }
        if (sum == G) break;
        __builtin_amdgcn_s_sleep(1);
        if ((++sp & 255u) == 0u) { if (xb_ld(&bar[XB_TMO])) break; if (sp > XB_SPIN_CAP) { atomicAdd(&bar[XB_TMO], 1u); break; } }
    }
    nloc = mine > 0u ? mine : 1u; nx = cnt > 0u ? cnt : 1u;
}
__device__ __forceinline__ void xcd_barrier(const XcdBarrier& b) {
    asm volatile("s_waitcnt vmcnt(0)" ::: "memory");
    __syncthreads();
    if (threadIdx.x == 0) {
        unsigned* bar = b.bar;
        __builtin_amdgcn_s_waitcnt(0);
        unsigned nloc = b.st[0], nx = b.st[1];
        if (nloc == 0u) { xcd_barrier_complete(bar, b.x, nloc, nx); b.st[0] = nloc; b.st[1] = nx; }
        const unsigned old = xb_add(&bar[XB_XSUB(b.x)], 1u);
        const unsigned gen = old / nloc;
        if (old + 1u == (gen + 1u) * nloc) {
            __builtin_amdgcn_fence(__ATOMIC_RELEASE, "agent");
            asm volatile("s_waitcnt vmcnt(0)" ::: "memory");
            const unsigned og = xb_add(&bar[XB_TOP], 1u);
            const unsigned tg = og / nx;
            if (og + 1u == (tg + 1u) * nx) xb_add(&bar[XB_TOPGEN], 1u);
            else XB_SPIN(xb_ld(&bar[XB_TOPGEN]) == tg, bar);
            __builtin_amdgcn_fence(__ATOMIC_ACQUIRE, "agent");
            xb_add(&bar[XB_XGEN(b.x)], 1u);
            asm volatile("s_waitcnt vmcnt(0)" ::: "memory");
        } else {
            XB_SPIN(xb_ld(&bar[XB_XGEN(b.x)]) == gen, bar);
            __builtin_amdgcn_fence(__ATOMIC_ACQUIRE, "agent");
            asm volatile("s_waitcnt vmcnt(0)" ::: "memory");
        }
    }
    __syncthreads();
}

struct Args { const void* in[27]; float* out; unsigned char* ws; int pad0, pad1; };
#define KBASE() const CAS char* kbase_ = (const CAS char*)__builtin_amdgcn_kernarg_segment_ptr(); asm volatile("" : "+s"(kbase_))
#define KARG(k) (*(void* const CAS*)(kbase_ + 8 * (k)))
struct Frame { LAS unsigned char* lds; int G; };
#define PHASE_IDS() KBASE(); const int tid = fresh_tid(), lane = tid & 63, wave = __builtin_amdgcn_readfirstlane(tid >> 6), gw = (int)blockIdx.x * NWAVES + wave, NGW = F.G * NWAVES; (void)lane; (void)gw; (void)NGW
#define LDS_WAIT() asm volatile("s_waitcnt lgkmcnt(0)" ::: "memory")
#define LDS_BARRIER() do { asm volatile("s_waitcnt lgkmcnt(0)" ::: "memory"); __builtin_amdgcn_s_barrier(); asm volatile("" ::: "memory"); } while (0)

__device__ __forceinline__ void conv_matrix(const Frame& F, const float* W, int ldw, int coff, int K, int N, u16* WT, int mode, int NH, const float* gain) {
    for (int rep = 0; rep < REP_CONV; ++rep) {
    PHASE_IDS();
    LAS float* scr = (LAS float*)(F.lds + wave * 8448);
    const int nblk = N / 32, nitems = (K / 64) * nblk;
    for (int item = gw; item < nitems; item += NGW) {
        const int kb = item / nblk, nb = item % nblk, k0 = 64 * kb, n0 = 32 * nb;
        int d0 = n0;
        if (mode == 1) { d0 = (n0 < NH) ? (n0 / 128) * 256 + (n0 % 128) : ((n0 - NH) / 128) * 256 + 128 + ((n0 - NH) % 128); }
#pragma unroll
        for (int i = 0; i < 8; ++i) { const int kk = 8 * i + (lane >> 3), n4 = 4 * (lane & 7);
            f32x4 w4 = *(const f32x4*)(W + (size_t)(k0 + kk) * ldw + coff + n0 + n4); if (gain) w4 = w4 * gain[k0 + kk];
            scr[kk * 33 + n4] = w4[0]; scr[kk * 33 + n4 + 1] = w4[1]; scr[kk * 33 + n4 + 2] = w4[2]; scr[kk * 33 + n4 + 3] = w4[3]; }
        LDS_WAIT(); asm volatile("" ::: "memory");
        const int c = lane & 7;
#pragma unroll
        for (int j = 0; j < 4; ++j) { const int n = (lane >> 3) + 8 * j; const LAS float* s = scr + (8 * c) * 33 + n;
            u32x4 o; o.x = pk2b(s[0 * 33], s[1 * 33]); o.y = pk2b(s[2 * 33], s[3 * 33]); o.z = pk2b(s[4 * 33], s[5 * 33]); o.w = pk2b(s[6 * 33], s[7 * 33]);
            *(u32x4*)(WT + pg8::blk32(d0 + n, k0 + 8 * c, K)) = o; }
        LDS_WAIT(); asm volatile("" ::: "memory");
    }
    }
}
__device__ __forceinline__ void rms_row_h(const float* xrow, const float* g, u16* obase, int row, int lane) {
    const f32x4* xr = (const f32x4*)xrow + lane; const f32x4* gr = (const f32x4*)g + lane;
    f32x4 v[4]; float s = 0.f;
#pragma unroll
    for (int j = 0; j < 4; ++j) { v[j] = xr[64 * j]; s += (v[j].x * v[j].x + v[j].y * v[j].y) + (v[j].z * v[j].z + v[j].w * v[j].w); }
    const float r = __builtin_amdgcn_rsqf(wave_sum(s) * (1.f / D) + 1e-6f);
#pragma unroll
    for (int j = 0; j < 4; ++j) { const f32x4 gg = gr[64 * j]; u32x2 w; w.x = pk2b(v[j].x * r * gg.x, v[j].y * r * gg.y); w.y = pk2b(v[j].z * r * gg.z, v[j].w * r * gg.w); *(u32x2*)(obase + pg8::blk32(row, 4 * lane + 256 * j, D)) = w; }
}
__device__ __forceinline__ void rms_phase(const Frame& F, const float* src, const float* g, u16* dst, int rows) {
    for (int rep = 0; rep < REP_RMS; ++rep) {
    PHASE_IDS();
    for (int m = gw; m < rows; m += NGW) rms_row_h(src + (size_t)m * D, g, dst, m, lane);
    }
}


typedef float f32x8 __attribute__((ext_vector_type(8)));
typedef float f32x16 __attribute__((ext_vector_type(16)));
#define SLOAD8(dst, base, off) asm volatile("s_load_dwordx8 %0, %1, " #off : "=s"(dst) : "s"(base))
#define SLOAD16(dst, base, off) asm volatile("s_load_dwordx16 %0, %1, " #off : "=s"(dst) : "s"(base))
__device__ __forceinline__ int rsv_index(int row) { const int pm = row >> 8, R = row & 255; return ((pm * 2 + ((R >> 6) & 1)) * 16 + (R & 15)) * 8 + (R >> 7) * 4 + ((R >> 4) & 3); }
#define RS_PASS() do { KBASE(); for (int m_ = (int)blockIdx.x * (NWAVES * 64) + fresh_tid(); m_ < M; m_ += F.G * NWAVES * 64) { const f32x4* p_ = (const f32x4*)(RSQ + (size_t)m_ * 16); \
        const f32x4 a_ = p_[0], b_ = p_[1], c_ = p_[2], d_ = p_[3]; const f32x4 t_ = (a_ + b_) + (c_ + d_); \
        RSV[rsv_index(m_)] = __builtin_amdgcn_rsqf(((t_[0] + t_[1]) + (t_[2] + t_[3])) * (1.0f / 1024.0f) + 1e-6f); } } while (0)
__device__ __forceinline__ size_t za_idx(int m, int col) { return (size_t)(col >> 8) * ((size_t)M * 256) + (size_t)m * 256 + (col & 255); }


#define x_in        ((const float*)KARG(0))
#define mem_in      ((const float*)KARG(1))
#define pos_in      ((const int*)KARG(2))
#define norm_g      ((const float*)KARG(3))
#define ffn_w_in    ((const float*)KARG(4))
#define ffn_w_out   ((const float*)KARG(5))
#define mix_w_in    ((const float*)KARG(6))
#define mix_gate_b  ((const float*)KARG(7))
#define shift_mu    ((const float*)KARG(8))
#define a_w0        ((const float*)KARG(9))
#define a_w_up      ((const float*)KARG(10))
#define a_a0        ((const float*)KARG(11))
#define a_a_up      ((const float*)KARG(12))
#define a_g_up      ((const float*)KARG(13))
#define a_k_k       ((const float*)KARG(14))
#define a_k_a       ((const float*)KARG(15))
#define a_r_k       ((const float*)KARG(16))
#define a_ln        ((const float*)KARG(17))
#define b_gn        ((const float*)KARG(18))
#define w_branch_a  ((const float*)KARG(19))
#define w_branch_b  ((const float*)KARG(20))
#define mix_w_out   ((const float*)KARG(21))
#define mem_norm    ((const float*)KARG(22))
#define cross_w_q   ((const float*)KARG(23))
#define cross_w_kv  ((const float*)KARG(24))
#define cross_w_o   ((const float*)KARG(25))
#define final_norm  ((const float*)KARG(26))
#define WSP(TY, off) ((TY*)((unsigned char*)KARG(28) + (off)))
#define W_in_t  WSP(u16, WS_WB + WB_WIN)
#define W_out_t WSP(u16, WS_WB + WB_WOUT)
#define W_A_t   WSP(u16, WS_WB + WB_WA)
#define W_B_t   WSP(u16, WS_WB + WB_WBM)
#define W_G_t   WSP(u16, WS_WB + WB_WG)
#define W_LR_t  WSP(u16, WS_WB + WB_WLR)
#define P_A_t   WSP(u16, WS_WB + WB_PA)
#define P_B_t   WSP(u16, WS_WB + WB_PB)
#define W_MO_t  WSP(u16, WS_WB + WB_WMO)
#define W_Q_t   WSP(u16, WS_WB + WB_WQ)
#define W_K_t   WSP(u16, WS_WB + WB_WK)
#define W_V_t   WSP(u16, WS_WB + WB_WV)
#define W_O_t   WSP(u16, WS_WB + WB_WO)
#define MEMN    WSP(u16, WS_MEMN)
#define KM      WSP(u16, WS_KM)
#define VTM     WSP(u16, WS_VTM)
#define COS     WSP(float, WS_COS)
#define SIN     WSP(float, WS_SIN)
#define H16     WSP(u16, WS_XN)
#define YS      WSP(u16, WS_AR + AR_YS)
#define RSQ     WSP(float, WS_RSQ)
#define RSV     WSP(float, WS_CTL + 512 * 1024)
#define ZA      WSP(u16, WS_AR + AR_ZA)
#define ALR     WSP(u16, WS_AR + AR_ALR)
#define WAG     WSP(u16, WS_AR + AR_WAG)
#define YA      WSP(u16, WS_AR + AR_YA)
#define ZB      WSP(u16, WS_AR + AR_ZB)
#define YB      WSP(u16, WS_AR + AR_YB)
#define TMPA    WSP(u16, WS_AR + AR_TMPA)
#define TMPB    WSP(u16, WS_AR + AR_TMPB)
#define MRG     WSP(u16, WS_AR + AR_MRG)
#define QX      WSP(u16, WS_AR + AR_Q)
#define OX      WSP(u16, WS_AR + AR_O)
#define ACT     WSP(u16, WS_AR + AR_ACT)
#define H       ((float*)KARG(27))

__global__ void __launch_bounds__(NWAVES * 64, 2) fwd_kernel(Args args) {
    extern __shared__ __attribute__((aligned(16))) unsigned char lds_raw[];
    Frame F;
    F.lds = (LAS unsigned char*)lds_raw;
    F.G = gridDim.x;
    volatile LAS unsigned* MISC = (volatile LAS unsigned*)(F.lds + LDSCTL_OFF);
    for (int u = threadIdx.x; u < 64; u += NWAVES * 64) MISC[u] = 0u;
    __syncthreads();
    XcdBarrier bar; { KBASE(); bar = xcd_barrier_post((unsigned*)((unsigned char*)KARG(28) + WS_CTL) + CW_BAR, MISC + 8); }
#define GRID_BAR() do { for (int rb_ = 0; rb_ < REP_BAR; ++rb_) xcd_barrier(bar); } while (0)


    { KBASE();
    for (int i = blockIdx.x * (NWAVES * 64) + threadIdx.x; i < M * 32; i += F.G * NWAVES * 64) {
        const int m = i >> 5, f = i & 31;
        const double a = (double)pos_in[m] * (double)c_invfreq[f] * 0.15915494309189535;
        const float fr = (float)(a - __builtin_rint(a));
        COS[i] = __builtin_amdgcn_cosf(fr); SIN[i] = __builtin_amdgcn_sinf(fr);
    }
    }

    {
        PHASE_IDS();
        for (int m = gw; m < M; m += NGW) {
            const f32x4* xr = (const f32x4*)(x_in + (size_t)m * D) + lane; float sq = 0.f;
#pragma unroll
            for (int j = 0; j < 4; ++j) { const f32x4 v = xr[64 * j]; sq += (v.x * v.x + v.y * v.y) + (v.z * v.z + v.w * v.w); u32x2 w; w.x = pk2b(v.x, v.y); w.y = pk2b(v.z, v.w); *(u32x2*)(H16 + pg8::blk32(m, 4 * lane + 256 * j, D)) = w; }
            sq = wave_sum(sq);
            if (lane < 16) RSQ[(size_t)m * 16 + lane] = (lane == 0) ? sq : 0.f;
        }
    }
    for (int l = 0; l < DEPTH; ++l) {
        { KBASE();
            for (int s = 0; s < 2; ++s) {
                conv_matrix(F, ffn_w_in + ((size_t)l * 2 + s) * D * 2 * DFF, 2 * DFF, 0, D, 2 * DFF, W_in_t + (size_t)s * 5632 * 1024, 1, DFF, norm_g + ((size_t)l * 4 + 3 * s) * D);
                conv_matrix(F, ffn_w_out + ((size_t)l * 2 + s) * DFF * D, D, 0, DFF, D, W_out_t + (size_t)s * 1024 * 2816, 0, 0, nullptr);
            }
            const float* mw = mix_w_in + (size_t)l * D * INW;
            conv_matrix(F, mw, INW, 0, D, 1792, W_A_t, 0, 0, norm_g + ((size_t)l * 4 + 1) * D);
            conv_matrix(F, mw, INW, 1792, D, 3072, W_B_t, 0, 0, norm_g + ((size_t)l * 4 + 1) * D);
            conv_matrix(F, mw, INW, 4864, D, 2048, W_G_t, 1, 1024, norm_g + ((size_t)l * 4 + 1) * D);
            conv_matrix(F, w_branch_a + (size_t)l * AW * D, D, 0, AW, D, P_A_t, 0, 0, nullptr);
            conv_matrix(F, w_branch_b + (size_t)l * D * D, D, 0, D, D, P_B_t, 0, 0, nullptr);
            conv_matrix(F, mix_w_out + (size_t)l * D * D, D, 0, D, D, W_MO_t, 0, 0, nullptr);
            conv_matrix(F, cross_w_q + (size_t)l * D * D, D, 0, D, D, W_Q_t, 0, 0, norm_g + ((size_t)l * 4 + 2) * D);
            conv_matrix(F, cross_w_kv + (size_t)l * D * 2 * D, 2 * D, 0, D, D, W_K_t, 0, 0, nullptr);
            conv_matrix(F, cross_w_kv + (size_t)l * D * 2 * D, 2 * D, D, D, D, W_V_t, 0, 0, nullptr);
            conv_matrix(F, cross_w_o + (size_t)l * D * D, D, 0, D, D, W_O_t, 0, 0, nullptr);
            for (int i = blockIdx.x * (NWAVES * 64) + fresh_tid(); i < 1536 * 128; i += F.G * NWAVES * 64) {
                const int n = i >> 7, k = i & 127; float v = 0.f;
                if (n < 512) { if (k < 64) v = a_w_up[((size_t)l * 64 + k) * 512 + n]; }
                else if (n < 1024) { if (k >= 64) v = a_a_up[((size_t)l * 64 + (k - 64)) * 512 + (n - 512)]; }
                else v = a_g_up[((size_t)l * 128 + k) * 512 + (n - 1024)];
                W_LR_t[pg8::blk32(n, k, 128)] = f2b(v);
            }
            rms_phase(F, mem_in, mem_norm + (size_t)l * D, MEMN, MM);
        }
        GRID_BAR();
        {
            { KBASE(); pg8::Gemm g{H16, W_in_t, M, 2 * DFF, D}; pg8::StaticOrder S; S.init(M, 2 * DFF, F.G, (int)blockIdx.x); pg8::EpiSwiglu E{ACT, DFF, RSQ};
              for (int rep = 0; rep < REPG(0); ++rep) pg8::gemm_phase<true, true>(F.lds, g, S, E); }
            { KBASE(); pg8::Gemm g{MEMN, W_K_t, MM, D, D}; pg8::StaticOrder S; S.init(MM, D, F.G, (int)blockIdx.x); pg8::EpiStoreH<false> E{KM, D, 0, 0, nullptr};
              for (int rep = 0; rep < REPG(1); ++rep) pg8::gemm_phase<true, true>(F.lds, g, S, E); }
            { KBASE(); pg8::Gemm g{W_V_t, MEMN, D, MM, D}; pg8::StaticOrder S; S.init(D, MM, F.G, (int)((blockIdx.x + 128) % F.G)); pg8::EpiStoreH<false> E{VTM, MM, 0, 0, nullptr};
              for (int rep = 0; rep < REPG(2); ++rep) pg8::gemm_phase<true, true>(F.lds, g, S, E); }
        }
        GRID_BAR();
        { KBASE(); pg8::Gemm g{ACT, W_out_t, M, D, DFF}; pg8::StaticOrder S; S.init(M, D, F.G, (int)blockIdx.x); pg8::EpiResid E{(unsigned char*)KARG(28), 0.5f};
          pg8::gemm_phase<true, true>(F.lds, g, S, E); }
        GRID_BAR();
        { KBASE(); pg8::Gemm g{H16, W_A_t, M, 1792, D}; pg8::StaticOrder S; S.init(M, 1792, F.G, (int)blockIdx.x); pg8::EpiStoreH<true> E{ZA, 256, 256, (size_t)M * 256, RSQ};
          for (int rep = 0; rep < REPG(3); ++rep) pg8::gemm_phase<true, true>(F.lds, g, S, E); }
        GRID_BAR();
        {
            PHASE_IDS();
            const u16* T6 = ZA + (size_t)6 * M * 256; const float* mu = shift_mu + (size_t)l * 1792 + 1536;
            for (int m = gw; m < M; m += NGW) {
                const int c0 = 4 * lane; const bool first = (m % T) == 0;
                const u32x2 zc = *(const u32x2*)(T6 + pg8::blk32(m, c0, 256));
                u32x2 zp = {0u, 0u}; if (!first) zp = *(const u32x2*)(T6 + pg8::blk32(m - 1, c0, 256));
                const f32x4 mm = *(const f32x4*)(mu + c0);
                float v[4] = {hlo(zc.x), hhi(zc.x), hlo(zc.y), hhi(zc.y)}; const float p[4] = {hlo(zp.x), hhi(zp.x), hlo(zp.y), hhi(zp.y)};
#pragma unroll
                for (int j = 0; j < 4; ++j) { float s = v[j] + (p[j] - v[j]) * mm[j];
                    if (c0 < 64) { const float e = __builtin_amdgcn_exp2f(2.88539008178f * s); s = 1.0f - 2.0f * __builtin_amdgcn_rcpf(1.0f + e); }
                    else if (c0 >= 128) s = fsigmoid(s);
                    v[j] = s; }
                u32x2 o; o.x = pk2b(v[0], v[1]); o.y = pk2b(v[2], v[3]);
                *(u32x2*)(ALR + pg8::blk32(m, c0, 256)) = o;
            }
        }
        GRID_BAR();
        { KBASE(); pg8::Gemm g{ALR, W_LR_t, M, 1536, 128, 256, 4, 8192u}; pg8::StaticOrder S; S.init(M, 1536, F.G, (int)blockIdx.x); pg8::EpiStoreH<false> E{WAG, 1536, 0, 0, nullptr};
          for (int rep = 0; rep < REPG(4); ++rep) pg8::gemm_phase<true, true>(F.lds, g, S, E); }
        GRID_BAR();
        {
            for (int rep = 0; rep < REP_PA; ++rep) {
                PHASE_IDS();
                const int fr_o = lane & 15, fq_o = lane >> 4;
                LAS u16* Bh = (LAS u16*)F.lds;  LAS u16* Kh = Bh + 32 * 72; LAS u16* Kt = Kh + 32 * 72; LAS u16* Rt = Kt + 32 * 72;
                LAS u16* Ktx = Rt + 32 * 72;    LAS u16* Rx = Ktx + 32 * 72;
                LAS u16* BgT = Rx + 32 * 72;    LAS u16* VT = BgT + 64 * 40; LAS u16* KgT = VT + 64 * 40;
                LAS u16* AbrT = KgT + 64 * 40;  LAS u16* AkkT = AbrT + 32 * 40; LAS u16* AkrT = AkkT + 32 * 40;
                LAS float* ATt = (LAS float*)(F.lds + 50688);
                LAS float* Uf = (LAS float*)(F.lds + 55296);
                LAS u16* Zh = (LAS u16*)(F.lds + 64512);
                LAS float* YL = (LAS float*)(F.lds + 69632);
                LAS u16* Sh = (LAS u16*)(F.lds + 78336);
                LAS float* Lgrp = (LAS float*)(F.lds + 87552);
                LAS float* gC = Lgrp + 512;
                LAS float* CVl = (LAS float*)(F.lds + 89856);
                LAS float* GGl = (LAS float*)(F.lds + 107264);
                for (int bh = blockIdx.x; bh < NBATCH * 8; bh += F.G) {
                    const int b = bh >> 3, h = bh & 7, jj = tid & 63, col = 64 * h + jj;
                    const u16* zrp = ZA + (size_t)(col >> 8) * M * 256; const u16* zkp = zrp + (size_t)2 * M * 256; const u16* zvp = zrp + (size_t)4 * M * 256;
                    u16 nzr[5], nzk[5], nzv[5], nwd[4], nad[4], ngd[4];
#define PA_LOAD(cc_) do { const int t1_ = CH * (cc_) + 4 * wave; int m1_ = b * T + t1_; asm volatile("" : "+v"(m1_)); \
        const size_t zb_ = pg8::blk32(m1_, col & 255, 256), zp_ = (m1_ & 31) ? zb_ - 32 : zb_ - 8 * 1024 + 31 * 32;     \
        const bool ok_ = t1_ > 0; nzr[0] = ok_ ? zrp[zp_] : (u16)0; nzk[0] = ok_ ? zkp[zp_] : (u16)0; nzv[0] = ok_ ? zvp[zp_] : (u16)0; \
        _Pragma("unroll") for (int u = 1; u < 5; ++u) { nzr[u] = zrp[zb_ + (u - 1) * 32]; nzk[u] = zkp[zb_ + (u - 1) * 32]; nzv[u] = zvp[zb_ + (u - 1) * 32]; } \
        const size_t wb_ = pg8::blk32(m1_, col, 1536); \
        _Pragma("unroll") for (int u = 0; u < 4; ++u) { nwd[u] = WAG[wb_ + u * 32]; nad[u] = WAG[wb_ + u * 32 + (size_t)16 * 1024]; ngd[u] = WAG[wb_ + u * 32 + (size_t)32 * 1024]; } } while (0)
                    float lw[4], bb[4], kp[4], rr[4], vv[4], kq[4], c[4], cvv[4], ggv[4];
                    const float* mu = shift_mu + (size_t)l * 1792;
                    const float mur = mu[col], muk = mu[512 + col], muv = mu[1024 + col], w0c = a_w0[(size_t)l * 512 + col], a0c = a_a0[(size_t)l * 512 + col];
                    const float kkc = a_k_k[(size_t)l * 512 + col], kac = a_k_a[(size_t)l * 512 + col], rkc = a_r_k[(size_t)l * 512 + col];
                    const f32x4 ln0 = *(const f32x4*)(a_ln + ((size_t)l * 2 + 0) * 512 + 64 * h + 4 * (tid & 15)), ln1 = *(const f32x4*)(a_ln + ((size_t)l * 2 + 1) * 512 + 64 * h + 4 * (tid & 15));
#define PA_FIRST() do { \
        float zr[5], zk[5], zv[5]; \
        _Pragma("unroll") for (int u = 0; u < 5; ++u) { zr[u] = h2f(nzr[u]); zk[u] = h2f(nzk[u]); zv[u] = h2f(nzv[u]); } \
        _Pragma("unroll") for (int u = 0; u < 4; ++u) { \
            rr[u] = zr[u + 1] + (zr[u] - zr[u + 1]) * mur; const float kx = zk[u + 1] + (zk[u] - zk[u + 1]) * muk; vv[u] = zv[u + 1] + (zv[u] - zv[u + 1]) * muv; \
            const float a = fsigmoid(a0c + h2f(nad[u])); \
            lw[u] = -0.60653065971f * 1.44269504089f * fsigmoid(w0c + h2f(nwd[u]));            \
            float kk = kx * kkc; kk = kk * __builtin_amdgcn_rsqf(fmaxf(wave_sum(kk * kk), 1e-24f)); \
            kq[u] = kk; bb[u] = kk * a; kp[u] = kx * (1.0f + (a - 1.0f) * kac); \
            cvv[u] = wave_sum(rr[u] * kp[u] * rkc) * vv[u]; ggv[u] = h2f(ngd[u]); }       \
        c[0] = lw[0]; c[1] = c[0] + lw[1]; c[2] = c[1] + lw[2]; c[3] = c[2] + lw[3]; \
        Lgrp[wave * 64 + jj] = c[3]; } while (0)
                    PA_LOAD(0);
                    for (int e = tid; e < 64 * 72; e += NWAVES * 64) Sh[e] = 0;
                    f32x4 Sreg[2] = {{0.f, 0.f, 0.f, 0.f}, {0.f, 0.f, 0.f, 0.f}};
                    PA_FIRST();
                    LDS_BARRIER();
                    for (int cc = 0; cc < NCH; ++cc) {
                        int fr = fr_o, fq = fq_o, jl = jj; asm volatile("" : "+v"(fr), "+v"(fq), "+v"(jl));
                        LAS float* CVc = CVl + (cc & 1) * 2176; LAS float* GGc = GGl + (cc & 1) * 2176;
                        const int ib = wave >> 1, hb = wave & 1;
                        {
                            const int j = jl, g = wave;
                            if (cc + 1 < NCH) PA_LOAD(cc + 1);
                            float pre = 0.f, Lmid = 0.f, Lend = 0.f;
#pragma unroll
                            for (int g2 = 0; g2 < 8; ++g2) { const float x = Lgrp[g2 * 64 + j]; if (g2 < g) pre += x; if (g2 < 4) Lmid += x; Lend += x; }
                            const float cM = __builtin_amdgcn_exp2f(-Lmid), cMi = __builtin_amdgcn_exp2f(Lmid), cE = __builtin_amdgcn_exp2f(Lend);
                            float xg[4], xk[4], x1[4], x2[4], x3[4], x4[4], x5[4], x6[4]; float e4 = __builtin_amdgcn_exp2f(pre);
#pragma unroll
                            for (int u = 0; u < 4; ++u) { const int sT = 4 * g + u; const float L = pre + c[u];
                                const float e5 = __builtin_amdgcn_exp2f(L), r5 = __builtin_amdgcn_rcpf(e5);
                                const float e3 = e5 * cM, e2 = e4 * cM, e1 = fminf(cMi * r5, 8192.f), e6 = cE * r5;
                                x1[u] = bb[u] * e1; x2[u] = kp[u] * e1; x3[u] = kq[u] * e2; x4[u] = rr[u] * e3; x5[u] = kq[u] * e4; x6[u] = rr[u] * e5;
                                xg[u] = bb[u] * e6; xk[u] = kp[u] * e6; e4 = e5;
                                CVc[sT * 68 + j] = cvv[u]; GGc[sT * 68 + j] = ggv[u]; }
                            {
                                u32x2 w; w.x = pk2(xg[0], xg[1]); w.y = pk2(xg[2], xg[3]); *(LAS u32x2*)(BgT + j * 40 + 4 * g) = w;
                                w.x = pk2(x1[0], x1[1]); w.y = pk2(x1[2], x1[3]); *(LAS u32x2*)(Bh + j * 36 + 4 * g) = w;
                                w.x = pk2(x2[0], x2[1]); w.y = pk2(x2[2], x2[3]); *(LAS u32x2*)(Kh + j * 36 + 4 * g) = w;
                                w.x = pk2(x3[0], x3[1]); w.y = pk2(x3[2], x3[3]); *(LAS u32x2*)(Kt + j * 36 + 4 * g) = w;
                                w.x = pk2(x4[0], x4[1]); w.y = pk2(x4[2], x4[3]); *(LAS u32x2*)(Rt + j * 36 + 4 * g) = w;
                                w.x = pk2(x5[0], x5[1]); w.y = pk2(x5[2], x5[3]); *(LAS u32x2*)(Ktx + j * 36 + 4 * g) = w;
                                w.x = pk2(x6[0], x6[1]); w.y = pk2(x6[2], x6[3]); *(LAS u32x2*)(Rx + j * 36 + 4 * g) = w;
                                w.x = pk2(vv[0], vv[1]); w.y = pk2(vv[2], vv[3]); *(LAS u32x2*)(VT + j * 40 + 4 * g) = w;
                                w.x = pk2(xk[0], xk[1]); w.y = pk2(xk[2], xk[3]); *(LAS u32x2*)(KgT + j * 40 + 4 * g) = w; }
                            if (g == 0) gC[j] = cE;
                        }
                        LDS_BARRIER();
                        f32x4 accU = {0.f, 0.f, 0.f, 0.f}, accY = {0.f, 0.f, 0.f, 0.f}, accS[2] = {{0.f, 0.f, 0.f, 0.f}, {0.f, 0.f, 0.f, 0.f}};
                        h16x8 aV;
                        {
                            const int mt = wave >> 2, sb = (wave >> 1) & 1, tb = wave & 1;
                            const LAS u16* X = mt ? Kh : Bh;
                            const h16x8 a0 = lds_tr16(X, 36, 0, 16 * sb, lane), a1 = lds_tr16(X, 36, 32, 16 * sb, lane);
                            const h16x8 k0 = lds_tr16(Kt, 36, 0, 16 * tb, lane), k1 = lds_tr16(Kt, 36, 32, 16 * tb, lane);
                            const h16x8 r0 = lds_tr16(Rt, 36, 0, 16 * tb, lane), r1 = lds_tr16(Rt, 36, 32, 16 * tb, lane);
                            const h16x8 s0 = *(const LAS h16x8*)(Sh + (16 * ib + fr) * 72 + 8 * fq), s1 = *(const LAS h16x8*)(Sh + (16 * ib + fr) * 72 + 32 + 8 * fq);
                            const h16x8 x0 = lds_tr16(Ktx, 36, 0, 16 * hb, lane), x1 = lds_tr16(Ktx, 36, 32, 16 * hb, lane);
                            const h16x8 y0 = lds_tr16(Rx, 36, 0, 16 * hb, lane), y1 = lds_tr16(Rx, 36, 32, 16 * hb, lane);
                            aV = *(const LAS h16x8*)(VT + (16 * ib + fr) * 40 + 8 * fq);
                            const h16x8 g0 = *(const LAS h16x8*)(KgT + (16 * (2 * hb) + fr) * 40 + 8 * fq), g1 = *(const LAS h16x8*)(KgT + (16 * (2 * hb + 1) + fr) * 40 + 8 * fq);
                            f32x4 aK = {0.f, 0.f, 0.f, 0.f}, aR = {0.f, 0.f, 0.f, 0.f};
                            aK = MFMA16(a0, k0, aK); aK = MFMA16(a1, k1, aK); aR = MFMA16(a0, r0, aR); aR = MFMA16(a1, r1, aR);
                            accU = MFMA16(s0, x0, accU); accU = MFMA16(s1, x1, accU); accY = MFMA16(s0, y0, accY); accY = MFMA16(s1, y1, accY);
                            accS[0] = MFMA16(aV, g0, accS[0]); accS[1] = MFMA16(aV, g1, accS[1]);
                            const int t = 16 * tb + fr, s0i = 16 * sb + 4 * fq;
#pragma unroll
                            for (int rg = 0; rg < 4; ++rg) { if (s0i + rg >= t) aK[rg] = 0.f; if (s0i + rg > t) aR[rg] = 0.f; }
                            u32x2 wK, wR; wK.x = pk2(aK[0], aK[1]); wK.y = pk2(aK[2], aK[3]); wR.x = pk2(aR[0], aR[1]); wR.y = pk2(aR[2], aR[3]);
                            if (mt == 0) {
#pragma unroll
                                for (int rg = 0; rg < 4; ++rg) ATt[(s0i + rg) * 36 + t] = aK[rg];
                                *(LAS u32x2*)(AbrT + t * 40 + s0i) = wR; }
                            else { *(LAS u32x2*)(AkkT + t * 40 + s0i) = wK; *(LAS u32x2*)(AkrT + t * 40 + s0i) = wR; }
                        }
                        LDS_BARRIER();
                        {
                            const h16x8 bK = *(const LAS h16x8*)(AkkT + (16 * hb + fr) * 40 + 8 * fq), bR = *(const LAS h16x8*)(AkrT + (16 * hb + fr) * 40 + 8 * fq);
                            accU = MFMA16(aV, bK, accU); accY = MFMA16(aV, bR, accY);
#pragma unroll
                            for (int rg = 0; rg < 4; ++rg) Uf[(16 * ib + 4 * fq + rg) * 36 + 16 * hb + fr] = accU[rg];
                        }
                        LDS_BARRIER();
                        if (wave == 0) {
                            float z[32];
#pragma unroll
                            for (int q = 0; q < 8; ++q) { const f32x4 v = *(const LAS f32x4*)(Uf + lane * 36 + 4 * q); z[4 * q] = v[0]; z[4 * q + 1] = v[1]; z[4 * q + 2] = v[2]; z[4 * q + 3] = v[3]; }
#pragma unroll
                            for (int sx = 0; sx < 31; ++sx) {
#pragma unroll
                                for (int q = (sx + 1) / 4; q < 8; ++q) { const f32x4 a4 = *(const LAS f32x4*)(ATt + sx * 36 + 4 * q);
#pragma unroll
                                    for (int i = 0; i < 4; ++i) if (4 * q + i > sx) z[4 * q + i] = fmaf(-z[sx], a4[i], z[4 * q + i]); }
                            }
#pragma unroll
                            for (int q = 0; q < 4; ++q) { u32x4 w; w.x = pk2(-z[8 * q], -z[8 * q + 1]); w.y = pk2(-z[8 * q + 2], -z[8 * q + 3]); w.z = pk2(-z[8 * q + 4], -z[8 * q + 5]); w.w = pk2(-z[8 * q + 6], -z[8 * q + 7]);
                                *(LAS u32x4*)(Zh + lane * 40 + 8 * q) = w; }
                        }
                        if (cc + 1 < NCH) PA_FIRST();
                        LDS_BARRIER();
                        {
                            const h16x8 aZ = *(const LAS h16x8*)(Zh + (16 * ib + fr) * 40 + 8 * fq);
                            const h16x8 bA = *(const LAS h16x8*)(AbrT + (16 * hb + fr) * 40 + 8 * fq);
                            const h16x8 b0 = *(const LAS h16x8*)(BgT + (16 * (2 * hb) + fr) * 40 + 8 * fq), b1 = *(const LAS h16x8*)(BgT + (16 * (2 * hb + 1) + fr) * 40 + 8 * fq);
                            const float gc0 = gC[16 * (2 * hb) + fr], gc1 = gC[16 * (2 * hb + 1) + fr];
                            accY = MFMA16(aZ, bA, accY); accS[0] = MFMA16(aZ, b0, accS[0]); accS[1] = MFMA16(aZ, b1, accS[1]);
                            const int i0 = 16 * ib + 4 * fq;
                            *(LAS f32x4*)(YL + (16 * hb + fr) * 68 + i0) = accY;
                            Sreg[0] = Sreg[0] * gc0 + accS[0]; Sreg[1] = Sreg[1] * gc1 + accS[1];
#pragma unroll
                            for (int rg = 0; rg < 4; ++rg) { Sh[(i0 + rg) * 72 + 16 * (2 * hb) + fr] = f2h(Sreg[0][rg]); Sh[(i0 + rg) * 72 + 16 * (2 * hb + 1) + fr] = f2h(Sreg[1][rg]); }
                        }
                        LDS_BARRIER();
                        {
                            const int t = tid >> 4, i4 = 4 * (tid & 15), colo = 64 * h + i4;
                            const f32x4 y4 = *(const LAS f32x4*)(YL + t * 68 + i4), cv4 = *(const LAS f32x4*)(CVc + t * 68 + i4), g4 = *(const LAS f32x4*)(GGc + t * 68 + i4);
                            const float mean = sum16((y4[0] + y4[1]) + (y4[2] + y4[3])) * (1.f / 64.f); const f32x4 d4 = y4 - mean;
                            const float rstd = __builtin_amdgcn_rsqf(sum16((d4[0] * d4[0] + d4[1] * d4[1]) + (d4[2] * d4[2] + d4[3] * d4[3])) * (1.f / 64.f) + 64e-5f);
                            const f32x4 o4 = (d4 * rstd * ln0 + ln1 + cv4) * g4;
                            u32x2 w; w.x = pk2b(o4[0], o4[1]); w.y = pk2b(o4[2], o4[3]);
                            *(u32x2*)(YA + pg8::blk32(b * T + CH * cc + t, colo, 512)) = w;
                        }
                    }
                    LDS_BARRIER();
#undef PA_LOAD
#undef PA_FIRST
                }
            }
            GRID_BAR();
        }
        { KBASE(); pg8::Gemm g{H16, W_B_t, M, 3072, D}; pg8::StaticOrder S; S.init(M, 3072, F.G, (int)blockIdx.x); pg8::EpiStoreH<true> E{ZB, 3072, 0, 0, RSQ};
          for (int rep = 0; rep < REPG(5); ++rep) pg8::gemm_phase<true, true>(F.lds, g, S, E); }
        GRID_BAR();
        for (int rep = 0; rep < REP_RET; ++rep) {
            PHASE_IDS();
            LAS u16* Qd = (LAS u16*)(F.lds + 0);
            LAS u16* Kd = (LAS u16*)(F.lds + 18432);
            LAS u16* RTL = (LAS u16*)(F.lds + 36864);
            LAS u16* Vr = (LAS u16*)(F.lds + 72704);
            LAS u16* PL = (LAS u16*)(F.lds + 107520);
            const int fr = lane & 15, fq = lane >> 4;
            for (int bh = blockIdx.x; bh < NBATCH * 8; bh += F.G) {
                const int b = bh >> 3, h = bh & 7;
                const float lg = __builtin_log2f(1.0f - __builtin_amdgcn_exp2f(-5.0f - (float)h));
                const float gC = __builtin_amdgcn_exp2f(128.0f * lg);
                f32x4 rt[4];
#pragma unroll
                for (int i = 0; i < 4; ++i) rt[i] = (f32x4){0.f, 0.f, 0.f, 0.f};
                u32x4 nq1, nq2, nk1, nk2, nv8[4]; f32x4 nc0, nc1, ns0, ns1;
#define RET_LOAD(n_) do { const int s_ = 16 * wave + (lane >> 2), ci_ = lane & 3;     const size_t tok_ = (size_t)b * T + 128 * (n_) + s_; const u16* zp_ = ZB + pg8::blk32((int)tok_, 64 * h + 8 * ci_, 3072); \
        nq1 = *(const u32x4*)(zp_); nq2 = *(const u32x4*)(zp_ + 1024); nk1 = *(const u32x4*)(zp_ + 16 * 1024); nk2 = *(const u32x4*)(zp_ + 17 * 1024); \
        const float* cp_ = COS + tok_ * 32 + 8 * ci_; const float* sp_ = SIN + tok_ * 32 + 8 * ci_; nc0 = *(const f32x4*)cp_; nc1 = *(const f32x4*)(cp_ + 4); ns0 = *(const f32x4*)sp_; ns1 = *(const f32x4*)(sp_ + 4); \
        const u16* vp_ = ZB + pg8::blk32((int)tok_, 1024 + 128 * h + 8 * ci_, 3072); _Pragma("unroll") for (int i = 0; i < 4; ++i) nv8[i] = *(const u32x4*)(vp_ + i * 1024); } while (0)
                RET_LOAD(0);
                for (int n = 0; n < T / 128; ++n) {
                    const int m0 = b * T + 128 * n;
                    {
                        const int s = 16 * wave + (lane >> 2), ci = lane & 3;
                        const u32x4 q1 = nq1, q2 = nq2, k1 = nk1, k2 = nk2; const f32x4 c0 = nc0, c1 = nc1, s0 = ns0, s1 = ns1;
                        u32x4 cv8[4];
#pragma unroll
                        for (int i = 0; i < 4; ++i) cv8[i] = nv8[i];
                        if (n + 1 < T / 128) RET_LOAD(n + 1);
                        const float fqs = __builtin_amdgcn_exp2f((float)(s + 1) * lg), fks = 0.125f * __builtin_amdgcn_exp2f(-(float)(s + 1) * lg);
                        float qa[8], qb[8], ka[8], kbv[8];
#pragma unroll
                        for (int j = 0; j < 8; ++j) { const float cs = (j < 4) ? c0[j & 3] : c1[j & 3], sn = (j < 4) ? s0[j & 3] : s1[j & 3];
                            const float x1 = (j & 1) ? hhi(q1[j >> 1]) : hlo(q1[j >> 1]), x2 = (j & 1) ? hhi(q2[j >> 1]) : hlo(q2[j >> 1]);
                            const float y1 = (j & 1) ? hhi(k1[j >> 1]) : hlo(k1[j >> 1]), y2 = (j & 1) ? hhi(k2[j >> 1]) : hlo(k2[j >> 1]);
                            qa[j] = (x1 * cs - x2 * sn) * fqs; qb[j] = (x1 * sn + x2 * cs) * fqs; ka[j] = (y1 * cs - y2 * sn) * fks; kbv[j] = (y1 * sn + y2 * cs) * fks; }
                        u32x4 w;
                        w.x = pk2(qa[0], qa[1]); w.y = pk2(qa[2], qa[3]); w.z = pk2(qa[4], qa[5]); w.w = pk2(qa[6], qa[7]); *(LAS u32x4*)(Qd + s * 72 + 8 * ci) = w;
                        w.x = pk2(qb[0], qb[1]); w.y = pk2(qb[2], qb[3]); w.z = pk2(qb[4], qb[5]); w.w = pk2(qb[6], qb[7]); *(LAS u32x4*)(Qd + s * 72 + 32 + 8 * ci) = w;
                        w.x = pk2(ka[0], ka[1]); w.y = pk2(ka[2], ka[3]); w.z = pk2(ka[4], ka[5]); w.w = pk2(ka[6], ka[7]); *(LAS u32x4*)(Kd + s * 72 + 8 * ci) = w;
                        w.x = pk2(kbv[0], kbv[1]); w.y = pk2(kbv[2], kbv[3]); w.z = pk2(kbv[4], kbv[5]); w.w = pk2(kbv[6], kbv[7]); *(LAS u32x4*)(Kd + s * 72 + 32 + 8 * ci) = w;
#pragma unroll
                        for (int i = 0; i < 4; ++i) *(LAS u32x4*)(Vr + s * 136 + 8 * (ci + 4 * i)) = cv8[i];
#pragma unroll
                        for (int db = 0; db < 4; ++db)
#pragma unroll
                            for (int r = 0; r < 4; ++r) RTL[(16 * wave + 4 * fq + r) * 72 + 16 * db + fr] = f2h(rt[db][r]);
                    }
                    LDS_BARRIER();
                    {
                        const h16x8 bq0 = *(const LAS h16x8*)(Qd + (16 * wave + fr) * 72 + 8 * fq), bq1 = *(const LAS h16x8*)(Qd + (16 * wave + fr) * 72 + 32 + 8 * fq);
#pragma unroll
                        for (int sb = 0; sb < 8; ++sb) {
                            u32x2 pw = {0u, 0u};
                            if (sb <= wave) {
                                f32x4 acc = {0.f, 0.f, 0.f, 0.f};
                                const h16x8 a0 = *(const LAS h16x8*)(Kd + (16 * sb + fr) * 72 + 8 * fq), a1 = *(const LAS h16x8*)(Kd + (16 * sb + fr) * 72 + 32 + 8 * fq);
                                acc = MFMA16(a0, bq0, acc); acc = MFMA16(a1, bq1, acc);
                                const int cc = 16 * wave + fr, s0i = 16 * sb + 4 * fq;
#pragma unroll
                                for (int r = 0; r < 4; ++r) if (s0i + r > cc) acc[r] = 0.f;
                                pw.x = pk2(acc[0], acc[1]); pw.y = pk2(acc[2], acc[3]);
                            }
                            *(LAS u32x2*)(PL + (16 * wave + fr) * 136 + 16 * sb + 4 * fq) = pw;
                        }
                    }
                    asm volatile("" ::: "memory");
                    {
                        h16x8 pf[4], qf[2];
#pragma unroll
                        for (int ks = 0; ks < 4; ++ks) pf[ks] = *(const LAS h16x8*)(PL + (16 * wave + fr) * 136 + 32 * ks + 8 * fq);
#pragma unroll
                        for (int ks = 0; ks < 2; ++ks) qf[ks] = *(const LAS h16x8*)(Qd + (16 * wave + fr) * 72 + 32 * ks + 8 * fq);
                        f32x4 oacc[8];
#pragma unroll
                        for (int eb = 0; eb < 8; ++eb) { f32x4 acc = {0.f, 0.f, 0.f, 0.f};
#pragma unroll
                            for (int ks = 0; ks < 4; ++ks) { const h16x8 a = lds_tr16(Vr, 136, 32 * ks, 16 * eb, lane); acc = MFMA16(a, pf[ks], acc); }
#pragma unroll
                            for (int ks = 0; ks < 2; ++ks) { const h16x8 a = *(const LAS h16x8*)(RTL + (16 * eb + fr) * 72 + 32 * ks + 8 * fq); acc = MFMA16(a, qf[ks], acc); }
                            oacc[eb] = acc; }
                        float sm = 0.f;
#pragma unroll
                        for (int eb = 0; eb < 8; ++eb) sm += (oacc[eb][0] + oacc[eb][1]) + (oacc[eb][2] + oacc[eb][3]);
                        sm = xsum16(sm); sm = xsum32(sm);
                        const float mean = sm * (1.f / 128.f); float vs = 0.f;
#pragma unroll
                        for (int eb = 0; eb < 8; ++eb)
#pragma unroll
                            for (int r = 0; r < 4; ++r) { const float dd = oacc[eb][r] - mean; vs += dd * dd; }
                        vs = xsum16(vs); vs = xsum32(vs);
                        const float inv = __builtin_amdgcn_rsqf(vs * (1.f / 128.f) + 1e-5f);
                        const int m = m0 + 16 * wave + fr, eo = 16 * (fq & 1) + 8 * (fq >> 1);
                        const u16* gp = ZB + pg8::blk32(m, 2048 + 128 * h + eo, 3072); u16* yp = YB + pg8::blk32(m, 128 * h + eo, 1024);
#pragma unroll
                        for (int p = 0; p < 4; ++p) {
                            f32x4 xa = oacc[2 * p], xb = oacc[2 * p + 1];
#pragma unroll
                            for (int r = 0; r < 4; ++r) { float pa_ = xa[r], pb_ = xb[r]; pair16(pa_, pb_); xa[r] = pa_; xb[r] = pb_; }
                            const int e0 = 16 * (2 * p + (fq & 1)) + 8 * (fq >> 1);
                            const u32x4 g4 = *(const u32x4*)(gp + p * 1024);
                            const f32x4 gn0 = *(const f32x4*)(b_gn + (size_t)l * 1024 + 128 * h + e0), gn1 = *(const f32x4*)(b_gn + (size_t)l * 1024 + 128 * h + e0 + 4);
                            float o[8];
#pragma unroll
                            for (int r = 0; r < 4; ++r) { const float ga = (r & 1) ? hhi(g4[r >> 1]) : hlo(g4[r >> 1]), gb = (r & 1) ? hhi(g4[2 + (r >> 1)]) : hlo(g4[2 + (r >> 1)]);
                                o[r] = (xa[r] - mean) * inv * gn0[r] * fsilu(ga); o[4 + r] = (xb[r] - mean) * inv * gn1[r] * fsilu(gb); }
                            u32x4 w; w.x = pk2b(o[0], o[1]); w.y = pk2b(o[2], o[3]); w.z = pk2b(o[4], o[5]); w.w = pk2b(o[6], o[7]);
                            *(u32x4*)(yp + p * 1024) = w; }
                    }
                    {
#pragma unroll
                        for (int ks = 0; ks < 4; ++ks) { const h16x8 a = lds_tr16(Vr, 136, 32 * ks, 16 * wave, lane);
#pragma unroll
                            for (int db = 0; db < 4; ++db) { const h16x8 bb = lds_tr16(Kd, 72, 32 * ks, 16 * db, lane); rt[db] = MFMA16(a, bb, rt[db]); } }
#pragma unroll
                        for (int db = 0; db < 4; ++db) rt[db] = rt[db] * gC;
                    }
                    LDS_BARRIER();
                }
            }
        }
        #undef RET_LOAD
        GRID_BAR();
        {
            { KBASE(); pg8::Gemm g{YA, P_A_t, M, D, AW}; pg8::StaticOrder S; S.init(M, D, F.G, (int)blockIdx.x); pg8::EpiStoreH<false> E{TMPA, D, 0, 0, nullptr}; for (int rep = 0; rep < REPG(6); ++rep) pg8::gemm_phase<true, true>(F.lds, g, S, E); }
            { KBASE(); pg8::Gemm g{YB, P_B_t, M, D, D}; pg8::StaticOrder S; S.init(M, D, F.G, (int)blockIdx.x); pg8::EpiStoreH<false> E{TMPB, D, 0, 0, nullptr}; for (int rep = 0; rep < REPG(7); ++rep) pg8::gemm_phase<true, true>(F.lds, g, S, E); }
        }
        GRID_BAR();
        { KBASE(); pg8::Gemm g{H16, W_G_t, M, 2048, D}; pg8::StaticOrder S; S.init(M, 2048, F.G, (int)blockIdx.x);
          pg8::EpiGate E{mix_gate_b + (size_t)l * 2048, mix_gate_b + (size_t)l * 2048 + 1024, TMPA, TMPB, MRG, D, RSQ};
          for (int rep = 0; rep < REPG(8); ++rep) pg8::gemm_phase<true, true>(F.lds, g, S, E); }
        GRID_BAR();
        { KBASE(); pg8::Gemm g{MRG, W_MO_t, M, D, D}; pg8::StaticOrder S; S.init(M, D, F.G, (int)blockIdx.x); pg8::EpiResid E{(unsigned char*)KARG(28), 1.0f}; pg8::gemm_phase<true, true>(F.lds, g, S, E); }
        GRID_BAR();
        { KBASE(); pg8::Gemm g{H16, W_Q_t, M, D, D}; pg8::StaticOrder S; S.init(M, D, F.G, (int)blockIdx.x); pg8::EpiStoreH<true> E{QX, D, 0, 0, RSQ}; for (int rep = 0; rep < REPG(9); ++rep) pg8::gemm_phase<true, true>(F.lds, g, S, E); }
        GRID_BAR();
        for (int rep = 0; rep < REP_XATT; ++rep) {
            PHASE_IDS();
            LAS u16* KL = (LAS u16*)(F.lds + 0);
            LAS u16* PL = (LAS u16*)(F.lds + 69632);
            const int fr_o = lane & 15, fq_o = lane >> 4;
            const int NU = NBATCH * 4 * 16, per = (NU + F.G - 1) / F.G;
            for (int uj = 0; uj < per;) {
                const int un = (int)blockIdx.x * per + uj; if (un >= NU) break;
                const bool two = (uj + 1 < per) && (un + 1 < NU) && (((un + 1) >> 4) == (un >> 4));
                uj += two ? 2 : 1;
                int fr = fr_o, fq = fq_o, tl = tid; asm volatile("" : "+v"(fr), "+v"(fq), "+v"(tl));
                const int b = un >> 6, hx = (un >> 4) & 3, qtA = un & 15, qtB = two ? qtA + 1 : qtA;
                const int mqA = b * T + qtA * 128 + 16 * wave + fr, mqB = b * T + qtB * 128 + 16 * wave + fr;
                f32x4 sA[16], sB[16];
#pragma unroll
                for (int kb2 = 0; kb2 < 16; ++kb2) { sA[kb2] = (f32x4){0.f, 0.f, 0.f, 0.f}; sB[kb2] = (f32x4){0.f, 0.f, 0.f, 0.f}; }
#pragma unroll 1
                for (int hh = 0; hh < 2; ++hh) {
                    h16x8 qfA[4], qfB[4];
                    const u16* qpa = QX + pg8::blk32(mqA, 256 * hx + 128 * hh + 8 * fq, D); const u16* qpb = QX + pg8::blk32(mqB, 256 * hx + 128 * hh + 8 * fq, D);
#pragma unroll
                    for (int k4 = 0; k4 < 4; ++k4) { qfA[k4] = *(const h16x8*)(qpa + k4 * 1024); qfB[k4] = *(const h16x8*)(qpb + k4 * 1024); }
                    const u16* kp0 = KM + pg8::blk32(b * MEML + (tl >> 4), 256 * hx + 128 * hh + 8 * (tl & 15), D);
#pragma unroll
                    for (int i = 0; i < 8; ++i) { const int c = tl + 512 * i, row = c >> 4, cc = c & 15;
                        *(LAS u32x4*)(KL + row * 136 + 8 * cc) = *(const u32x4*)(kp0 + (size_t)i * (D / 32) * 1024); }
                    __syncthreads();
#pragma unroll
                    for (int kb2 = 0; kb2 < 16; ++kb2)
#pragma unroll
                        for (int k4 = 0; k4 < 4; ++k4) { const h16x8 a = *(const LAS h16x8*)(KL + (16 * kb2 + fr) * 136 + 32 * k4 + 8 * fq);
                            sA[kb2] = MFMA16(a, qfA[k4], sA[kb2]); sB[kb2] = MFMA16(a, qfB[k4], sB[kb2]); }
                    __syncthreads();
                }
                h16x8 pfA[8], pfB[8]; float isA, isB;
#define XA_SOFTMAX(sacc, pf, isum_) do { float mx = -3.0e38f; \
        _Pragma("unroll") for (int kb2 = 0; kb2 < 16; ++kb2) mx = fmaxf(mx, fmaxf(fmaxf(sacc[kb2][0], sacc[kb2][1]), fmaxf(sacc[kb2][2], sacc[kb2][3]))); \
        mx = xmax16(mx); mx = xmax32(mx); float sum = 0.f; const float sc = 0.0625f * 1.44269504089f; \
        _Pragma("unroll") for (int kb2 = 0; kb2 < 16; ++kb2) { float p[4]; \
            _Pragma("unroll") for (int r = 0; r < 4; ++r) { p[r] = __builtin_amdgcn_exp2f((sacc[kb2][r] - mx) * sc); sum += p[r]; } \
            u32x2 w; w.x = pk2(p[0], p[1]); w.y = pk2(p[2], p[3]); *(LAS u32x2*)(PL + (16 * wave + fr) * 264 + 16 * kb2 + 4 * fq) = w; } \
        sum = xsum16(sum); sum = xsum32(sum); isum_ = __builtin_amdgcn_rcpf(sum); \
        asm volatile("" ::: "memory"); \
        _Pragma("unroll") for (int ks = 0; ks < 8; ++ks) pf[ks] = *(const LAS h16x8*)(PL + (16 * wave + fr) * 264 + 32 * ks + 8 * fq); \
        asm volatile("" ::: "memory"); } while (0)
                XA_SOFTMAX(sA, pfA, isA);
                XA_SOFTMAX(sB, pfB, isB);
#undef XA_SOFTMAX
#pragma unroll 1
                for (int dh = 0; dh < 2; ++dh) {
                    const u16* vp0 = VTM + pg8::blk32(256 * hx + 128 * dh + (tl >> 5), b * MEML + 8 * (tl & 31), MM);
#pragma unroll
                    for (int i = 0; i < 8; ++i) { const int c = tl + 512 * i, row = c >> 5, cc = c & 31;
                        *(LAS u32x4*)(KL + row * 264 + 8 * cc) = *(const u32x4*)(vp0 + (size_t)(i >> 1) * (MM / 32) * 1024 + (i & 1) * 16 * 32); }
                    __syncthreads();
                    u16* opa = OX + pg8::blk32(mqA, 256 * hx + 128 * dh + 16 * (fq & 1) + 8 * (fq >> 1), D); u16* opb = OX + pg8::blk32(mqB, 256 * hx + 128 * dh + 16 * (fq & 1) + 8 * (fq >> 1), D);
#pragma unroll
                    for (int dp = 0; dp < 4; ++dp) {
                        f32x4 xa = {0.f, 0.f, 0.f, 0.f}, xb = {0.f, 0.f, 0.f, 0.f}, ya = {0.f, 0.f, 0.f, 0.f}, yb = {0.f, 0.f, 0.f, 0.f};
#pragma unroll
                        for (int ks = 0; ks < 8; ++ks) { const h16x8 a = *(const LAS h16x8*)(KL + (16 * (2 * dp) + fr) * 264 + 32 * ks + 8 * fq); xa = MFMA16(a, pfA[ks], xa); ya = MFMA16(a, pfB[ks], ya); }
#pragma unroll
                        for (int ks = 0; ks < 8; ++ks) { const h16x8 a = *(const LAS h16x8*)(KL + (16 * (2 * dp + 1) + fr) * 264 + 32 * ks + 8 * fq); xb = MFMA16(a, pfA[ks], xb); yb = MFMA16(a, pfB[ks], yb); }
#pragma unroll
                        for (int r = 0; r < 4; ++r) { float pa_ = xa[r], pb_ = xb[r]; pair16(pa_, pb_); xa[r] = pa_; xb[r] = pb_; float qa_ = ya[r], qb_ = yb[r]; pair16(qa_, qb_); ya[r] = qa_; yb[r] = qb_; }
                        u32x4 w; w.x = pk2b(xa[0] * isA, xa[1] * isA); w.y = pk2b(xa[2] * isA, xa[3] * isA); w.z = pk2b(xb[0] * isA, xb[1] * isA); w.w = pk2b(xb[2] * isA, xb[3] * isA);
                        *(u32x4*)(opa + dp * 1024) = w;
                        if (two) { u32x4 v; v.x = pk2b(ya[0] * isB, ya[1] * isB); v.y = pk2b(ya[2] * isB, ya[3] * isB); v.z = pk2b(yb[0] * isB, yb[1] * isB); v.w = pk2b(yb[2] * isB, yb[3] * isB);
                            *(u32x4*)(opb + dp * 1024) = v; }
                    }
                    __syncthreads();
                }
            }
        }
        GRID_BAR();
        { KBASE(); pg8::Gemm g{OX, W_O_t, M, D, D}; pg8::StaticOrder S; S.init(M, D, F.G, (int)blockIdx.x); pg8::EpiResid E{(unsigned char*)KARG(28), 1.0f}; pg8::gemm_phase<true, true>(F.lds, g, S, E); }
        GRID_BAR();
        { KBASE(); pg8::Gemm g{H16, W_in_t + (size_t)5632 * 1024, M, 2 * DFF, D}; pg8::StaticOrder S; S.init(M, 2 * DFF, F.G, (int)blockIdx.x); pg8::EpiSwiglu E{ACT, DFF, RSQ};
          for (int rep = 0; rep < REPG(10); ++rep) pg8::gemm_phase<true, true>(F.lds, g, S, E); }
        GRID_BAR();
        { KBASE(); pg8::Gemm g{ACT, W_out_t + (size_t)1024 * 2816, M, D, DFF}; pg8::StaticOrder S; S.init(M, D, F.G, (int)blockIdx.x); pg8::EpiResid E{(unsigned char*)KARG(28), 0.5f};
          pg8::gemm_phase<true, true>(F.lds, g, S, E); }
        GRID_BAR();
    }
    PHASE_IDS();
    for (int m = gw; m < M; m += NGW) {
        f32x4* xr = (f32x4*)(H + (size_t)m * D) + lane; const f32x4* gr = (const f32x4*)final_norm + lane;
        f32x4 v[4]; float ss = 0.f;
#pragma unroll
        for (int j = 0; j < 4; ++j) { const u32x2 w = *(const u32x2*)(H16 + pg8::blk32(m, 4 * lane + 256 * j, D)); v[j] = (f32x4){blo(w.x), bhi(w.x), blo(w.y), bhi(w.y)}; ss += (v[j].x * v[j].x + v[j].y * v[j].y) + (v[j].z * v[j].z + v[j].w * v[j].w); }
        const float r = __builtin_amdgcn_rsqf(wave_sum(ss) * (1.f / D) + 1e-6f);
#pragma unroll
        for (int j = 0; j < 4; ++j) xr[64 * j] = v[j] * r * gr[64 * j];
    }
}

extern "C" void kernel_launch(void* const* d_in, const int* in_sizes, int n_in, void* d_out, int out_size, void* d_ws, size_t ws_size, hipStream_t stream) {
    static int grid = 0;
    if (grid == 0) {
        if (n_in != 27 || out_size != M * D || ws_size < WS_END) { fprintf(stderr, "kernel_launch: unexpected problem (n_in %d, out %d, ws %zu < %zu)\n", n_in, out_size, ws_size, (size_t)WS_END); grid = -1; return; }
        int dev = 0, cus = 0, per_cu = 0;
        if (hipGetDevice(&dev) != hipSuccess || hipDeviceGetAttribute(&cus, hipDeviceAttributeMultiprocessorCount, dev) != hipSuccess) { grid = -1; return; }
        if (hipFuncSetAttribute((const void*)fwd_kernel, hipFuncAttributeMaxDynamicSharedMemorySize, LDS_BYTES) != hipSuccess) { fprintf(stderr, "kernel_launch: hipFuncSetAttribute failed\n"); grid = -1; return; }
        if (hipOccupancyMaxActiveBlocksPerMultiprocessor(&per_cu, (const void*)fwd_kernel, NWAVES * 64, LDS_BYTES) != hipSuccess || per_cu < 1) { fprintf(stderr, "kernel_launch: occupancy query says %d\n", per_cu); }
        (void)hipGetLastError();
        grid = cus;
    }
    if (grid < 0) return;
    if (hipMemsetAsync((char*)d_ws + WS_CTL, 0, CTL_ZERO_BYTES, stream) != hipSuccess) return;
    Args a{};
    for (int i = 0; i < 27; ++i) a.in[i] = d_in[i];
    a.out = (float*)d_out; a.ws = (unsigned char*)d_ws; a.pad0 = 0; a.pad1 = 0;
    hipLaunchKernelGGL(fwd_kernel, dim3(grid), dim3(NWAVES * 64), LDS_BYTES, stream, a);
}
```

```cpp
#include <hip/hip_runtime.h>
#include <cstdio>
#include <cstdint>

#define GAS __attribute__((address_space(1)))
#define LAS __attribute__((address_space(3)))
#define CAS __attribute__((address_space(4)))
typedef unsigned short u16;
typedef _Float16 h16x8 __attribute__((ext_vector_type(8)));
typedef _Float16 h16x4 __attribute__((ext_vector_type(4)));
typedef _Float16 h16x2 __attribute__((ext_vector_type(2)));
typedef float f32x4 __attribute__((ext_vector_type(4)));
typedef float f32x2 __attribute__((ext_vector_type(2)));
typedef unsigned u32x4 __attribute__((ext_vector_type(4)));
typedef unsigned u32x2 __attribute__((ext_vector_type(2)));

__device__ __forceinline__ unsigned pk2(float lo, float hi) { f32x2 v = {lo, hi}; h16x2 h = __builtin_convertvector(v, h16x2); return __builtin_bit_cast(unsigned, h); }
typedef __bf16 b16x2 __attribute__((ext_vector_type(2)));
__device__ __forceinline__ unsigned pk2b(float lo, float hi) { f32x2 v = {lo, hi}; b16x2 h = __builtin_convertvector(v, b16x2); return __builtin_bit_cast(unsigned, h); }
__device__ __forceinline__ u16 f2b(float f) { return (u16)(pk2b(f, 0.f) & 0xffffu); }
__device__ __forceinline__ float blo(unsigned u) { return __builtin_bit_cast(float, u << 16); }
__device__ __forceinline__ float bhi(unsigned u) { return __builtin_bit_cast(float, u & 0xffff0000u); }
__device__ __forceinline__ u16 f2h(float f) { _Float16 h = (_Float16)f; return __builtin_bit_cast(u16, h); }
__device__ __forceinline__ float h2f(u16 u) { return (float)__builtin_bit_cast(_Float16, u); }
__device__ __forceinline__ float hlo(unsigned u) { return (float)__builtin_bit_cast(h16x2, u)[0]; }
__device__ __forceinline__ float hhi(unsigned u) { return (float)__builtin_bit_cast(h16x2, u)[1]; }
__device__ __forceinline__ float fsigmoid(float x) { return __builtin_amdgcn_rcpf(1.0f + __builtin_amdgcn_exp2f(-1.44269504089f * x)); }
__device__ __forceinline__ float fsilu(float x) { return x * fsigmoid(x); }
#define DPP_ADD_(v, ctrl, rmask) (v) += __builtin_bit_cast(float, __builtin_amdgcn_update_dpp(0, __builtin_bit_cast(int, (v)), (ctrl), (rmask), 0xf, false))
__device__ __forceinline__ float sum16(float v) {
    DPP_ADD_(v, 0xB1, 0xf); DPP_ADD_(v, 0x4E, 0xf); DPP_ADD_(v, 0x141, 0xf); DPP_ADD_(v, 0x140, 0xf); return v; }
__device__ __forceinline__ float wave_sum(float v) {
    v = sum16(v); DPP_ADD_(v, 0x142, 0xa); DPP_ADD_(v, 0x143, 0xc);
    return __builtin_bit_cast(float, __builtin_amdgcn_readlane(__builtin_bit_cast(int, v), 63)); }
__device__ __forceinline__ float xsum32(float v) {
    const unsigned u = __builtin_bit_cast(unsigned, v); auto r = __builtin_amdgcn_permlane32_swap(u, u, false, false); const unsigned a = r[0], b = r[1];
    return __builtin_bit_cast(float, a) + __builtin_bit_cast(float, b); }
__device__ __forceinline__ float xsum16(float v) {
    const unsigned u = __builtin_bit_cast(unsigned, v); auto r = __builtin_amdgcn_permlane16_swap(u, u, false, false); const unsigned a = r[0], b = r[1];
    return __builtin_bit_cast(float, a) + __builtin_bit_cast(float, b); }
__device__ __forceinline__ void pair16(float& a, float& b) {
    auto r = __builtin_amdgcn_permlane16_swap(__builtin_bit_cast(unsigned, a), __builtin_bit_cast(unsigned, b), false, false); const unsigned x = r[0], y = r[1];
    a = __builtin_bit_cast(float, x); b = __builtin_bit_cast(float, y); }
__device__ __forceinline__ float xmax32(float v) { const unsigned u = __builtin_bit_cast(unsigned, v); auto r = __builtin_amdgcn_permlane32_swap(u, u, false, false); const unsigned a = r[0], b = r[1];
    return fmaxf(__builtin_bit_cast(float, a), __builtin_bit_cast(float, b)); }
__device__ __forceinline__ float xmax16(float v) { const unsigned u = __builtin_bit_cast(unsigned, v); auto r = __builtin_amdgcn_permlane16_swap(u, u, false, false); const unsigned a = r[0], b = r[1];
    return fmaxf(__builtin_bit_cast(float, a), __builtin_bit_cast(float, b)); }
__device__ __forceinline__ int fresh_tid() { int t = threadIdx.x; asm volatile("" : "+v"(t)); return t; }
#define MFMA16(a, b, c) __builtin_amdgcn_mfma_f32_16x16x32_f16((a), (b), (c), 0, 0, 0)
typedef short s16x4 __attribute__((ext_vector_type(4)));
typedef short s16x8 __attribute__((ext_vector_type(8)));
__device__ __forceinline__ h16x8 lds_tr16(const __attribute__((address_space(3))) unsigned short* img, int pitch, int k0, int n0, int lane) {
    const int g = lane >> 4, q = (lane & 15) >> 2, p = lane & 3;
    const __attribute__((address_space(3))) unsigned short* a = img + (k0 + 8 * g + q) * pitch + n0 + 4 * p;
    const s16x4 r0 = __builtin_amdgcn_ds_read_tr16_b64_v4i16((__attribute__((address_space(3))) s16x4*)a);
    const s16x4 r1 = __builtin_amdgcn_ds_read_tr16_b64_v4i16((__attribute__((address_space(3))) s16x4*)(a + 4 * pitch));
    return __builtin_bit_cast(h16x8, __builtin_shufflevector(r0, r1, 0, 1, 2, 3, 4, 5, 6, 7));
}

namespace pg8 {
#ifndef PG8_ZC
#define PG8_ZC 1
#endif
#ifndef PG8_SPLIT
#define PG8_SPLIT false
#endif
constexpr int BM = 256, BK = 64, HALF = 128, HTB = HALF * BK * 2, STAGE_BYTES = 8 * HTB, NXCD = 8, WGM = 8;
__host__ __device__ __forceinline__ int lds_byte(int r, int c) { const int st = (r >> 4) * 2 + (c >> 5), rr = r & 15, cc = c & 31, ob = rr * 64 + cc * 2; return st * 1024 + (ob ^ (((ob >> 9) & 1) << 5)); }
__host__ __device__ __forceinline__ void stage_rc(int b, int& R, int& C) { const int st = b / 1024, sb = b % 1024, swz = sb ^ (((sb >> 9) & 1) << 5); R = (st >> 1) * 16 + swz / 64; C = (st & 1) * 32 + (swz % 64) / 2; }
__host__ __device__ __forceinline__ int perm32(int rho) { const int n = rho >> 4, i = rho & 15; return 8 * (i >> 2) + 4 * n + (i & 3); }
__host__ __device__ __forceinline__ size_t blk32(int row, int col, int K) { return ((size_t)(row >> 5) * (K >> 5) + (col >> 5)) * 1024 + (row & 31) * 32 + (col & 31); }
struct Unit { int pm, pn; };
struct Gemm { const u16* A; const u16* Bt; int M, N, K; int lda, asplit; unsigned aofs; };
struct StaticOrder {
    int nM, nN, nwg, G, c;
    __host__ __device__ void init(int M, int N, int G_, int c_) { nM = M / BM; nN = N / BM; nwg = nM * nN; G = G_; c = c_; }
    __host__ __device__ bool next(int i, Unit& u) const {
        const long L = (long)i * G + c; if (L >= nwg) return false;
        int wgid = (int)L; { const int q = nwg / NXCD, r = nwg % NXCD, xcd = wgid % NXCD, off = wgid / NXCD; wgid = (xcd < r ? xcd * (q + 1) : r * (q + 1) + (xcd - r) * q) + off; }
        const int nig = WGM * nN, gid = wgid / nig, fm = gid * WGM, gsz = (nM - fm) < WGM ? (nM - fm) : WGM;
        u.pm = fm + ((wgid % nig) % gsz); u.pn = (wgid % nig) / gsz; return true;
    }
    __device__ __forceinline__ void a_ready(const Unit&, int) const {}
    __device__ __forceinline__ void done(const Unit&) const {}
};
__device__ __forceinline__ void load_scales(LAS float* dst, const float* rsq, int pm, int tid) {
    const int r = tid >> 1, hf = tid & 1;
    const f32x4* p = (const f32x4*)(rsq + (size_t)pm * 4096) + (unsigned)(tid * 2);
    const f32x4 a = p[0], b = p[1]; const f32x4 t = a + b; float s = (t[0] + t[1]) + (t[2] + t[3]);
    s += __builtin_bit_cast(float, __builtin_amdgcn_update_dpp(0, __builtin_bit_cast(int, s), 0xB1, 0xF, 0xF, true));
    if (hf == 0) dst[(((r >> 6) & 1) * 16 + (r & 15)) * 8 + (r >> 7) * 4 + ((r >> 4) & 3)] = __builtin_amdgcn_rsqf(s * (1.0f / 1024.0f) + 1e-6f);
}
template <bool RS> struct EpiStoreH {
    static constexpr bool PERM = true, SPLIT = PG8_SPLIT, HALVES = true, RS_LDS = RS;
    static constexpr int NST = 8;
    u16* O; int ldc; int split_cols; size_t split_stride; const float* rsv;
    template <int AI> __device__ __forceinline__ void half(const f32x4 (&acc)[2][2][4][2], const Unit& u, int wr, int wc, int fr_in, int fq_in, const LAS float* rs) const {
        int fr = fr_in, fq = fq_in; asm volatile("" : "+v"(fr), "+v"(fq));
        const int row0 = u.pm * BM + wr * 64 + fr + AI * HALF; int colt = u.pn * BM; u16* base = O;
        if (split_cols) { const int t = colt / split_cols; base += (size_t)t * split_stride; colt -= t * split_cols; }
        const int col0 = colt + wc * 32 + 8 * fq;
        f32x4 rsa = {1.f, 1.f, 1.f, 1.f};
        if (RS) rsa = *(const LAS f32x4*)(rs + (wr * 16 + fr) * 8 + AI * 4);
        u16* p0 = base + blk32(row0, col0, ldc);
#pragma unroll
        for (int m = 0; m < 4; ++m) {
            const float rsc = rsa[m];
#pragma unroll
            for (int bj = 0; bj < 2; ++bj) { const f32x4 v0 = acc[AI][bj][m][0] * rsc, v1 = acc[AI][bj][m][1] * rsc;
                u32x4 w; w.x = pk2(v0[0], v0[1]); w.y = pk2(v0[2], v0[3]); w.z = pk2(v1[0], v1[1]); w.w = pk2(v1[2], v1[3]);
                __builtin_nontemporal_store(w, (u32x4*)(p0 + (size_t)(m >> 1) * (ldc >> 5) * 1024 + (m & 1) * 512 + bj * (HALF / 32) * 1024)); } }
    }
};
struct EpiSwiglu {
    static constexpr bool PERM = true, SPLIT = PG8_SPLIT, HALVES = true, RS_LDS = true;
    static constexpr int NST = 4;
    u16* O; int ldc; const float* rsv;
    template <int AI> __device__ __forceinline__ void half(const f32x4 (&acc)[2][2][4][2], const Unit& u, int wr, int wc, int fr_in, int fq_in, const LAS float* rs) const {
        int fr = fr_in, fq = fq_in; asm volatile("" : "+v"(fr), "+v"(fq));
        const int row0 = u.pm * BM + wr * 64 + fr + AI * HALF, col0 = u.pn * HALF + wc * 32 + 8 * fq;
        const f32x4 rsa = *(const LAS f32x4*)(rs + (wr * 16 + fr) * 8 + AI * 4);
        u16* p0 = O + blk32(row0, col0, ldc);
#pragma unroll
        for (int m = 0; m < 4; ++m) { u16* rowp = p0 + (size_t)(m >> 1) * (ldc >> 5) * 1024 + (m & 1) * 512;
            const float rsc = rsa[m]; const f32x2 rs2 = {rsc, rsc};
            unsigned ow[4];
#pragma unroll
            for (int p = 0; p < 4; ++p) {
                const f32x4 ga = acc[AI][0][m][p >> 1], ua = acc[AI][1][m][p >> 1];
                const f32x2 g2 = (f32x2){ga[2 * (p & 1)], ga[2 * (p & 1) + 1]} * rs2, u2 = (f32x2){ua[2 * (p & 1)], ua[2 * (p & 1) + 1]} * rs2;
                const f32x2 t2 = g2 * (f32x2){-1.44269504089f, -1.44269504089f};
                const f32x2 d2 = (f32x2){__builtin_amdgcn_exp2f(t2.x), __builtin_amdgcn_exp2f(t2.y)} + (f32x2){1.0f, 1.0f};
                const f32x2 o2 = (g2 * (f32x2){__builtin_amdgcn_rcpf(d2.x), __builtin_amdgcn_rcpf(d2.y)}) * u2;
                ow[p] = pk2b(o2.x, o2.y); }
            u32x4 w; w.x = ow[0]; w.y = ow[1]; w.z = ow[2]; w.w = ow[3];
            __builtin_nontemporal_store(w, (u32x4*)rowp); }
    }
};
constexpr size_t H16_OFF = (size_t)127 << 20, RSQ_OFF = (size_t)255 << 20;
struct EpiResid {
    static constexpr bool PERM = true, SPLIT = false, HALVES = false, RS_LDS = false;
    static constexpr int NST = 0;
    static constexpr int ldc = 1024;
    static constexpr const float* rsv = nullptr;
    template <int AI> __device__ __forceinline__ void half(const f32x4 (&)[2][2][4][2], const Unit&, int, int, int, int, const LAS float*) const {}
    unsigned char* wsb; float scale;
    __device__ __forceinline__ void operator()(const f32x4 (&acc)[2][2][4][2], const Unit& u, int wr, int wc, int fr_in, int fq_in, int, const LAS float*) const {
        int fr = fr_in, fq = fq_in; asm volatile("" : "+v"(fr), "+v"(fq));
        const int row0 = u.pm * BM + wr * 64 + fr, col0 = u.pn * BM + wc * 32 + 8 * fq;
        u16* h16 = (u16*)(wsb + H16_OFF); float* rsq = (float*)(wsb + RSQ_OFF);
#pragma unroll
        for (int ai = 0; ai < 2; ++ai)
#pragma unroll
            for (int m = 0; m < 4; ++m) { const int rw = row0 + ai * HALF + m * 16; float sq = 0.f;
                u32x4 hv[2];
#pragma unroll
                for (int bj = 0; bj < 2; ++bj) hv[bj] = *(const u32x4*)(h16 + blk32(rw, col0 + bj * HALF, ldc));
#pragma unroll
                for (int bj = 0; bj < 2; ++bj) { unsigned ow[4];
#pragma unroll
                    for (int n = 0; n < 2; ++n) { const unsigned w0 = hv[bj][2 * n], w1 = hv[bj][2 * n + 1];
                        const f32x4 bs = {blo(w0), bhi(w0), blo(w1), bhi(w1)}; const f32x4 o = bs + acc[ai][bj][m][n] * scale;
                        ow[2 * n] = pk2b(o[0], o[1]); ow[2 * n + 1] = pk2b(o[2], o[3]);
                        sq += (o[0] * o[0] + o[1] * o[1]) + (o[2] * o[2] + o[3] * o[3]); }
                    u32x4 w; w.x = ow[0]; w.y = ow[1]; w.z = ow[2]; w.w = ow[3]; *(u32x4*)(h16 + blk32(rw, col0 + bj * HALF, ldc)) = w; }
                sq = xsum16(sq); sq = xsum32(sq);
                if (fq == 0) rsq[(size_t)(row0 + ai * HALF + m * 16) * 16 + 4 * u.pn + wc] = sq;
                asm volatile("" ::: "memory"); }
    }
};
struct EpiGate {
    static constexpr bool PERM = true, SPLIT = false, HALVES = false, RS_LDS = true;
    static constexpr int NST = 0;
    template <int AI> __device__ __forceinline__ void half(const f32x4 (&)[2][2][4][2], const Unit&, int, int, int, int, const LAS float*) const {}
    const float* ba; const float* bb; const u16* tA; const u16* tB; u16* O; int ldc; const float* rsv;
    __device__ __forceinline__ void operator()(const f32x4 (&acc)[2][2][4][2], const Unit& u, int wr, int wc, int fr_in, int fq_in, int ui, const LAS float* rs) const {
        int fr = fr_in, fq = fq_in; asm volatile("" : "+v"(fr), "+v"(fq));
        const int row0 = u.pm * BM + wr * 64 + fr, col0 = u.pn * HALF + wc * 32 + 8 * fq;
        float va[8], vb[8];
#pragma unroll
        for (int j = 0; j < 8; ++j) { va[j] = ba[col0 + j]; vb[j] = bb[col0 + j]; }
        f32x4 rsa[2]; { const LAS f32x4* rp = (const LAS f32x4*)(rs + (wr * 16 + fr) * 8); rsa[0] = rp[0]; rsa[1] = rp[1]; }
#pragma unroll
        for (int ai = 0; ai < 2; ++ai)
#pragma unroll
            for (int m = 0; m < 4; ++m) { const size_t off = (size_t)(row0 + ai * HALF + m * 16) * ldc + col0;
                const size_t boff = blk32(row0 + ai * HALF + m * 16, col0, ldc); const u32x4 a4 = *(const u32x4*)(tA + boff), b4 = *(const u32x4*)(tB + boff);
                const float rs = rsa[ai][m];
                const f32x2 rs2 = {rs, rs}; unsigned ow[4];
#pragma unroll
                for (int p = 0; p < 4; ++p) {
                    const f32x4 xa = acc[ai][0][m][p >> 1], xb = acc[ai][1][m][p >> 1]; const int e = 2 * p;
                    const f32x2 pa = (f32x2){xa[2 * (p & 1)], xa[2 * (p & 1) + 1]} * rs2 + (f32x2){va[e], va[e + 1]}, pb = (f32x2){xb[2 * (p & 1)], xb[2 * (p & 1) + 1]} * rs2 + (f32x2){vb[e], vb[e + 1]};
                    const f32x2 ta2 = pa * (f32x2){-1.44269504089f, -1.44269504089f}, tb2 = pb * (f32x2){-1.44269504089f, -1.44269504089f};
                    const f32x2 da = (f32x2){__builtin_amdgcn_exp2f(ta2.x), __builtin_amdgcn_exp2f(ta2.y)} + (f32x2){1.0f, 1.0f}, db = (f32x2){__builtin_amdgcn_exp2f(tb2.x), __builtin_amdgcn_exp2f(tb2.y)} + (f32x2){1.0f, 1.0f};
                    const f32x2 tA = {hlo(a4[p]), hhi(a4[p])}, tB = {hlo(b4[p]), hhi(b4[p])};
                    const f32x2 o2 = (f32x2){__builtin_amdgcn_rcpf(da.x), __builtin_amdgcn_rcpf(da.y)} * tA + (f32x2){__builtin_amdgcn_rcpf(db.x), __builtin_amdgcn_rcpf(db.y)} * tB;
                    ow[p] = pk2b(o2.x, o2.y); }
                u32x4 w; w.x = ow[0]; w.y = ow[1]; w.z = ow[2]; w.w = ow[3];
                __builtin_nontemporal_store(w, (u32x4*)(O + blk32(row0 + ai * HALF + m * 16, col0, ldc))); }
    }
};

typedef __bf16 bf16x8 __attribute__((ext_vector_type(8)));
#define MFMA16B(a, b, c) __builtin_amdgcn_mfma_f32_16x16x32_bf16(__builtin_bit_cast(bf16x8, (a)), __builtin_bit_cast(bf16x8, (b)), (c), 0, 0, 0)
template <bool ABLK, bool BBLK, class Epi, class Sched>
__device__ __forceinline__ void gemm_phase(LAS unsigned char* lds, const Gemm g, const Sched& S, const Epi& E) {
    const int tid = fresh_tid(), wid = __builtin_amdgcn_readfirstlane(tid >> 6), lane = tid & 63, wr = wid >> 2, wc = wid & 3, fr = lane & 15, fq = lane >> 4;
    const int K = g.K, KA = g.lda ? g.lda : K; int nt = K / BK; asm volatile("" : "+s"(nt));
    unsigned voffA, voffB;
    { int R, C; stage_rc(tid * 16, R, C); const int Rb = Epi::PERM ? ((R & ~31) + perm32(R & 31)) : R;
      voffA = ABLK ? (unsigned)blk32(R, C, KA) * 2u : (unsigned)(R * KA + C) * 2u; voffB = BBLK ? (unsigned)blk32(Rb, C, K) * 2u : (unsigned)(Rb * K + C) * 2u; }
    const size_t sA = (size_t)64 * KA * 2, sB = (size_t)64 * K * 2;
    const size_t kstepA = ABLK ? (size_t)4096 : (size_t)(BK * 2), kstepB = BBLK ? (size_t)4096 : (size_t)(BK * 2);
    const size_t hstep = (size_t)HALF * K * 2, hstepA = (size_t)HALF * KA * 2;
    const size_t tstep = 2 * hstep, tstepA = 2 * hstepA;
    const unsigned ldsw = (unsigned)wid * 1024u;
    const int aoff = lds_byte(wr * 64 + fr, fq * 8), boff = lds_byte(wc * 32 + fr, fq * 8);
#define PG8_SA(b, h) (((b) * 2 + (h)) * HTB)
#define PG8_SB(b, h) ((4 + (b) * 2 + (h)) * HTB)
#define PG8_STAGE(bufoff, gbase, voff) do { _Pragma("unroll") for (int _i = 0; _i < 2; ++_i) \
        __builtin_amdgcn_global_load_lds((const unsigned*)((const char*)(gbase) + _i * PG8_STEP_##voff + (voff)), (LAS unsigned*)(lds + (bufoff) + ldsw + _i * 8192), 16, 0, 0); } while (0)
#define PG8_STEP_voffA sA
#define PG8_STEP_voffB sB
#define PG8_LDA(dst, b, h) do { _Pragma("unroll") for (int m = 0; m < 4; ++m) _Pragma("unroll") for (int k = 0; k < 2; ++k) dst[m][k] = *(const LAS h16x8*)(lds + PG8_SA(b, h) + aoff + m * 2048 + k * 1024); } while (0)
#define PG8_LDB(dst, b, h) do { _Pragma("unroll") for (int n = 0; n < 2; ++n) _Pragma("unroll") for (int k = 0; k < 2; ++k) dst[n][k] = *(const LAS h16x8*)(lds + PG8_SB(b, h) + boff + n * 2048 + k * 1024); } while (0)
#define PG8_MMA(ai, bj, At, Bt) do { __builtin_amdgcn_s_setprio(1); _Pragma("unroll") for (int m = 0; m < 4; ++m) _Pragma("unroll") for (int n = 0; n < 2; ++n) _Pragma("unroll") for (int k = 0; k < 2; ++k) \
        acc[ai][bj][m][n] = MFMA16B(Bt[n][k], At[m][k], acc[ai][bj][m][n]); __builtin_amdgcn_s_setprio(0); } while (0)
#define PG8_MMAZ(ai, bj, At, Bt) do { __builtin_amdgcn_s_setprio(1); _Pragma("unroll") for (int m = 0; m < 4; ++m) _Pragma("unroll") for (int n = 0; n < 2; ++n) { \
        acc[ai][bj][m][n] = MFMA16B(Bt[n][0], At[m][0], zero4); acc[ai][bj][m][n] = MFMA16B(Bt[n][1], At[m][1], acc[ai][bj][m][n]); } __builtin_amdgcn_s_setprio(0); } while (0)
#define PG8_WAIT_V(n) asm volatile("s_waitcnt vmcnt(" #n ")" ::: "memory")
#define PG8_WAIT_VN(n) asm volatile("s_waitcnt vmcnt(%0)" :: "n"(n) : "memory")
#define PG8_WAIT_L(n) asm volatile("s_waitcnt lgkmcnt(" #n ")" ::: "memory")
#define PG8_BAR __builtin_amdgcn_s_barrier()
#define PG8_SCHED __builtin_amdgcn_sched_barrier(0)
#define PG8_H1P E.template half<1>(acc, prv, wr, wc, fr, fq, rsl + psb * 256)
#define PG8_H0C E.template half<0>(acc, cur, wr, wc, fr, fq, rsl + sb * 256)
#define PG8_ZERO(a) do { _Pragma("unroll") for (int b_ = 0; b_ < 2; ++b_) _Pragma("unroll") for (int m_ = 0; m_ < 4; ++m_) _Pragma("unroll") for (int n_ = 0; n_ < 2; ++n_) acc[a][b_][m_][n_] = zero4; } while (0)
    Unit cur, nxt, prv; int ui = 0; prv.pm = 0; prv.pn = 0;
    if (!S.next(0, cur)) return;
    f32x4 acc[2][2][4][2]; const f32x4 zero4 = {0.f, 0.f, 0.f, 0.f};
    PG8_ZERO(0); PG8_ZERO(1);
    h16x8 At[4][2], B0[2][2], B1[2][2];
    LAS float* rsl = (LAS float*)(lds + STAGE_BYTES);
    int sb = 0, psb = 0;
    if (Epi::RS_LDS) load_scales(rsl, E.rsv, cur.pm, tid);
    const char* cA = (const char*)g.A + (size_t)cur.pm * tstepA + ((g.asplit && cur.pn >= g.asplit) ? g.aofs : 0u); const char* cB = (const char*)g.Bt + (size_t)cur.pn * tstep;
    S.a_ready(cur, 0);
    PG8_STAGE(PG8_SB(0, 0), cB, voffB); PG8_STAGE(PG8_SB(0, 1), cB + hstep, voffB); PG8_STAGE(PG8_SA(0, 0), cA, voffA); PG8_STAGE(PG8_SA(0, 1), cA + hstepA, voffA);
    if (wr == 1) PG8_BAR;
    PG8_WAIT_V(2); PG8_BAR;
    PG8_STAGE(PG8_SB(1, 0), cB + kstepB, voffB); PG8_STAGE(PG8_SA(1, 0), cA + kstepA, voffA); PG8_STAGE(PG8_SB(1, 1), cB + hstep + kstepB, voffB);
    PG8_WAIT_V(6); PG8_BAR;
    for (;;) {
        const bool has_next = S.next(ui + 1, nxt);
        const char* nA = has_next ? (const char*)g.A + (size_t)nxt.pm * tstepA + ((g.asplit && nxt.pn >= g.asplit) ? g.aofs : 0u) : cA; const char* nB = has_next ? (const char*)g.Bt + (size_t)nxt.pn * tstep : cB;
        for (int t = 0; t < nt; t += 2) {
            const bool last = (t == nt - 2), fe = Epi::SPLIT && t == 0 && ui > 0;
            const char* a1 = cA + (size_t)(t + 1) * kstepA;
            const char* a2 = last ? nA : cA + (size_t)(t + 2) * kstepA; const char* b2 = last ? nB : cB + (size_t)(t + 2) * kstepB;
            const char* a3 = a2 + kstepA; const char* b3 = b2 + kstepB;
            PG8_LDB(B0, 0, 0); PG8_LDB(B1, 0, 1); PG8_SCHED; PG8_LDA(At, 0, 0); PG8_STAGE(PG8_SA(1, 1), a1 + hstepA, voffA);
            if (fe) { PG8_H1P; PG8_ZERO(1); PG8_WAIT_VN(8 + 2 * Epi::NST); } else PG8_WAIT_V(8);
            PG8_WAIT_L(0); PG8_BAR; PG8_MMA(0, 0, At, B0); PG8_MMA(0, 1, At, B1); PG8_BAR; PG8_SCHED;
            PG8_LDA(At, 0, 1); PG8_STAGE(PG8_SB(0, 0), b2, voffB); PG8_STAGE(PG8_SB(0, 1), b2 + hstep, voffB); PG8_STAGE(PG8_SA(0, 0), a2, voffA);
            if (fe) PG8_WAIT_VN(8 + 2 * Epi::NST); else PG8_WAIT_V(8);
            PG8_WAIT_L(0); PG8_BAR; PG8_MMA(1, 0, At, B0); PG8_MMA(1, 1, At, B1); PG8_BAR; PG8_SCHED;
            PG8_LDB(B0, 1, 0); PG8_LDB(B1, 1, 1); PG8_SCHED; PG8_LDA(At, 1, 0); PG8_STAGE(PG8_SA(0, 1), a2 + hstepA, voffA);
            if (fe) PG8_WAIT_VN(8 + Epi::NST); else PG8_WAIT_V(8);
            PG8_WAIT_L(0); PG8_BAR; PG8_MMA(0, 0, At, B0); PG8_MMA(0, 1, At, B1); PG8_BAR; PG8_SCHED;
            PG8_LDA(At, 1, 1); PG8_STAGE(PG8_SB(1, 0), b3, voffB); PG8_STAGE(PG8_SB(1, 1), b3 + hstep, voffB); PG8_STAGE(PG8_SA(1, 0), a3, voffA);
            if (Epi::SPLIT && last) { PG8_SCHED; PG8_H0C; PG8_ZERO(0); PG8_WAIT_VN(8 + Epi::NST); } else PG8_WAIT_V(8);
            PG8_WAIT_L(0); PG8_BAR; PG8_MMA(1, 0, At, B0); PG8_MMA(1, 1, At, B1); PG8_BAR; PG8_SCHED;
        }
        if constexpr (!Epi::SPLIT) {
            if (wr == 0) PG8_BAR;
            if constexpr (Epi::HALVES) { E.template half<0>(acc, cur, wr, wc, fr, fq, rsl + sb * 256); E.template half<1>(acc, cur, wr, wc, fr, fq, rsl + sb * 256); } else E(acc, cur, wr, wc, fr, fq, ui, rsl + sb * 256);
            if (!has_next) break;
            if (Epi::RS_LDS && nxt.pm != cur.pm) { sb ^= 1; load_scales(rsl + sb * 256, E.rsv, nxt.pm, tid); }
            cur = nxt; cA = nA; cB = nB; ++ui;
            if (wr == 1) PG8_BAR;
            PG8_SCHED; PG8_ZERO(0); PG8_ZERO(1); PG8_SCHED;
        } else {
            if (!has_next) { E.template half<1>(acc, cur, wr, wc, fr, fq, rsl + sb * 256); break; }
            prv = cur; psb = sb;
            if (Epi::RS_LDS && nxt.pm != cur.pm) { sb ^= 1; load_scales(rsl + sb * 256, E.rsv, nxt.pm, tid); }
            cur = nxt; cA = nA; cB = nB; ++ui;
        }
    }
    if (Epi::SPLIT) { if (wr == 0) PG8_BAR; }
    PG8_WAIT_V(0);
    PG8_BAR;
#undef PG8_ZERO
#undef PG8_H1P
#undef PG8_H0C
#undef PG8_NONE
#undef PG8_SA
#undef PG8_SB
#undef PG8_STAGE
#undef PG8_STEP_voffA
#undef PG8_STEP_voffB
#undef PG8_LDA
#undef PG8_LDB
#undef PG8_MMA
#undef PG8_MMAZ
#undef PG8_WAIT_V
#undef PG8_WAIT_VN
#undef PG8_WAIT_L
#undef PG8_BAR
#undef PG8_SCHED
}
}

#ifndef REP_CONV
#define REP_CONV 1
#endif
#ifndef REP_RMS
#define REP_RMS 1
#endif
#ifndef REP_MASK
#define REP_MASK 0
#endif
#define REPG(i) ((((REP_MASK) >> (i)) & 1) + 1)
#ifndef REP_G
#define REP_G 1
#endif
#ifndef REP_PREP
#define REP_PREP 1
#endif
#ifndef REP_PA
#define REP_PA 1
#endif
#ifndef REP_PB
#define REP_PB 1
#endif
#ifndef REP_POST
#define REP_POST 1
#endif
#ifndef REP_RET
#define REP_RET 1
#endif
#ifndef REP_XATT
#define REP_XATT 1
#endif
#ifndef REP_BAR
#define REP_BAR 1
#endif
constexpr int NWAVES = 8;
constexpr int D = 1024, NBATCH = 32, T = 2048, DEPTH = 4, M = NBATCH * T, MEML = 256, MM = NBATCH * MEML, DFF = 2816;
constexpr int AW = 512, INW = 6912, CH = 32, NCH = T / CH;
constexpr size_t MiB = 1u << 20;
constexpr size_t WS_CTL = 0, CTL_ZERO_BYTES = 1 * MiB;
constexpr size_t WS_WB = 1 * MiB;
constexpr size_t WB_WIN = 0, WB_WOUT = WB_WIN + 2 * (size_t)5632 * 1024 * 2, WB_WA = WB_WOUT + 2 * (size_t)1024 * 2816 * 2, WB_WBM = WB_WA + (size_t)1792 * 1024 * 2,
                 WB_WG = WB_WBM + (size_t)3072 * 1024 * 2, WB_WLR = WB_WG + (size_t)2048 * 1024 * 2, WB_PA = WB_WLR + (size_t)1536 * 256 * 2, WB_PB = WB_PA + (size_t)1024 * 512 * 2,
                 WB_WMO = WB_PB + 2 * MiB, WB_WQ = WB_WMO + 2 * MiB, WB_WK = WB_WQ + 2 * MiB, WB_WV = WB_WK + 2 * MiB, WB_WO = WB_WV + 2 * MiB, WB_END = WB_WO + 2 * MiB;
static_assert(WB_END <= 62 * MiB, "weights region");
static_assert(pg8::H16_OFF == 127 * MiB && pg8::RSQ_OFF == 255 * MiB, "EpiResid offsets");
constexpr size_t WS_MEMN = 63 * MiB, WS_KM = 79 * MiB, WS_VTM = 95 * MiB, WS_COS = 111 * MiB, WS_SIN = 119 * MiB, WS_XN = 127 * MiB, WS_RSQ = 255 * MiB, WS_AR = 259 * MiB;
constexpr size_t AR_ZA = 0, AR_YS = 192 * MiB, AR_ALR = 224 * MiB, AR_WAG = 256 * MiB, AR_PAO = 448 * MiB, AR_ST = 641 * MiB, AR_YA = 645 * MiB, AR_END = 709 * MiB;
constexpr size_t AR_ZB = 0, AR_YB = 384 * MiB, AR_TMPA = 0, AR_TMPB = 128 * MiB, AR_MRG = 256 * MiB, AR_Q = 0, AR_O = 128 * MiB, AR_ACT = 0;
constexpr size_t WS_END = WS_AR + AR_END;
constexpr int CW_BAR = 4096;
constexpr int LDS_BYTES = 163840, LDSCTL_OFF = LDS_BYTES - 256, LDS_RS_OFF = 131072;

__constant__ float c_invfreq[32] = {
    1.0f, 0.7498942093324559f, 0.5623413251903491f, 0.4216965034285822f, 0.31622776601683794f, 0.23713737056616552f, 0.1778279410038923f, 0.1333521432163324f,
    0.1f, 0.07498942093324559f, 0.05623413251903491f, 0.04216965034285822f, 0.031622776601683794f, 0.023713737056616552f, 0.01778279410038923f, 0.01333521432163324f,
    0.01f, 0.007498942093324559f, 0.005623413251903491f, 0.004216965034285822f, 0.0031622776601683794f, 0.0023713737056616554f, 0.001778279410038923f, 0.001333521432163324f,
    0.001f, 0.0007498942093324559f, 0.0005623413251903491f, 0.0004216965034285822f, 0.00031622776601683794f, 0.00023713737056616554f, 0.0001778279410038923f, 0.0001333521432163324f };

#define XB_TMO      128
#define XB_XCNT(j)  (256  + 64 * (j))
#define XB_XSUB(j)  (1280 + 64 * (j))
#define XB_XGEN(j)  (2304 + 64 * (j))
#define XB_TOP      3328
#define XB_TOPGEN   3392
#define XCD_BAR_WORDS 3456
#define XB_SPIN_CAP (1u << 18)
__device__ __forceinline__ unsigned xb_ld(unsigned* p)              { return __hip_atomic_load(p, __ATOMIC_RELAXED, __HIP_MEMORY_SCOPE_AGENT); }
__device__ __forceinline__ unsigned xb_add(unsigned* p, unsigned v) { return __hip_atomic_fetch_add(p, v, __ATOMIC_RELAXED, __HIP_MEMORY_SCOPE_AGENT); }
__device__ __forceinline__ unsigned xb_xcc_id() { return (unsigned)__builtin_amdgcn_s_getreg((3 << 11) | 20) & 0xFu; }
#define XB_SPIN(cond, bar) do { unsigned _sp = 0; while (cond) { __builtin_amdgcn_s_sleep(1); \
    if ((++_sp & 255u) == 0u) { if (xb_ld(&(bar)[XB_TMO])) break; if (_sp > XB_SPIN_CAP) { atomicAdd(&(bar)[XB_TMO], 1u); break; } } } } while (0)
struct XcdBarrier { unsigned* bar; unsigned x; volatile LAS unsigned* st; };
__device__ __forceinline__ XcdBarrier xcd_barrier_post(unsigned* bar, volatile LAS unsigned* st) {
    XcdBarrier b; b.bar = bar; b.x = xb_xcc_id(); b.st = st;
    if (threadIdx.x == 0) (void)xb_add(&bar[XB_XCNT(b.x)], 1u);
    return b;
}
__device__ __forceinline__ void xcd_barrier_complete(unsigned* bar, unsigned x, unsigned& nloc, unsigned& nx) {
    const unsigned G = gridDim.x * gridDim.y * gridDim.z;
    unsigned sum, cnt, mine, sp = 0u;
    for (;;) {
        sum = 0u; cnt = 0u; mine = 0u;
#pragma unroll
        for (unsigned j = 0; j < 16; ++j) { const unsigned c = xb_ld(&bar[XB_XCNT(j)]); sum += c; cnt += (c > 0u) ? 1u : 0u; mine = (j == x) ? c : mine; }
        if (sum == G) break;
        __builtin_amdgcn_s_sleep(1);
        if ((++sp & 255u) == 0u) { if (xb_ld(&bar[XB_TMO])) break; if (sp > XB_SPIN_CAP) { atomicAdd(&bar[XB_TMO], 1u); break; } }
    }
    nloc = mine > 0u ? mine : 1u; nx = cnt > 0u ? cnt : 1u;
}
__device__ __forceinline__ void xcd_barrier(const XcdBarrier& b) {
    asm volatile("s_waitcnt vmcnt(0)" ::: "memory");
    __syncthreads();
    if (threadIdx.x == 0) {
        unsigned* bar = b.bar;
        __builtin_amdgcn_s_waitcnt(0);
        unsigned nloc = b.st[0], nx = b.st[1];
        if (nloc == 0u) { xcd_barrier_complete(bar, b.x, nloc, nx); b.st[0] = nloc; b.st[1] = nx; }
        const unsigned old = xb_add(&bar[XB_XSUB(b.x)], 1u);
        const unsigned gen = old / nloc;
        if (old + 1u == (gen + 1u) * nloc) {
            __builtin_amdgcn_fence(__ATOMIC_RELEASE, "agent");
            asm volatile("s_waitcnt vmcnt(0)" ::: "memory");
            const unsigned og = xb_add(&bar[XB_TOP], 1u);
            const unsigned tg = og / nx;
            if (og + 1u == (tg + 1u) * nx) xb_add(&bar[XB_TOPGEN], 1u);
            else XB_SPIN(xb_ld(&bar[XB_TOPGEN]) == tg, bar);
            __builtin_amdgcn_fence(__ATOMIC_ACQUIRE, "agent");
            xb_add(&bar[XB_XGEN(b.x)], 1u);
            asm volatile("s_waitcnt vmcnt(0)" ::: "memory");
        } else {
            XB_SPIN(xb_ld(&bar[XB_XGEN(b.x)]) == gen, bar);
            __builtin_amdgcn_fence(__ATOMIC_ACQUIRE, "agent");
            asm volatile("s_waitcnt vmcnt(0)" ::: "memory");
        }
    }
    __syncthreads();
}

struct Args { const void* in[27]; float* out; unsigned char* ws; int pad0, pad1; };
#define KBASE() const CAS char* kbase_ = (const CAS char*)__builtin_amdgcn_kernarg_segment_ptr(); asm volatile("" : "+s"(kbase_))
#define KARG(k) (*(void* const CAS*)(kbase_ + 8 * (k)))
struct Frame { LAS unsigned char* lds; int G; };
#define PHASE_IDS() KBASE(); const int tid = fresh_tid(), lane = tid & 63, wave = __builtin_amdgcn_readfirstlane(tid >> 6), gw = (int)blockIdx.x * NWAVES + wave, NGW = F.G * NWAVES; (void)lane; (void)gw; (void)NGW
#define LDS_WAIT() asm volatile("s_waitcnt lgkmcnt(0)" ::: "memory")
#define LDS_BARRIER() do { asm volatile("s_waitcnt lgkmcnt(0)" ::: "memory"); __builtin_amdgcn_s_barrier(); asm volatile("" ::: "memory"); } while (0)

__device__ __forceinline__ void conv_matrix(const Frame& F, const float* W, int ldw, int coff, int K, int N, u16* WT, int mode, int NH, const float* gain) {
    for (int rep = 0; rep < REP_CONV; ++rep) {
    PHASE_IDS();
    LAS float* scr = (LAS float*)(F.lds + wave * 8448);
    const int nblk = N / 32, nitems = (K / 64) * nblk;
    for (int item = gw; item < nitems; item += NGW) {
        const int kb = item / nblk, nb = item % nblk, k0 = 64 * kb, n0 = 32 * nb;
        int d0 = n0;
        if (mode == 1) { d0 = (n0 < NH) ? (n0 / 128) * 256 + (n0 % 128) : ((n0 - NH) / 128) * 256 + 128 + ((n0 - NH) % 128); }
#pragma unroll
        for (int i = 0; i < 8; ++i) { const int kk = 8 * i + (lane >> 3), n4 = 4 * (lane & 7);
            f32x4 w4 = *(const f32x4*)(W + (size_t)(k0 + kk) * ldw + coff + n0 + n4); if (gain) w4 = w4 * gain[k0 + kk];
            scr[kk * 33 + n4] = w4[0]; scr[kk * 33 + n4 + 1] = w4[1]; scr[kk * 33 + n4 + 2] = w4[2]; scr[kk * 33 + n4 + 3] = w4[3]; }
        LDS_WAIT(); asm volatile("" ::: "memory");
        const int c = lane & 7;
#pragma unroll
        for (int j = 0; j < 4; ++j) { const int n = (lane >> 3) + 8 * j; const LAS float* s = scr + (8 * c) * 33 + n;
            u32x4 o; o.x = pk2b(s[0 * 33], s[1 * 33]); o.y = pk2b(s[2 * 33], s[3 * 33]); o.z = pk2b(s[4 * 33], s[5 * 33]); o.w = pk2b(s[6 * 33], s[7 * 33]);
            *(u32x4*)(WT + pg8::blk32(d0 + n, k0 + 8 * c, K)) = o; }
        LDS_WAIT(); asm volatile("" ::: "memory");
    }
    }
}
__device__ __forceinline__ void rms_row_h(const float* xrow, const float* g, u16* obase, int row, int lane) {
    const f32x4* xr = (const f32x4*)xrow + lane; const f32x4* gr = (const f32x4*)g + lane;
    f32x4 v[4]; float s = 0.f;
#pragma unroll
    for (int j = 0; j < 4; ++j) { v[j] = xr[64 * j]; s += (v[j].x * v[j].x + v[j].y * v[j].y) + (v[j].z * v[j].z + v[j].w * v[j].w); }
    const float r = __builtin_amdgcn_rsqf(wave_sum(s) * (1.f / D) + 1e-6f);
#pragma unroll
    for (int j = 0; j < 4; ++j) { const f32x4 gg = gr[64 * j]; u32x2 w; w.x = pk2b(v[j].x * r * gg.x, v[j].y * r * gg.y); w.y = pk2b(v[j].z * r * gg.z, v[j].w * r * gg.w); *(u32x2*)(obase + pg8::blk32(row, 4 * lane + 256 * j, D)) = w; }
}
__device__ __forceinline__ void rms_phase(const Frame& F, const float* src, const float* g, u16* dst, int rows) {
    for (int rep = 0; rep < REP_RMS; ++rep) {
    PHASE_IDS();
    for (int m = gw; m < rows; m += NGW) rms_row_h(src + (size_t)m * D, g, dst, m, lane);
    }
}


typedef float f32x8 __attribute__((ext_vector_type(8)));
typedef float f32x16 __attribute__((ext_vector_type(16)));
#define SLOAD8(dst, base, off) asm volatile("s_load_dwordx8 %0, %1, " #off : "=s"(dst) : "s"(base))
#define SLOAD16(dst, base, off) asm volatile("s_load_dwordx16 %0, %1, " #off : "=s"(dst) : "s"(base))
__device__ __forceinline__ int rsv_index(int row) { const int pm = row >> 8, R = row & 255; return ((pm * 2 + ((R >> 6) & 1)) * 16 + (R & 15)) * 8 + (R >> 7) * 4 + ((R >> 4) & 3); }
#define RS_PASS() do { KBASE(); for (int m_ = (int)blockIdx.x * (NWAVES * 64) + fresh_tid(); m_ < M; m_ += F.G * NWAVES * 64) { const f32x4* p_ = (const f32x4*)(RSQ + (size_t)m_ * 16); \
        const f32x4 a_ = p_[0], b_ = p_[1], c_ = p_[2], d_ = p_[3]; const f32x4 t_ = (a_ + b_) + (c_ + d_); \
        RSV[rsv_index(m_)] = __builtin_amdgcn_rsqf(((t_[0] + t_[1]) + (t_[2] + t_[3])) * (1.0f / 1024.0f) + 1e-6f); } } while (0)
__device__ __forceinline__ size_t za_idx(int m, int col) { return (size_t)(col >> 8) * ((size_t)M * 256) + (size_t)m * 256 + (col & 255); }


#define x_in        ((const float*)KARG(0))
#define mem_in      ((const float*)KARG(1))
#define pos_in      ((const int*)KARG(2))
#define norm_g      ((const float*)KARG(3))
#define ffn_w_in    ((const float*)KARG(4))
#define ffn_w_out   ((const float*)KARG(5))
#define mix_w_in    ((const float*)KARG(6))
#define mix_gate_b  ((const float*)KARG(7))
#define shift_mu    ((const float*)KARG(8))
#define a_w0        ((const float*)KARG(9))
#define a_w_up      ((const float*)KARG(10))
#define a_a0        ((const float*)KARG(11))
#define a_a_up      ((const float*)KARG(12))
#define a_g_up      ((const float*)KARG(13))
#define a_k_k       ((const float*)KARG(14))
#define a_k_a       ((const float*)KARG(15))
#define a_r_k       ((const float*)KARG(16))
#define a_ln        ((const float*)KARG(17))
#define b_gn        ((const float*)KARG(18))
#define w_branch_a  ((const float*)KARG(19))
#define w_branch_b  ((const float*)KARG(20))
#define mix_w_out   ((const float*)KARG(21))
#define mem_norm    ((const float*)KARG(22))
#define cross_w_q   ((const float*)KARG(23))
#define cross_w_kv  ((const float*)KARG(24))
#define cross_w_o   ((const float*)KARG(25))
#define final_norm  ((const float*)KARG(26))
#define WSP(TY, off) ((TY*)((unsigned char*)KARG(28) + (off)))
#define W_in_t  WSP(u16, WS_WB + WB_WIN)
#define W_out_t WSP(u16, WS_WB + WB_WOUT)
#define W_A_t   WSP(u16, WS_WB + WB_WA)
#define W_B_t   WSP(u16, WS_WB + WB_WBM)
#define W_G_t   WSP(u16, WS_WB + WB_WG)
#define W_LR_t  WSP(u16, WS_WB + WB_WLR)
#define P_A_t   WSP(u16, WS_WB + WB_PA)
#define P_B_t   WSP(u16, WS_WB + WB_PB)
#define W_MO_t  WSP(u16, WS_WB + WB_WMO)
#define W_Q_t   WSP(u16, WS_WB + WB_WQ)
#define W_K_t   WSP(u16, WS_WB + WB_WK)
#define W_V_t   WSP(u16, WS_WB + WB_WV)
#define W_O_t   WSP(u16, WS_WB + WB_WO)
#define MEMN    WSP(u16, WS_MEMN)
#define KM      WSP(u16, WS_KM)
#define VTM     WSP(u16, WS_VTM)
#define COS     WSP(float, WS_COS)
#define SIN     WSP(float, WS_SIN)
#define H16     WSP(u16, WS_XN)
#define YS      WSP(u16, WS_AR + AR_YS)
#define RSQ     WSP(float, WS_RSQ)
#define RSV     WSP(float, WS_CTL + 512 * 1024)
#define ZA      WSP(u16, WS_AR + AR_ZA)
#define ALR     WSP(u16, WS_AR + AR_ALR)
#define WAG     WSP(u16, WS_AR + AR_WAG)
#define YA      WSP(u16, WS_AR + AR_YA)
#define ZB      WSP(u16, WS_AR + AR_ZB)
#define YB      WSP(u16, WS_AR + AR_YB)
#define TMPA    WSP(u16, WS_AR + AR_TMPA)
#define TMPB    WSP(u16, WS_AR + AR_TMPB)
#define MRG     WSP(u16, WS_AR + AR_MRG)
#define QX      WSP(u16, WS_AR + AR_Q)
#define OX      WSP(u16, WS_AR + AR_O)
#define ACT     WSP(u16, WS_AR + AR_ACT)
#define H       ((float*)KARG(27))

__global__ void __launch_bounds__(NWAVES * 64, 2) fwd_kernel(Args args) {
    extern __shared__ __attribute__((aligned(16))) unsigned char lds_raw[];
    Frame F;
    F.lds = (LAS unsigned char*)lds_raw;
    F.G = gridDim.x;
    volatile LAS unsigned* MISC = (volatile LAS unsigned*)(F.lds + LDSCTL_OFF);
    for (int u = threadIdx.x; u < 64; u += NWAVES * 64) MISC[u] = 0u;
    __syncthreads();
    XcdBarrier bar; { KBASE(); bar = xcd_barrier_post((unsigned*)((unsigned char*)KARG(28) + WS_CTL) + CW_BAR, MISC + 8); }
#define GRID_BAR() do { for (int rb_ = 0; rb_ < REP_BAR; ++rb_) xcd_barrier(bar); } while (0)


    { KBASE();
    for (int i = blockIdx.x * (NWAVES * 64) + threadIdx.x; i < M * 32; i += F.G * NWAVES * 64) {
        const int m = i >> 5, f = i & 31;
        const double a = (double)pos_in[m] * (double)c_invfreq[f] * 0.15915494309189535;
        const float fr = (float)(a - __builtin_rint(a));
        COS[i] = __builtin_amdgcn_cosf(fr); SIN[i] = __builtin_amdgcn_sinf(fr);
    }
    }

    {
        PHASE_IDS();
        for (int m = gw; m < M; m += NGW) {
            const f32x4* xr = (const f32x4*)(x_in + (size_t)m * D) + lane; float sq = 0.f;
#pragma unroll
            for (int j = 0; j < 4; ++j) { const f32x4 v = xr[64 * j]; sq += (v.x * v.x + v.y * v.y) + (v.z * v.z + v.w * v.w); u32x2 w; w.x = pk2b(v.x, v.y); w.y = pk2b(v.z, v.w); *(u32x2*)(H16 + pg8::blk32(m, 4 * lane + 256 * j, D)) = w; }
            sq = wave_sum(sq);
            if (lane < 16) RSQ[(size_t)m * 16 + lane] = (lane == 0) ? sq : 0.f;
        }
    }
    for (int l = 0; l < DEPTH; ++l) {
        { KBASE();
            for (int s = 0; s < 2; ++s) {
                conv_matrix(F, ffn_w_in + ((size_t)l * 2 + s) * D * 2 * DFF, 2 * DFF, 0, D, 2 * DFF, W_in_t + (size_t)s * 5632 * 1024, 1, DFF, norm_g + ((size_t)l * 4 + 3 * s) * D);
                conv_matrix(F, ffn_w_out + ((size_t)l * 2 + s) * DFF * D, D, 0, DFF, D, W_out_t + (size_t)s * 1024 * 2816, 0, 0, nullptr);
            }
            const float* mw = mix_w_in + (size_t)l * D * INW;
            conv_matrix(F, mw, INW, 0, D, 1792, W_A_t, 0, 0, norm_g + ((size_t)l * 4 + 1) * D);
            conv_matrix(F, mw, INW, 1792, D, 3072, W_B_t, 0, 0, norm_g + ((size_t)l * 4 + 1) * D);
            conv_matrix(F, mw, INW, 4864, D, 2048, W_G_t, 1, 1024, norm_g + ((size_t)l * 4 + 1) * D);
            conv_matrix(F, w_branch_a + (size_t)l * AW * D, D, 0, AW, D, P_A_t, 0, 0, nullptr);
            conv_matrix(F, w_branch_b + (size_t)l * D * D, D, 0, D, D, P_B_t, 0, 0, nullptr);
            conv_matrix(F, mix_w_out + (size_t)l * D * D, D, 0, D, D, W_MO_t, 0, 0, nullptr);
            conv_matrix(F, cross_w_q + (size_t)l * D * D, D, 0, D, D, W_Q_t, 0, 0, norm_g + ((size_t)l * 4 + 2) * D);
            conv_matrix(F, cross_w_kv + (size_t)l * D * 2 * D, 2 * D, 0, D, D, W_K_t, 0, 0, nullptr);
            conv_matrix(F, cross_w_kv + (size_t)l * D * 2 * D, 2 * D, D, D, D, W_V_t, 0, 0, nullptr);
            conv_matrix(F, cross_w_o + (size_t)l * D * D, D, 0, D, D, W_O_t, 0, 0, nullptr);
            for (int i = blockIdx.x * (NWAVES * 64) + fresh_tid(); i < 1536 * 128; i += F.G * NWAVES * 64) {
                const int n = i >> 7, k = i & 127; float v = 0.f;
                if (n < 512) { if (k < 64) v = a_w_up[((size_t)l * 64 + k) * 512 + n]; }
                else if (n < 1024) { if (k >= 64) v = a_a_up[((size_t)l * 64 + (k - 64)) * 512 + (n - 512)]; }
                else v = a_g_up[((size_t)l * 128 + k) * 512 + (n - 1024)];
                W_LR_t[pg8::blk32(n, k, 128)] = f2b(v);
            }
            rms_phase(F, mem_in, mem_norm + (size_t)l * D, MEMN, MM);
        }
        GRID_BAR();
        {
            { KBASE(); pg8::Gemm g{H16, W_in_t, M, 2 * DFF, D}; pg8::StaticOrder S; S.init(M, 2 * DFF, F.G, (int)blockIdx.x); pg8::EpiSwiglu E{ACT, DFF, RSQ};
              for (int rep = 0; rep < REPG(0); ++rep) pg8::gemm_phase<true, true>(F.lds, g, S, E); }
            { KBASE(); pg8::Gemm g{MEMN, W_K_t, MM, D, D}; pg8::StaticOrder S; S.init(MM, D, F.G, (int)blockIdx.x); pg8::EpiStoreH<false> E{KM, D, 0, 0, nullptr};
              for (int rep = 0; rep < REPG(1); ++rep) pg8::gemm_phase<true, true>(F.lds, g, S, E); }
            { KBASE(); pg8::Gemm g{W_V_t, MEMN, D, MM, D}; pg8::StaticOrder S; S.init(D, MM, F.G, (int)((blockIdx.x + 128) % F.G)); pg8::EpiStoreH<false> E{VTM, MM, 0, 0, nullptr};
              for (int rep = 0; rep < REPG(2); ++rep) pg8::gemm_phase<true, true>(F.lds, g, S, E); }
        }
        GRID_BAR();
        { KBASE(); pg8::Gemm g{ACT, W_out_t, M, D, DFF}; pg8::StaticOrder S; S.init(M, D, F.G, (int)blockIdx.x); pg8::EpiResid E{(unsigned char*)KARG(28), 0.5f};
          pg8::gemm_phase<true, true>(F.lds, g, S, E); }
        GRID_BAR();
        { KBASE(); pg8::Gemm g{H16, W_A_t, M, 1792, D}; pg8::StaticOrder S; S.init(M, 1792, F.G, (int)blockIdx.x); pg8::EpiStoreH<true> E{ZA, 256, 256, (size_t)M * 256, RSQ};
          for (int rep = 0; rep < REPG(3); ++rep) pg8::gemm_phase<true, true>(F.lds, g, S, E); }
        GRID_BAR();
        {
            PHASE_IDS();
            const u16* T6 = ZA + (size_t)6 * M * 256; const float* mu = shift_mu + (size_t)l * 1792 + 1536;
            for (int m = gw; m < M; m += NGW) {
                const int c0 = 4 * lane; const bool first = (m % T) == 0;
                const u32x2 zc = *(const u32x2*)(T6 + pg8::blk32(m, c0, 256));
                u32x2 zp = {0u, 0u}; if (!first) zp = *(const u32x2*)(T6 + pg8::blk32(m - 1, c0, 256));
                const f32x4 mm = *(const f32x4*)(mu + c0);
                float v[4] = {hlo(zc.x), hhi(zc.x), hlo(zc.y), hhi(zc.y)}; const float p[4] = {hlo(zp.x), hhi(zp.x), hlo(zp.y), hhi(zp.y)};
#pragma unroll
                for (int j = 0; j < 4; ++j) { float s = v[j] + (p[j] - v[j]) * mm[j];
                    if (c0 < 64) { const float e = __builtin_amdgcn_exp2f(2.88539008178f * s); s = 1.0f - 2.0f * __builtin_amdgcn_rcpf(1.0f + e); }
                    else if (c0 >= 128) s = fsigmoid(s);
                    v[j] = s; }
                u32x2 o; o.x = pk2b(v[0], v[1]); o.y = pk2b(v[2], v[3]);
                *(u32x2*)(ALR + pg8::blk32(m, c0, 256)) = o;
            }
        }
        GRID_BAR();
        { KBASE(); pg8::Gemm g{ALR, W_LR_t, M, 1536, 128, 256, 4, 8192u}; pg8::StaticOrder S; S.init(M, 1536, F.G, (int)blockIdx.x); pg8::EpiStoreH<false> E{WAG, 1536, 0, 0, nullptr};
          for (int rep = 0; rep < REPG(4); ++rep) pg8::gemm_phase<true, true>(F.lds, g, S, E); }
        GRID_BAR();
        {
            for (int rep = 0; rep < REP_PA; ++rep) {
                PHASE_IDS();
                const int fr_o = lane & 15, fq_o = lane >> 4;
                LAS u16* Bh = (LAS u16*)F.lds;  LAS u16* Kh = Bh + 32 * 72; LAS u16* Kt = Kh + 32 * 72; LAS u16* Rt = Kt + 32 * 72;
                LAS u16* Ktx = Rt + 32 * 72;    LAS u16* Rx = Ktx + 32 * 72;
                LAS u16* Bg = Rx + 32 * 72;     LAS u16* Vr = Bg + 32 * 72; LAS u16* Kg = Vr + 32 * 72;
                LAS u16* AbrT = Kg + 32 * 72;   LAS u16* AkkT = AbrT + 32 * 40; LAS u16* AkrT = AkkT + 32 * 40;
                LAS float* ATt = (LAS float*)(F.lds + 49152);
                LAS float* Uf = (LAS float*)(F.lds + 53760);
                LAS u16* Zh = (LAS u16*)(F.lds + 62976);
                LAS float* YL = (LAS float*)(F.lds + 68096);
                LAS u16* Sh = (LAS u16*)(F.lds + 76800);
                LAS float* Lgrp = (LAS float*)(F.lds + 86016);
                LAS float* PRE = (LAS float*)(F.lds + 88064);
                LAS float* CMl = (LAS float*)(F.lds + 92160);
                LAS float* CMIl = CMl + 128; LAS float* CEl = CMIl + 128;
                for (int bh = blockIdx.x; bh < NBATCH * 8; bh += F.G) {
                    const int b = bh >> 3, h = bh & 7, row4 = lane >> 4, tt = 4 * wave + row4, j0 = 4 * (lane & 15), col0 = 64 * h + j0;
                    const u16* zrp = ZA + (size_t)(col0 >> 8) * M * 256; const u16* zkp = zrp + (size_t)2 * M * 256; const u16* zvp = zrp + (size_t)4 * M * 256;
                    u32x2 nzr[2], nzk[2], nzv[2], nwd, nad, ngd;
#define PA_LOAD(cc_) do { const int t1_ = CH * (cc_) + tt; int m1_ = b * T + t1_; asm volatile("" : "+v"(m1_)); \
        const size_t zb_ = pg8::blk32(m1_, col0 & 255, 256), zp_ = (m1_ & 31) ? zb_ - 32 : zb_ - 8 * 1024 + 31 * 32;     \
        const bool ok_ = t1_ > 0; const u32x2 z0_ = {0u, 0u}; \
        nzr[0] = ok_ ? *(const u32x2*)(zrp + zp_) : z0_; nzk[0] = ok_ ? *(const u32x2*)(zkp + zp_) : z0_; nzv[0] = ok_ ? *(const u32x2*)(zvp + zp_) : z0_; \
        nzr[1] = *(const u32x2*)(zrp + zb_); nzk[1] = *(const u32x2*)(zkp + zb_); nzv[1] = *(const u32x2*)(zvp + zb_); \
        const size_t wb_ = pg8::blk32(m1_, col0, 1536); \
        nwd = *(const u32x2*)(WAG + wb_); nad = *(const u32x2*)(WAG + wb_ + (size_t)16 * 1024); ngd = *(const u32x2*)(WAG + wb_ + (size_t)32 * 1024); } while (0)
                    float lw[4], bb[4], kp[4], rr[4], vv[4], kq[4], c[4]; f32x4 cvn, ggn, cvc = {0.f, 0.f, 0.f, 0.f}, ggc = {0.f, 0.f, 0.f, 0.f};
                    const float* mu = shift_mu + (size_t)l * 1792;
                    const f32x4 mur = *(const f32x4*)(mu + col0), muk = *(const f32x4*)(mu + 512 + col0), muv = *(const f32x4*)(mu + 1024 + col0);
                    const f32x4 w0c = *(const f32x4*)(a_w0 + (size_t)l * 512 + col0), a0c = *(const f32x4*)(a_a0 + (size_t)l * 512 + col0);
                    const f32x4 kkc = *(const f32x4*)(a_k_k + (size_t)l * 512 + col0), kac = *(const f32x4*)(a_k_a + (size_t)l * 512 + col0), rkc = *(const f32x4*)(a_r_k + (size_t)l * 512 + col0);
                    const f32x4 ln0 = *(const f32x4*)(a_ln + ((size_t)l * 2 + 0) * 512 + col0), ln1 = *(const f32x4*)(a_ln + ((size_t)l * 2 + 1) * 512 + col0);
#define PA_UNPK(dst_, w_) do { dst_[0] = hlo((w_).x); dst_[1] = hhi((w_).x); dst_[2] = hlo((w_).y); dst_[3] = hhi((w_).y); } while (0)
#define PA_FIRST() do { \
        float zr0[4], zr1[4], zk0[4], zk1[4], zv0[4], zv1[4], wd_[4], ad_[4], gd_[4], kx_[4], a_[4], kk_[4]; \
        PA_UNPK(zr0, nzr[0]); PA_UNPK(zr1, nzr[1]); PA_UNPK(zk0, nzk[0]); PA_UNPK(zk1, nzk[1]); PA_UNPK(zv0, nzv[0]); PA_UNPK(zv1, nzv[1]); PA_UNPK(wd_, nwd); PA_UNPK(ad_, nad); PA_UNPK(gd_, ngd); \
        float ss_ = 0.f; \
        _Pragma("unroll") for (int i = 0; i < 4; ++i) { \
            rr[i] = zr1[i] + (zr0[i] - zr1[i]) * mur[i]; kx_[i] = zk1[i] + (zk0[i] - zk1[i]) * muk[i]; vv[i] = zv1[i] + (zv0[i] - zv1[i]) * muv[i]; \
            a_[i] = fsigmoid(a0c[i] + ad_[i]); \
            lw[i] = -0.60653065971f * 1.44269504089f * fsigmoid(w0c[i] + wd_[i]);            \
            kk_[i] = kx_[i] * kkc[i]; ss_ = fmaf(kk_[i], kk_[i], ss_); } \
        const float inv_ = __builtin_amdgcn_rsqf(fmaxf(sum16(ss_), 1e-24f)); float cs_ = 0.f; \
        _Pragma("unroll") for (int i = 0; i < 4; ++i) { kq[i] = kk_[i] * inv_; bb[i] = kq[i] * a_[i]; kp[i] = kx_[i] * (1.0f + (a_[i] - 1.0f) * kac[i]); cs_ = fmaf(rr[i] * kp[i], rkc[i], cs_); } \
        cs_ = sum16(cs_); f32x4 tot_; \
        _Pragma("unroll") for (int i = 0; i < 4; ++i) { cvn[i] = cs_ * vv[i]; ggn[i] = gd_[i];       \
            const float s_ = xsum16(lw[i]), t_ = xsum32(s_), p_ = (row4 & 1) ? s_ : lw[i];            \
            c[i] = (row4 >= 2) ? p_ + (t_ - s_) : p_; tot_[i] = t_; } \
        if (lane < 16) *(LAS f32x4*)(Lgrp + wave * 64 + j0) = tot_; } while (0)
#define PA_HELPER(par_) do { float pre_ = 0.f, Lmid_ = 0.f, Lend_ = 0.f; \
        _Pragma("unroll") for (int g2 = 0; g2 < 8; ++g2) { const float x = Lgrp[g2 * 64 + lane]; if (g2 < wave) pre_ += x; if (g2 < 4) Lmid_ += x; Lend_ += x; } \
        PRE[(par_) * 512 + wave * 64 + lane] = pre_; \
        if (wave == 0) { CMl[(par_) * 64 + lane] = __builtin_amdgcn_exp2f(-Lmid_); CMIl[(par_) * 64 + lane] = __builtin_amdgcn_exp2f(Lmid_); CEl[(par_) * 64 + lane] = __builtin_amdgcn_exp2f(Lend_); } } while (0)
                    PA_LOAD(0);
                    for (int e = tid; e < 64 * 72; e += NWAVES * 64) Sh[e] = 0;
                    f32x4 Sreg[2] = {{0.f, 0.f, 0.f, 0.f}, {0.f, 0.f, 0.f, 0.f}};
                    PA_FIRST();
                    LDS_BARRIER();
                    PA_HELPER(0);
                    LDS_BARRIER();
                    for (int cc = 0; cc < NCH; ++cc) {
                        int fr = fr_o, fq = fq_o; asm volatile("" : "+v"(fr), "+v"(fq));
                        const int ib = wave >> 1, hb = wave & 1, par = cc & 1;
                        {
                            cvc = cvn; ggc = ggn;
                            if (cc + 1 < NCH) PA_LOAD(cc + 1);
                            const f32x4 pre4 = *(const LAS f32x4*)(PRE + par * 512 + wave * 64 + j0), cM4 = *(const LAS f32x4*)(CMl + par * 64 + j0), cMi4 = *(const LAS f32x4*)(CMIl + par * 64 + j0), cE4 = *(const LAS f32x4*)(CEl + par * 64 + j0);
                            float x1[4], x2[4], x3[4], x4[4], x5[4], x6[4], xg[4], xk[4];
#pragma unroll
                            for (int i = 0; i < 4; ++i) { const float L = pre4[i] + c[i];
                                const float e5 = __builtin_amdgcn_exp2f(L), e4 = __builtin_amdgcn_exp2f(L - lw[i]), r5 = __builtin_amdgcn_rcpf(e5);
                                const float e3 = e5 * cM4[i], e2 = e4 * cM4[i], e1 = fminf(cMi4[i] * r5, 8192.f), e6 = cE4[i] * r5;
                                x1[i] = bb[i] * e1; x2[i] = kp[i] * e1; x3[i] = kq[i] * e2; x4[i] = rr[i] * e3; x5[i] = kq[i] * e4; x6[i] = rr[i] * e5; xg[i] = bb[i] * e6; xk[i] = kp[i] * e6; }
                            const int io = tt * 72 + j0; u32x2 w;
                            w.x = pk2(x1[0], x1[1]); w.y = pk2(x1[2], x1[3]); *(LAS u32x2*)(Bh + io) = w;
                            w.x = pk2(x2[0], x2[1]); w.y = pk2(x2[2], x2[3]); *(LAS u32x2*)(Kh + io) = w;
                            w.x = pk2(x3[0], x3[1]); w.y = pk2(x3[2], x3[3]); *(LAS u32x2*)(Kt + io) = w;
                            w.x = pk2(x4[0], x4[1]); w.y = pk2(x4[2], x4[3]); *(LAS u32x2*)(Rt + io) = w;
                            w.x = pk2(x5[0], x5[1]); w.y = pk2(x5[2], x5[3]); *(LAS u32x2*)(Ktx + io) = w;
                            w.x = pk2(x6[0], x6[1]); w.y = pk2(x6[2], x6[3]); *(LAS u32x2*)(Rx + io) = w;
                            w.x = pk2(xg[0], xg[1]); w.y = pk2(xg[2], xg[3]); *(LAS u32x2*)(Bg + io) = w;
                            w.x = pk2(vv[0], vv[1]); w.y = pk2(vv[2], vv[3]); *(LAS u32x2*)(Vr + io) = w;
                            w.x = pk2(xk[0], xk[1]); w.y = pk2(xk[2], xk[3]); *(LAS u32x2*)(Kg + io) = w;
                        }
                        LDS_BARRIER();
                        f32x4 accU = {0.f, 0.f, 0.f, 0.f}, accY = {0.f, 0.f, 0.f, 0.f}, accS[2] = {{0.f, 0.f, 0.f, 0.f}, {0.f, 0.f, 0.f, 0.f}};
                        h16x8 aV;
                        {
                            const int mt = wave >> 2, sb = (wave >> 1) & 1, tb = wave & 1;
                            const LAS u16* X = mt ? Kh : Bh;
                            const h16x8 a0 = *(const LAS h16x8*)(X + (16 * sb + fr) * 72 + 8 * fq), a1 = *(const LAS h16x8*)(X + (16 * sb + fr) * 72 + 32 + 8 * fq);
                            const h16x8 k0 = *(const LAS h16x8*)(Kt + (16 * tb + fr) * 72 + 8 * fq), k1 = *(const LAS h16x8*)(Kt + (16 * tb + fr) * 72 + 32 + 8 * fq);
                            const h16x8 r0 = *(const LAS h16x8*)(Rt + (16 * tb + fr) * 72 + 8 * fq), r1 = *(const LAS h16x8*)(Rt + (16 * tb + fr) * 72 + 32 + 8 * fq);
                            const h16x8 s0 = *(const LAS h16x8*)(Sh + (16 * ib + fr) * 72 + 8 * fq), s1 = *(const LAS h16x8*)(Sh + (16 * ib + fr) * 72 + 32 + 8 * fq);
                            const h16x8 x0 = *(const LAS h16x8*)(Ktx + (16 * hb + fr) * 72 + 8 * fq), x1 = *(const LAS h16x8*)(Ktx + (16 * hb + fr) * 72 + 32 + 8 * fq);
                            const h16x8 y0 = *(const LAS h16x8*)(Rx + (16 * hb + fr) * 72 + 8 * fq), y1 = *(const LAS h16x8*)(Rx + (16 * hb + fr) * 72 + 32 + 8 * fq);
                            aV = lds_tr16(Vr, 72, 0, 16 * ib, lane);
                            const h16x8 g0 = lds_tr16(Kg, 72, 0, 16 * (2 * hb), lane), g1 = lds_tr16(Kg, 72, 0, 16 * (2 * hb + 1), lane);
                            f32x4 aK = {0.f, 0.f, 0.f, 0.f}, aR = {0.f, 0.f, 0.f, 0.f};
                            aK = MFMA16(a0, k0, aK); aK = MFMA16(a1, k1, aK); aR = MFMA16(a0, r0, aR); aR = MFMA16(a1, r1, aR);
                            accU = MFMA16(s0, x0, accU); accU = MFMA16(s1, x1, accU); accY = MFMA16(s0, y0, accY); accY = MFMA16(s1, y1, accY);
                            accS[0] = MFMA16(aV, g0, accS[0]); accS[1] = MFMA16(aV, g1, accS[1]);
                            const int t = 16 * tb + fr, s0i = 16 * sb + 4 * fq;
#pragma unroll
                            for (int rg = 0; rg < 4; ++rg) { if (s0i + rg >= t) aK[rg] = 0.f; if (s0i + rg > t) aR[rg] = 0.f; }
                            u32x2 wK, wR; wK.x = pk2(aK[0], aK[1]); wK.y = pk2(aK[2], aK[3]); wR.x = pk2(aR[0], aR[1]); wR.y = pk2(aR[2], aR[3]);
                            if (mt == 0) {
#pragma unroll
                                for (int rg = 0; rg < 4; ++rg) ATt[(s0i + rg) * 36 + t] = aK[rg];
                                *(LAS u32x2*)(AbrT + t * 40 + s0i) = wR; }
                            else { *(LAS u32x2*)(AkkT + t * 40 + s0i) = wK; *(LAS u32x2*)(AkrT + t * 40 + s0i) = wR; }
                        }
                        LDS_BARRIER();
                        {
                            const h16x8 bK = *(const LAS h16x8*)(AkkT + (16 * hb + fr) * 40 + 8 * fq), bR = *(const LAS h16x8*)(AkrT + (16 * hb + fr) * 40 + 8 * fq);
                            accU = MFMA16(aV, bK, accU); accY = MFMA16(aV, bR, accY);
#pragma unroll
                            for (int rg = 0; rg < 4; ++rg) Uf[(16 * ib + 4 * fq + rg) * 36 + 16 * hb + fr] = accU[rg];
                        }
                        LDS_BARRIER();
                        if (wave == 0) {
                            float z[32];
#pragma unroll
                            for (int q = 0; q < 8; ++q) { const f32x4 v = *(const LAS f32x4*)(Uf + lane * 36 + 4 * q); z[4 * q] = v[0]; z[4 * q + 1] = v[1]; z[4 * q + 2] = v[2]; z[4 * q + 3] = v[3]; }
#pragma unroll
                            for (int sx = 0; sx < 31; ++sx) {
#pragma unroll
                                for (int q = (sx + 1) / 4; q < 8; ++q) { const f32x4 a4 = *(const LAS f32x4*)(ATt + sx * 36 + 4 * q);
#pragma unroll
                                    for (int i = 0; i < 4; ++i) if (4 * q + i > sx) z[4 * q + i] = fmaf(-z[sx], a4[i], z[4 * q + i]); }
                            }
#pragma unroll
                            for (int q = 0; q < 4; ++q) { u32x4 w; w.x = pk2(-z[8 * q], -z[8 * q + 1]); w.y = pk2(-z[8 * q + 2], -z[8 * q + 3]); w.z = pk2(-z[8 * q + 4], -z[8 * q + 5]); w.w = pk2(-z[8 * q + 6], -z[8 * q + 7]);
                                *(LAS u32x4*)(Zh + lane * 40 + 8 * q) = w; }
                        }
                        if (cc + 1 < NCH) PA_FIRST();
                        LDS_BARRIER();
                        {
                            const h16x8 aZ = *(const LAS h16x8*)(Zh + (16 * ib + fr) * 40 + 8 * fq);
                            const h16x8 bA = *(const LAS h16x8*)(AbrT + (16 * hb + fr) * 40 + 8 * fq);
                            const h16x8 b0 = lds_tr16(Bg, 72, 0, 16 * (2 * hb), lane), b1 = lds_tr16(Bg, 72, 0, 16 * (2 * hb + 1), lane);
                            const float gc0 = CEl[par * 64 + 16 * (2 * hb) + fr], gc1 = CEl[par * 64 + 16 * (2 * hb + 1) + fr];
                            if (cc + 1 < NCH) PA_HELPER(par ^ 1);
                            accY = MFMA16(aZ, bA, accY); accS[0] = MFMA16(aZ, b0, accS[0]); accS[1] = MFMA16(aZ, b1, accS[1]);
                            const int i0 = 16 * ib + 4 * fq;
                            *(LAS f32x4*)(YL + (16 * hb + fr) * 68 + i0) = accY;
                            Sreg[0] = Sreg[0] * gc0 + accS[0]; Sreg[1] = Sreg[1] * gc1 + accS[1];
#pragma unroll
                            for (int rg = 0; rg < 4; ++rg) { Sh[(i0 + rg) * 72 + 16 * (2 * hb) + fr] = f2h(Sreg[0][rg]); Sh[(i0 + rg) * 72 + 16 * (2 * hb + 1) + fr] = f2h(Sreg[1][rg]); }
                        }
                        LDS_BARRIER();
                        {
                            const int t = tt, i4 = j0, colo = col0;
                            const f32x4 y4 = *(const LAS f32x4*)(YL + t * 68 + i4), cv4 = cvc, g4 = ggc;
                            const float mean = sum16((y4[0] + y4[1]) + (y4[2] + y4[3])) * (1.f / 64.f); const f32x4 d4 = y4 - mean;
                            const float rstd = __builtin_amdgcn_rsqf(sum16((d4[0] * d4[0] + d4[1] * d4[1]) + (d4[2] * d4[2] + d4[3] * d4[3])) * (1.f / 64.f) + 64e-5f);
                            const f32x4 o4 = (d4 * rstd * ln0 + ln1 + cv4) * g4;
                            u32x2 w; w.x = pk2b(o4[0], o4[1]); w.y = pk2b(o4[2], o4[3]);
                            *(u32x2*)(YA + pg8::blk32(b * T + CH * cc + t, colo, 512)) = w;
                        }
                    }
                    LDS_BARRIER();
#undef PA_LOAD
#undef PA_FIRST
#undef PA_UNPK
#undef PA_HELPER
                }
            }
            GRID_BAR();
        }
        { KBASE(); pg8::Gemm g{H16, W_B_t, M, 3072, D}; pg8::StaticOrder S; S.init(M, 3072, F.G, (int)blockIdx.x); pg8::EpiStoreH<true> E{ZB, 3072, 0, 0, RSQ};
          for (int rep = 0; rep < REPG(5); ++rep) pg8::gemm_phase<true, true>(F.lds, g, S, E); }
        GRID_BAR();
        for (int rep = 0; rep < REP_RET; ++rep) {
            PHASE_IDS();
            LAS u16* Qd = (LAS u16*)(F.lds + 0);
            LAS u16* Kd = (LAS u16*)(F.lds + 18432);
            LAS u16* RTL = (LAS u16*)(F.lds + 36864);
            LAS u16* Vr = (LAS u16*)(F.lds + 72704);
            LAS u16* PL = (LAS u16*)(F.lds + 107520);
            const int fr = lane & 15, fq = lane >> 4;
            for (int bh = blockIdx.x; bh < NBATCH * 8; bh += F.G) {
                const int b = bh >> 3, h = bh & 7;
                const float lg = __builtin_log2f(1.0f - __builtin_amdgcn_exp2f(-5.0f - (float)h));
                const float gC = __builtin_amdgcn_exp2f(128.0f * lg);
                f32x4 rt[4];
#pragma unroll
                for (int i = 0; i < 4; ++i) rt[i] = (f32x4){0.f, 0.f, 0.f, 0.f};
                u32x4 nq1, nq2, nk1, nk2, nv8[4]; f32x4 nc0, nc1, ns0, ns1;
#define RET_LOAD(n_) do { const int s_ = 16 * wave + (lane >> 2), ci_ = lane & 3;     const size_t tok_ = (size_t)b * T + 128 * (n_) + s_; const u16* zp_ = ZB + pg8::blk32((int)tok_, 64 * h + 8 * ci_, 3072); \
        nq1 = *(const u32x4*)(zp_); nq2 = *(const u32x4*)(zp_ + 1024); nk1 = *(const u32x4*)(zp_ + 16 * 1024); nk2 = *(const u32x4*)(zp_ + 17 * 1024); \
        const float* cp_ = COS + tok_ * 32 + 8 * ci_; const float* sp_ = SIN + tok_ * 32 + 8 * ci_; nc0 = *(const f32x4*)cp_; nc1 = *(const f32x4*)(cp_ + 4); ns0 = *(const f32x4*)sp_; ns1 = *(const f32x4*)(sp_ + 4); \
        const u16* vp_ = ZB + pg8::blk32((int)tok_, 1024 + 128 * h + 8 * ci_, 3072); _Pragma("unroll") for (int i = 0; i < 4; ++i) nv8[i] = *(const u32x4*)(vp_ + i * 1024); } while (0)
                RET_LOAD(0);
                for (int n = 0; n < T / 128; ++n) {
                    const int m0 = b * T + 128 * n;
                    {
                        const int s = 16 * wave + (lane >> 2), ci = lane & 3;
                        const u32x4 q1 = nq1, q2 = nq2, k1 = nk1, k2 = nk2; const f32x4 c0 = nc0, c1 = nc1, s0 = ns0, s1 = ns1;
                        u32x4 cv8[4];
#pragma unroll
                        for (int i = 0; i < 4; ++i) cv8[i] = nv8[i];
                        if (n + 1 < T / 128) RET_LOAD(n + 1);
                        const float fqs = __builtin_amdgcn_exp2f((float)(s + 1) * lg), fks = 0.125f * __builtin_amdgcn_exp2f(-(float)(s + 1) * lg);
                        float qa[8], qb[8], ka[8], kbv[8];
#pragma unroll
                        for (int j = 0; j < 8; ++j) { const float cs = (j < 4) ? c0[j & 3] : c1[j & 3], sn = (j < 4) ? s0[j & 3] : s1[j & 3];
                            const float x1 = (j & 1) ? hhi(q1[j >> 1]) : hlo(q1[j >> 1]), x2 = (j & 1) ? hhi(q2[j >> 1]) : hlo(q2[j >> 1]);
                            const float y1 = (j & 1) ? hhi(k1[j >> 1]) : hlo(k1[j >> 1]), y2 = (j & 1) ? hhi(k2[j >> 1]) : hlo(k2[j >> 1]);
                            qa[j] = (x1 * cs - x2 * sn) * fqs; qb[j] = (x1 * sn + x2 * cs) * fqs; ka[j] = (y1 * cs - y2 * sn) * fks; kbv[j] = (y1 * sn + y2 * cs) * fks; }
                        u32x4 w;
                        w.x = pk2(qa[0], qa[1]); w.y = pk2(qa[2], qa[3]); w.z = pk2(qa[4], qa[5]); w.w = pk2(qa[6], qa[7]); *(LAS u32x4*)(Qd + s * 72 + 8 * ci) = w;
                        w.x = pk2(qb[0], qb[1]); w.y = pk2(qb[2], qb[3]); w.z = pk2(qb[4], qb[5]); w.w = pk2(qb[6], qb[7]); *(LAS u32x4*)(Qd + s * 72 + 32 + 8 * ci) = w;
                        w.x = pk2(ka[0], ka[1]); w.y = pk2(ka[2], ka[3]); w.z = pk2(ka[4], ka[5]); w.w = pk2(ka[6], ka[7]); *(LAS u32x4*)(Kd + s * 72 + 8 * ci) = w;
                        w.x = pk2(kbv[0], kbv[1]); w.y = pk2(kbv[2], kbv[3]); w.z = pk2(kbv[4], kbv[5]); w.w = pk2(kbv[6], kbv[7]); *(LAS u32x4*)(Kd + s * 72 + 32 + 8 * ci) = w;
#pragma unroll
                        for (int i = 0; i < 4; ++i) *(LAS u32x4*)(Vr + s * 136 + 8 * (ci + 4 * i)) = cv8[i];
#pragma unroll
                        for (int db = 0; db < 4; ++db)
#pragma unroll
                            for (int r = 0; r < 4; ++r) RTL[(16 * wave + 4 * fq + r) * 72 + 16 * db + fr] = f2h(rt[db][r]);
                    }
                    LDS_BARRIER();
                    {
                        const h16x8 bq0 = *(const LAS h16x8*)(Qd + (16 * wave + fr) * 72 + 8 * fq), bq1 = *(const LAS h16x8*)(Qd + (16 * wave + fr) * 72 + 32 + 8 * fq);
#pragma unroll
                        for (int sb = 0; sb < 8; ++sb) {
                            u32x2 pw = {0u, 0u};
                            if (sb <= wave) {
                                f32x4 acc = {0.f, 0.f, 0.f, 0.f};
                                const h16x8 a0 = *(const LAS h16x8*)(Kd + (16 * sb + fr) * 72 + 8 * fq), a1 = *(const LAS h16x8*)(Kd + (16 * sb + fr) * 72 + 32 + 8 * fq);
                                acc = MFMA16(a0, bq0, acc); acc = MFMA16(a1, bq1, acc);
                                const int cc = 16 * wave + fr, s0i = 16 * sb + 4 * fq;
#pragma unroll
                                for (int r = 0; r < 4; ++r) if (s0i + r > cc) acc[r] = 0.f;
                                pw.x = pk2(acc[0], acc[1]); pw.y = pk2(acc[2], acc[3]);
                            }
                            *(LAS u32x2*)(PL + (16 * wave + fr) * 136 + 16 * sb + 4 * fq) = pw;
                        }
                    }
                    asm volatile("" ::: "memory");
                    {
                        h16x8 pf[4], qf[2];
#pragma unroll
                        for (int ks = 0; ks < 4; ++ks) pf[ks] = *(const LAS h16x8*)(PL + (16 * wave + fr) * 136 + 32 * ks + 8 * fq);
#pragma unroll
                        for (int ks = 0; ks < 2; ++ks) qf[ks] = *(const LAS h16x8*)(Qd + (16 * wave + fr) * 72 + 32 * ks + 8 * fq);
                        f32x4 oacc[8];
#pragma unroll
                        for (int eb = 0; eb < 8; ++eb) { f32x4 acc = {0.f, 0.f, 0.f, 0.f};
#pragma unroll
                            for (int ks = 0; ks < 4; ++ks) { const h16x8 a = lds_tr16(Vr, 136, 32 * ks, 16 * eb, lane); acc = MFMA16(a, pf[ks], acc); }
#pragma unroll
                            for (int ks = 0; ks < 2; ++ks) { const h16x8 a = *(const LAS h16x8*)(RTL + (16 * eb + fr) * 72 + 32 * ks + 8 * fq); acc = MFMA16(a, qf[ks], acc); }
                            oacc[eb] = acc; }
                        float sm = 0.f;
#pragma unroll
                        for (int eb = 0; eb < 8; ++eb) sm += (oacc[eb][0] + oacc[eb][1]) + (oacc[eb][2] + oacc[eb][3]);
                        sm = xsum16(sm); sm = xsum32(sm);
                        const float mean = sm * (1.f / 128.f); float vs = 0.f;
#pragma unroll
                        for (int eb = 0; eb < 8; ++eb)
#pragma unroll
                            for (int r = 0; r < 4; ++r) { const float dd = oacc[eb][r] - mean; vs += dd * dd; }
                        vs = xsum16(vs); vs = xsum32(vs);
                        const float inv = __builtin_amdgcn_rsqf(vs * (1.f / 128.f) + 1e-5f);
                        const int m = m0 + 16 * wave + fr, eo = 16 * (fq & 1) + 8 * (fq >> 1);
                        const u16* gp = ZB + pg8::blk32(m, 2048 + 128 * h + eo, 3072); u16* yp = YB + pg8::blk32(m, 128 * h + eo, 1024);
#pragma unroll
                        for (int p = 0; p < 4; ++p) {
                            f32x4 xa = oacc[2 * p], xb = oacc[2 * p + 1];
#pragma unroll
                            for (int r = 0; r < 4; ++r) { float pa_ = xa[r], pb_ = xb[r]; pair16(pa_, pb_); xa[r] = pa_; xb[r] = pb_; }
                            const int e0 = 16 * (2 * p + (fq & 1)) + 8 * (fq >> 1);
                            const u32x4 g4 = *(const u32x4*)(gp + p * 1024);
                            const f32x4 gn0 = *(const f32x4*)(b_gn + (size_t)l * 1024 + 128 * h + e0), gn1 = *(const f32x4*)(b_gn + (size_t)l * 1024 + 128 * h + e0 + 4);
                            float o[8];
#pragma unroll
                            for (int r = 0; r < 4; ++r) { const float ga = (r & 1) ? hhi(g4[r >> 1]) : hlo(g4[r >> 1]), gb = (r & 1) ? hhi(g4[2 + (r >> 1)]) : hlo(g4[2 + (r >> 1)]);
                                o[r] = (xa[r] - mean) * inv * gn0[r] * fsilu(ga); o[4 + r] = (xb[r] - mean) * inv * gn1[r] * fsilu(gb); }
                            u32x4 w; w.x = pk2b(o[0], o[1]); w.y = pk2b(o[2], o[3]); w.z = pk2b(o[4], o[5]); w.w = pk2b(o[6], o[7]);
                            *(u32x4*)(yp + p * 1024) = w; }
                    }
                    {
#pragma unroll
                        for (int ks = 0; ks < 4; ++ks) { const h16x8 a = lds_tr16(Vr, 136, 32 * ks, 16 * wave, lane);
#pragma unroll
                            for (int db = 0; db < 4; ++db) { const h16x8 bb = lds_tr16(Kd, 72, 32 * ks, 16 * db, lane); rt[db] = MFMA16(a, bb, rt[db]); } }
#pragma unroll
                        for (int db = 0; db < 4; ++db) rt[db] = rt[db] * gC;
                    }
                    LDS_BARRIER();
                }
            }
        }
        #undef RET_LOAD
        GRID_BAR();
        {
            { KBASE(); pg8::Gemm g{YA, P_A_t, M, D, AW}; pg8::StaticOrder S; S.init(M, D, F.G, (int)blockIdx.x); pg8::EpiStoreH<false> E{TMPA, D, 0, 0, nullptr}; for (int rep = 0; rep < REPG(6); ++rep) pg8::gemm_phase<true, true>(F.lds, g, S, E); }
            { KBASE(); pg8::Gemm g{YB, P_B_t, M, D, D}; pg8::StaticOrder S; S.init(M, D, F.G, (int)blockIdx.x); pg8::EpiStoreH<false> E{TMPB, D, 0, 0, nullptr}; for (int rep = 0; rep < REPG(7); ++rep) pg8::gemm_phase<true, true>(F.lds, g, S, E); }
        }
        GRID_BAR();
        { KBASE(); pg8::Gemm g{H16, W_G_t, M, 2048, D}; pg8::StaticOrder S; S.init(M, 2048, F.G, (int)blockIdx.x);
          pg8::EpiGate E{mix_gate_b + (size_t)l * 2048, mix_gate_b + (size_t)l * 2048 + 1024, TMPA, TMPB, MRG, D, RSQ};
          for (int rep = 0; rep < REPG(8); ++rep) pg8::gemm_phase<true, true>(F.lds, g, S, E); }
        GRID_BAR();
        { KBASE(); pg8::Gemm g{MRG, W_MO_t, M, D, D}; pg8::StaticOrder S; S.init(M, D, F.G, (int)blockIdx.x); pg8::EpiResid E{(unsigned char*)KARG(28), 1.0f}; pg8::gemm_phase<true, true>(F.lds, g, S, E); }
        GRID_BAR();
        { KBASE(); pg8::Gemm g{H16, W_Q_t, M, D, D}; pg8::StaticOrder S; S.init(M, D, F.G, (int)blockIdx.x); pg8::EpiStoreH<true> E{QX, D, 0, 0, RSQ}; for (int rep = 0; rep < REPG(9); ++rep) pg8::gemm_phase<true, true>(F.lds, g, S, E); }
        GRID_BAR();
        for (int rep = 0; rep < REP_XATT; ++rep) {
            PHASE_IDS();
            LAS u16* KL = (LAS u16*)(F.lds + 0);
            LAS u16* PL = (LAS u16*)(F.lds + 69632);
            const int fr_o = lane & 15, fq_o = lane >> 4;
            const int NU = NBATCH * 4 * 16, per = (NU + F.G - 1) / F.G;
            for (int uj = 0; uj < per;) {
                const int un = (int)blockIdx.x * per + uj; if (un >= NU) break;
                const bool two = (uj + 1 < per) && (un + 1 < NU) && (((un + 1) >> 4) == (un >> 4));
                uj += two ? 2 : 1;
                int fr = fr_o, fq = fq_o, tl = tid; asm volatile("" : "+v"(fr), "+v"(fq), "+v"(tl));
                const int b = un >> 6, hx = (un >> 4) & 3, qtA = un & 15, qtB = two ? qtA + 1 : qtA;
                const int mqA = b * T + qtA * 128 + 16 * wave + fr, mqB = b * T + qtB * 128 + 16 * wave + fr;
                f32x4 sA[16], sB[16];
#pragma unroll
                for (int kb2 = 0; kb2 < 16; ++kb2) { sA[kb2] = (f32x4){0.f, 0.f, 0.f, 0.f}; sB[kb2] = (f32x4){0.f, 0.f, 0.f, 0.f}; }
#pragma unroll 1
                for (int hh = 0; hh < 2; ++hh) {
                    h16x8 qfA[4], qfB[4];
                    const u16* qpa = QX + pg8::blk32(mqA, 256 * hx + 128 * hh + 8 * fq, D); const u16* qpb = QX + pg8::blk32(mqB, 256 * hx + 128 * hh + 8 * fq, D);
#pragma unroll
                    for (int k4 = 0; k4 < 4; ++k4) { qfA[k4] = *(const h16x8*)(qpa + k4 * 1024); qfB[k4] = *(const h16x8*)(qpb + k4 * 1024); }
                    const u16* kp0 = KM + pg8::blk32(b * MEML + (tl >> 4), 256 * hx + 128 * hh + 8 * (tl & 15), D);
#pragma unroll
                    for (int i = 0; i < 8; ++i) { const int c = tl + 512 * i, row = c >> 4, cc = c & 15;
                        *(LAS u32x4*)(KL + row * 136 + 8 * cc) = *(const u32x4*)(kp0 + (size_t)i * (D / 32) * 1024); }
                    __syncthreads();
#pragma unroll
                    for (int kb2 = 0; kb2 < 16; ++kb2)
#pragma unroll
                        for (int k4 = 0; k4 < 4; ++k4) { const h16x8 a = *(const LAS h16x8*)(KL + (16 * kb2 + fr) * 136 + 32 * k4 + 8 * fq);
                            sA[kb2] = MFMA16(a, qfA[k4], sA[kb2]); sB[kb2] = MFMA16(a, qfB[k4], sB[kb2]); }
                    __syncthreads();
                }
                h16x8 pfA[8], pfB[8]; float isA, isB;
#define XA_SOFTMAX(sacc, pf, isum_) do { float mx = -3.0e38f; \
        _Pragma("unroll") for (int kb2 = 0; kb2 < 16; ++kb2) mx = fmaxf(mx, fmaxf(fmaxf(sacc[kb2][0], sacc[kb2][1]), fmaxf(sacc[kb2][2], sacc[kb2][3]))); \
        mx = xmax16(mx); mx = xmax32(mx); float sum = 0.f; const float sc = 0.0625f * 1.44269504089f; \
        _Pragma("unroll") for (int kb2 = 0; kb2 < 16; ++kb2) { float p[4]; \
            _Pragma("unroll") for (int r = 0; r < 4; ++r) { p[r] = __builtin_amdgcn_exp2f((sacc[kb2][r] - mx) * sc); sum += p[r]; } \
            u32x2 w; w.x = pk2(p[0], p[1]); w.y = pk2(p[2], p[3]); *(LAS u32x2*)(PL + (16 * wave + fr) * 264 + 16 * kb2 + 4 * fq) = w; } \
        sum = xsum16(sum); sum = xsum32(sum); isum_ = __builtin_amdgcn_rcpf(sum); \
        asm volatile("" ::: "memory"); \
        _Pragma("unroll") for (int ks = 0; ks < 8; ++ks) pf[ks] = *(const LAS h16x8*)(PL + (16 * wave + fr) * 264 + 32 * ks + 8 * fq); \
        asm volatile("" ::: "memory"); } while (0)
                XA_SOFTMAX(sA, pfA, isA);
                XA_SOFTMAX(sB, pfB, isB);
#undef XA_SOFTMAX
#pragma unroll 1
                for (int dh = 0; dh < 2; ++dh) {
                    const u16* vp0 = VTM + pg8::blk32(256 * hx + 128 * dh + (tl >> 5), b * MEML + 8 * (tl & 31), MM);
#pragma unroll
                    for (int i = 0; i < 8; ++i) { const int c = tl + 512 * i, row = c >> 5, cc = c & 31;
                        *(LAS u32x4*)(KL + row * 264 + 8 * cc) = *(const u32x4*)(vp0 + (size_t)(i >> 1) * (MM / 32) * 1024 + (i & 1) * 16 * 32); }
                    __syncthreads();
                    u16* opa = OX + pg8::blk32(mqA, 256 * hx + 128 * dh + 16 * (fq & 1) + 8 * (fq >> 1), D); u16* opb = OX + pg8::blk32(mqB, 256 * hx + 128 * dh + 16 * (fq & 1) + 8 * (fq >> 1), D);
#pragma unroll
                    for (int dp = 0; dp < 4; ++dp) {
                        f32x4 xa = {0.f, 0.f, 0.f, 0.f}, xb = {0.f, 0.f, 0.f, 0.f}, ya = {0.f, 0.f, 0.f, 0.f}, yb = {0.f, 0.f, 0.f, 0.f};
#pragma unroll
                        for (int ks = 0; ks < 8; ++ks) { const h16x8 a = *(const LAS h16x8*)(KL + (16 * (2 * dp) + fr) * 264 + 32 * ks + 8 * fq); xa = MFMA16(a, pfA[ks], xa); ya = MFMA16(a, pfB[ks], ya); }
#pragma unroll
                        for (int ks = 0; ks < 8; ++ks) { const h16x8 a = *(const LAS h16x8*)(KL + (16 * (2 * dp + 1) + fr) * 264 + 32 * ks + 8 * fq); xb = MFMA16(a, pfA[ks], xb); yb = MFMA16(a, pfB[ks], yb); }
#pragma unroll
                        for (int r = 0; r < 4; ++r) { float pa_ = xa[r], pb_ = xb[r]; pair16(pa_, pb_); xa[r] = pa_; xb[r] = pb_; float qa_ = ya[r], qb_ = yb[r]; pair16(qa_, qb_); ya[r] = qa_; yb[r] = qb_; }
                        u32x4 w; w.x = pk2b(xa[0] * isA, xa[1] * isA); w.y = pk2b(xa[2] * isA, xa[3] * isA); w.z = pk2b(xb[0] * isA, xb[1] * isA); w.w = pk2b(xb[2] * isA, xb[3] * isA);
                        *(u32x4*)(opa + dp * 1024) = w;
                        if (two) { u32x4 v; v.x = pk2b(ya[0] * isB, ya[1] * isB); v.y = pk2b(ya[2] * isB, ya[3] * isB); v.z = pk2b(yb[0] * isB, yb[1] * isB); v.w = pk2b(yb[2] * isB, yb[3] * isB);
                            *(u32x4*)(opb + dp * 1024) = v; }
                    }
                    __syncthreads();
                }
            }
        }
        GRID_BAR();
        { KBASE(); pg8::Gemm g{OX, W_O_t, M, D, D}; pg8::StaticOrder S; S.init(M, D, F.G, (int)blockIdx.x); pg8::EpiResid E{(unsigned char*)KARG(28), 1.0f}; pg8::gemm_phase<true, true>(F.lds, g, S, E); }
        GRID_BAR();
        { KBASE(); pg8::Gemm g{H16, W_in_t + (size_t)5632 * 1024, M, 2 * DFF, D}; pg8::StaticOrder S; S.init(M, 2 * DFF, F.G, (int)blockIdx.x); pg8::EpiSwiglu E{ACT, DFF, RSQ};
          for (int rep = 0; rep < REPG(10); ++rep) pg8::gemm_phase<true, true>(F.lds, g, S, E); }
        GRID_BAR();
        { KBASE(); pg8::Gemm g{ACT, W_out_t + (size_t)1024 * 2816, M, D, DFF}; pg8::StaticOrder S; S.init(M, D, F.G, (int)blockIdx.x); pg8::EpiResid E{(unsigned char*)KARG(28), 0.5f};
          pg8::gemm_phase<true, true>(F.lds, g, S, E); }
        GRID_BAR();
    }
    PHASE_IDS();
    for (int m = gw; m < M; m += NGW) {
        f32x4* xr = (f32x4*)(H + (size_t)m * D) + lane; const f32x4* gr = (const f32x4*)final_norm + lane;
        f32x4 v[4]; float ss = 0.f;
#pragma unroll
        for (int j = 0; j < 4; ++j) { const u32x2 w = *(const u32x2*)(H16 + pg8::blk32(m, 4 * lane + 256 * j, D)); v[j] = (f32x4){blo(w.x), bhi(w.x), blo(w.y), bhi(w.y)}; ss += (v[j].x * v[j].x + v[j].y * v[j].y) + (v[j].z * v[j].z + v[j].w * v[j].w); }
        const float r = __builtin_amdgcn_rsqf(wave_sum(ss) * (1.f / D) + 1e-6f);
#pragma unroll
        for (int j = 0; j < 4; ++j) xr[64 * j] = v[j] * r * gr[64 * j];
    }
}

extern "C" void kernel_launch(void* const* d_in, const int* in_sizes, int n_in, void* d_out, int out_size, void* d_ws, size_t ws_size, hipStream_t stream) {
    static int grid = 0;
    if (grid == 0) {
        if (n_in != 27 || out_size != M * D || ws_size < WS_END) { fprintf(stderr, "kernel_launch: unexpected problem (n_in %d, out %d, ws %zu < %zu)\n", n_in, out_size, ws_size, (size_t)WS_END); grid = -1; return; }
        int dev = 0, cus = 0, per_cu = 0;
        if (hipGetDevice(&dev) != hipSuccess || hipDeviceGetAttribute(&cus, hipDeviceAttributeMultiprocessorCount, dev) != hipSuccess) { grid = -1; return; }
        if (hipFuncSetAttribute((const void*)fwd_kernel, hipFuncAttributeMaxDynamicSharedMemorySize, LDS_BYTES) != hipSuccess) { fprintf(stderr, "kernel_launch: hipFuncSetAttribute failed\n"); grid = -1; return; }
        if (hipOccupancyMaxActiveBlocksPerMultiprocessor(&per_cu, (const void*)fwd_kernel, NWAVES * 64, LDS_BYTES) != hipSuccess || per_cu < 1) { fprintf(stderr, "kernel_launch: occupancy query says %d\n", per_cu); }
        (void)hipGetLastError();
        grid = cus;
    }
    if (grid < 0) return;
    if (hipMemsetAsync((char*)d_ws + WS_CTL, 0, CTL_ZERO_BYTES, stream) != hipSuccess) return;
    Args a{};
    for (int i = 0; i < 27; ++i) a.in[i] = d_in[i];
    a.out = (float*)d_out; a.ws = (unsigned char*)d_ws; a.pad0 = 0; a.pad1 = 0;
    hipLaunchKernelGGL(fwd_kernel, dim3(grid), dim3(NWAVES * 64), LDS_BYTES, stream, a);
}
```

```cpp
#include <hip/hip_runtime.h>
#include <cstdio>
#include <cstdint>

#define GAS __attribute__((address_space(1)))
#define LAS __attribute__((address_space(3)))
#define CAS __attribute__((address_space(4)))
typedef unsigned short u16;
typedef _Float16 h16x8 __attribute__((ext_vector_type(8)));
typedef _Float16 h16x4 __attribute__((ext_vector_type(4)));
typedef _Float16 h16x2 __attribute__((ext_vector_type(2)));
typedef float f32x4 __attribute__((ext_vector_type(4)));
typedef float f32x2 __attribute__((ext_vector_type(2)));
typedef unsigned u32x4 __attribute__((ext_vector_type(4)));
typedef unsigned u32x2 __attribute__((ext_vector_type(2)));

__device__ __forceinline__ unsigned pk2(float lo, float hi) { f32x2 v = {lo, hi}; h16x2 h = __builtin_convertvector(v, h16x2); return __builtin_bit_cast(unsigned, h); }
typedef __bf16 b16x2 __attribute__((ext_vector_type(2)));
__device__ __forceinline__ unsigned pk2b(float lo, float hi) { f32x2 v = {lo, hi}; b16x2 h = __builtin_convertvector(v, b16x2); return __builtin_bit_cast(unsigned, h); }
__device__ __forceinline__ u16 f2b(float f) { return (u16)(pk2b(f, 0.f) & 0xffffu); }
__device__ __forceinline__ float blo(unsigned u) { return __builtin_bit_cast(float, u << 16); }
__device__ __forceinline__ float bhi(unsigned u) { return __builtin_bit_cast(float, u & 0xffff0000u); }
__device__ __forceinline__ u16 f2h(float f) { _Float16 h = (_Float16)f; return __builtin_bit_cast(u16, h); }
__device__ __forceinline__ float h2f(u16 u) { return (float)__builtin_bit_cast(_Float16, u); }
__device__ __forceinline__ float hlo(unsigned u) { return (float)__builtin_bit_cast(h16x2, u)[0]; }
__device__ __forceinline__ float hhi(unsigned u) { return (float)__builtin_bit_cast(h16x2, u)[1]; }
__device__ __forceinline__ float fsigmoid(float x) { return __builtin_amdgcn_rcpf(1.0f + __builtin_amdgcn_exp2f(-1.44269504089f * x)); }
__device__ __forceinline__ float fsilu(float x) { return x * fsigmoid(x); }
#define DPP_ADD_(v, ctrl, rmask) (v) += __builtin_bit_cast(float, __builtin_amdgcn_update_dpp(0, __builtin_bit_cast(int, (v)), (ctrl), (rmask), 0xf, false))
__device__ __forceinline__ float sum16(float v) {
    DPP_ADD_(v, 0xB1, 0xf); DPP_ADD_(v, 0x4E, 0xf); DPP_ADD_(v, 0x141, 0xf); DPP_ADD_(v, 0x140, 0xf); return v; }
__device__ __forceinline__ float wave_sum(float v) {
    v = sum16(v); DPP_ADD_(v, 0x142, 0xa); DPP_ADD_(v, 0x143, 0xc);
    return __builtin_bit_cast(float, __builtin_amdgcn_readlane(__builtin_bit_cast(int, v), 63)); }
__device__ __forceinline__ float xsum32(float v) {
    const unsigned u = __builtin_bit_cast(unsigned, v); auto r = __builtin_amdgcn_permlane32_swap(u, u, false, false); const unsigned a = r[0], b = r[1];
    return __builtin_bit_cast(float, a) + __builtin_bit_cast(float, b); }
__device__ __forceinline__ float xsum16(float v) {
    const unsigned u = __builtin_bit_cast(unsigned, v); auto r = __builtin_amdgcn_permlane16_swap(u, u, false, false); const unsigned a = r[0], b = r[1];
    return __builtin_bit_cast(float, a) + __builtin_bit_cast(float, b); }
__device__ __forceinline__ void pair16(float& a, float& b) {
    auto r = __builtin_amdgcn_permlane16_swap(__builtin_bit_cast(unsigned, a), __builtin_bit_cast(unsigned, b), false, false); const unsigned x = r[0], y = r[1];
    a = __builtin_bit_cast(float, x); b = __builtin_bit_cast(float, y); }
__device__ __forceinline__ float xmax32(float v) { const unsigned u = __builtin_bit_cast(unsigned, v); auto r = __builtin_amdgcn_permlane32_swap(u, u, false, false); const unsigned a = r[0], b = r[1];
    return fmaxf(__builtin_bit_cast(float, a), __builtin_bit_cast(float, b)); }
__device__ __forceinline__ float xmax16(float v) { const unsigned u = __builtin_bit_cast(unsigned, v); auto r = __builtin_amdgcn_permlane16_swap(u, u, false, false); const unsigned a = r[0], b = r[1];
    return fmaxf(__builtin_bit_cast(float, a), __builtin_bit_cast(float, b)); }
__device__ __forceinline__ float quad_bcast(float v, int src) {
    const int x = __builtin_bit_cast(int, v); int r;
    switch (src) { case 0: r = __builtin_amdgcn_update_dpp(0, x, 0x00, 0xF, 0xF, true); break; case 1: r = __builtin_amdgcn_update_dpp(0, x, 0x55, 0xF, 0xF, true); break;
                   case 2: r = __builtin_amdgcn_update_dpp(0, x, 0xAA, 0xF, 0xF, true); break; default: r = __builtin_amdgcn_update_dpp(0, x, 0xFF, 0xF, 0xF, true); break; }
    return __builtin_bit_cast(float, r);
}
__device__ __forceinline__ int fresh_tid() { int t = threadIdx.x; asm volatile("" : "+v"(t)); return t; }
#define MFMA16(a, b, c) __builtin_amdgcn_mfma_f32_16x16x32_f16((a), (b), (c), 0, 0, 0)
typedef short s16x4 __attribute__((ext_vector_type(4)));
typedef short s16x8 __attribute__((ext_vector_type(8)));
__device__ __forceinline__ h16x8 lds_tr16(const __attribute__((address_space(3))) unsigned short* img, int pitch, int k0, int n0, int lane) {
    const int g = lane >> 4, q = (lane & 15) >> 2, p = lane & 3;
    const __attribute__((address_space(3))) unsigned short* a = img + (k0 + 8 * g + q) * pitch + n0 + 4 * p;
    const s16x4 r0 = __builtin_amdgcn_ds_read_tr16_b64_v4i16((__attribute__((address_space(3))) s16x4*)a);
    const s16x4 r1 = __builtin_amdgcn_ds_read_tr16_b64_v4i16((__attribute__((address_space(3))) s16x4*)(a + 4 * pitch));
    return __builtin_bit_cast(h16x8, __builtin_shufflevector(r0, r1, 0, 1, 2, 3, 4, 5, 6, 7));
}

namespace pg8 {
#ifndef PG8_ZC
#define PG8_ZC 1
#endif
#ifndef PG8_SPLIT
#define PG8_SPLIT false
#endif
constexpr int BM = 256, BK = 64, HALF = 128, HTB = HALF * BK * 2, STAGE_BYTES = 8 * HTB, NXCD = 8, WGM = 8;
__host__ __device__ __forceinline__ int lds_byte(int r, int c) { const int st = (r >> 4) * 2 + (c >> 5), rr = r & 15, cc = c & 31, ob = rr * 64 + cc * 2; return st * 1024 + (ob ^ (((ob >> 9) & 1) << 5)); }
__host__ __device__ __forceinline__ void stage_rc(int b, int& R, int& C) { const int st = b / 1024, sb = b % 1024, swz = sb ^ (((sb >> 9) & 1) << 5); R = (st >> 1) * 16 + swz / 64; C = (st & 1) * 32 + (swz % 64) / 2; }
__host__ __device__ __forceinline__ int perm32(int rho) { const int n = rho >> 4, i = rho & 15; return 8 * (i >> 2) + 4 * n + (i & 3); }
__host__ __device__ __forceinline__ size_t blk32(int row, int col, int K) { return ((size_t)(row >> 5) * (K >> 5) + (col >> 5)) * 1024 + (row & 31) * 32 + (col & 31); }
struct Unit { int pm, pn; };
struct Gemm { const u16* A; const u16* Bt; int M, N, K; int lda, asplit; unsigned aofs; };
struct StaticOrder {
    int nM, nN, nwg, G, c;
    __host__ __device__ void init(int M, int N, int G_, int c_) { nM = M / BM; nN = N / BM; nwg = nM * nN; G = G_; c = c_; }
    __host__ __device__ bool next(int i, Unit& u) const {
        const long L = (long)i * G + c; if (L >= nwg) return false;
        int wgid = (int)L; { const int q = nwg / NXCD, r = nwg % NXCD, xcd = wgid % NXCD, off = wgid / NXCD; wgid = (xcd < r ? xcd * (q + 1) : r * (q + 1) + (xcd - r) * q) + off; }
        const int nig = WGM * nN, gid = wgid / nig, fm = gid * WGM, gsz = (nM - fm) < WGM ? (nM - fm) : WGM;
        u.pm = fm + ((wgid % nig) % gsz); u.pn = (wgid % nig) / gsz; return true;
    }
    __device__ __forceinline__ void a_ready(const Unit&, int) const {}
    __device__ __forceinline__ void done(const Unit&) const {}
};
__device__ __forceinline__ void load_scales(LAS float* dst, const float* rsq, int pm, int tid) {
    const int r = tid >> 1, hf = tid & 1;
    const f32x4* p = (const f32x4*)(rsq + (size_t)pm * 4096) + (unsigned)(tid * 2);
    const f32x4 a = p[0], b = p[1]; const f32x4 t = a + b; float s = (t[0] + t[1]) + (t[2] + t[3]);
    s += __builtin_bit_cast(float, __builtin_amdgcn_update_dpp(0, __builtin_bit_cast(int, s), 0xB1, 0xF, 0xF, true));
    if (hf == 0) dst[(((r >> 6) & 1) * 16 + (r & 15)) * 8 + (r >> 7) * 4 + ((r >> 4) & 3)] = __builtin_amdgcn_rsqf(s * (1.0f / 1024.0f) + 1e-6f);
}
template <bool RS> struct EpiStoreH {
    static constexpr bool PERM = true, SPLIT = PG8_SPLIT, HALVES = true, RS_LDS = RS;
    static constexpr int NST = 8;
    u16* O; int ldc; int split_cols; size_t split_stride; const float* rsv;
    template <int AI> __device__ __forceinline__ void half(const f32x4 (&acc)[2][2][4][2], const Unit& u, int wr, int wc, int fr_in, int fq_in, const LAS float* rs) const {
        int fr = fr_in, fq = fq_in; asm volatile("" : "+v"(fr), "+v"(fq));
        const int row0 = u.pm * BM + wr * 64 + fr + AI * HALF; int colt = u.pn * BM; u16* base = O;
        if (split_cols) { const int t = colt / split_cols; base += (size_t)t * split_stride; colt -= t * split_cols; }
        const int col0 = colt + wc * 32 + 8 * fq;
        f32x4 rsa = {1.f, 1.f, 1.f, 1.f};
        if (RS) rsa = *(const LAS f32x4*)(rs + (wr * 16 + fr) * 8 + AI * 4);
        u16* p0 = base + blk32(row0, col0, ldc);
#pragma unroll
        for (int m = 0; m < 4; ++m) {
            const float rsc = rsa[m];
#pragma unroll
            for (int bj = 0; bj < 2; ++bj) { const f32x4 v0 = acc[AI][bj][m][0] * rsc, v1 = acc[AI][bj][m][1] * rsc;
                u32x4 w; w.x = pk2(v0[0], v0[1]); w.y = pk2(v0[2], v0[3]); w.z = pk2(v1[0], v1[1]); w.w = pk2(v1[2], v1[3]);
                __builtin_nontemporal_store(w, (u32x4*)(p0 + (size_t)(m >> 1) * (ldc >> 5) * 1024 + (m & 1) * 512 + bj * (HALF / 32) * 1024)); } }
    }
};
struct EpiSwiglu {
    static constexpr bool PERM = true, SPLIT = PG8_SPLIT, HALVES = true, RS_LDS = true;
    static constexpr int NST = 4;
    u16* O; int ldc; const float* rsv;
    template <int AI> __device__ __forceinline__ void half(const f32x4 (&acc)[2][2][4][2], const Unit& u, int wr, int wc, int fr_in, int fq_in, const LAS float* rs) const {
        int fr = fr_in, fq = fq_in; asm volatile("" : "+v"(fr), "+v"(fq));
        const int row0 = u.pm * BM + wr * 64 + fr + AI * HALF, col0 = u.pn * HALF + wc * 32 + 8 * fq;
        const f32x4 rsa = *(const LAS f32x4*)(rs + (wr * 16 + fr) * 8 + AI * 4);
        u16* p0 = O + blk32(row0, col0, ldc);
#pragma unroll
        for (int m = 0; m < 4; ++m) { u16* rowp = p0 + (size_t)(m >> 1) * (ldc >> 5) * 1024 + (m & 1) * 512;
            const float rsc = rsa[m]; const f32x2 rs2 = {rsc, rsc};
            unsigned ow[4];
#pragma unroll
            for (int p = 0; p < 4; ++p) {
                const f32x4 ga = acc[AI][0][m][p >> 1], ua = acc[AI][1][m][p >> 1];
                const f32x2 g2 = (f32x2){ga[2 * (p & 1)], ga[2 * (p & 1) + 1]} * rs2, u2 = (f32x2){ua[2 * (p & 1)], ua[2 * (p & 1) + 1]} * rs2;
                const f32x2 t2 = g2 * (f32x2){-1.44269504089f, -1.44269504089f};
                const f32x2 d2 = (f32x2){__builtin_amdgcn_exp2f(t2.x), __builtin_amdgcn_exp2f(t2.y)} + (f32x2){1.0f, 1.0f};
                const f32x2 o2 = (g2 * (f32x2){__builtin_amdgcn_rcpf(d2.x), __builtin_amdgcn_rcpf(d2.y)}) * u2;
                ow[p] = pk2b(o2.x, o2.y); }
            u32x4 w; w.x = ow[0]; w.y = ow[1]; w.z = ow[2]; w.w = ow[3];
            __builtin_nontemporal_store(w, (u32x4*)rowp); }
    }
};
constexpr size_t H16_OFF = (size_t)127 << 20, RSQ_OFF = (size_t)255 << 20;
struct EpiResid {
    static constexpr bool PERM = true, SPLIT = false, HALVES = false, RS_LDS = false;
    static constexpr int NST = 0;
    static constexpr int ldc = 1024;
    static constexpr const float* rsv = nullptr;
    template <int AI> __device__ __forceinline__ void half(const f32x4 (&)[2][2][4][2], const Unit&, int, int, int, int, const LAS float*) const {}
    unsigned char* wsb; float scale;
    __device__ __forceinline__ void operator()(const f32x4 (&acc)[2][2][4][2], const Unit& u, int wr, int wc, int fr_in, int fq_in, int, const LAS float*) const {
        int fr = fr_in, fq = fq_in; asm volatile("" : "+v"(fr), "+v"(fq));
        const int row0 = u.pm * BM + wr * 64 + fr, col0 = u.pn * BM + wc * 32 + 8 * fq;
        u16* h16 = (u16*)(wsb + H16_OFF); float* rsq = (float*)(wsb + RSQ_OFF);
#pragma unroll
        for (int ai = 0; ai < 2; ++ai)
#pragma unroll
            for (int m = 0; m < 4; ++m) { const int rw = row0 + ai * HALF + m * 16; float sq = 0.f;
                u32x4 hv[2];
#pragma unroll
                for (int bj = 0; bj < 2; ++bj) hv[bj] = *(const u32x4*)(h16 + blk32(rw, col0 + bj * HALF, ldc));
#pragma unroll
                for (int bj = 0; bj < 2; ++bj) { unsigned ow[4];
#pragma unroll
                    for (int n = 0; n < 2; ++n) { const unsigned w0 = hv[bj][2 * n], w1 = hv[bj][2 * n + 1];
                        const f32x4 bs = {blo(w0), bhi(w0), blo(w1), bhi(w1)}; const f32x4 o = bs + acc[ai][bj][m][n] * scale;
                        ow[2 * n] = pk2b(o[0], o[1]); ow[2 * n + 1] = pk2b(o[2], o[3]);
                        sq += (o[0] * o[0] + o[1] * o[1]) + (o[2] * o[2] + o[3] * o[3]); }
                    u32x4 w; w.x = ow[0]; w.y = ow[1]; w.z = ow[2]; w.w = ow[3]; *(u32x4*)(h16 + blk32(rw, col0 + bj * HALF, ldc)) = w; }
                sq = xsum16(sq); sq = xsum32(sq);
                if (fq == 0) rsq[(size_t)(row0 + ai * HALF + m * 16) * 16 + 4 * u.pn + wc] = sq;
                asm volatile("" ::: "memory"); }
    }
};
struct EpiGate {
    static constexpr bool PERM = true, SPLIT = false, HALVES = false, RS_LDS = true;
    static constexpr int NST = 0;
    template <int AI> __device__ __forceinline__ void half(const f32x4 (&)[2][2][4][2], const Unit&, int, int, int, int, const LAS float*) const {}
    const float* ba; const float* bb; const u16* tA; const u16* tB; u16* O; int ldc; const float* rsv;
    __device__ __forceinline__ void operator()(const f32x4 (&acc)[2][2][4][2], const Unit& u, int wr, int wc, int fr_in, int fq_in, int ui, const LAS float* rs) const {
        int fr = fr_in, fq = fq_in; asm volatile("" : "+v"(fr), "+v"(fq));
        const int row0 = u.pm * BM + wr * 64 + fr, col0 = u.pn * HALF + wc * 32 + 8 * fq;
        float va[8], vb[8];
#pragma unroll
        for (int j = 0; j < 8; ++j) { va[j] = ba[col0 + j]; vb[j] = bb[col0 + j]; }
        f32x4 rsa[2]; { const LAS f32x4* rp = (const LAS f32x4*)(rs + (wr * 16 + fr) * 8); rsa[0] = rp[0]; rsa[1] = rp[1]; }
#pragma unroll
        for (int ai = 0; ai < 2; ++ai)
#pragma unroll
            for (int m = 0; m < 4; ++m) { const size_t off = (size_t)(row0 + ai * HALF + m * 16) * ldc + col0;
                const size_t boff = blk32(row0 + ai * HALF + m * 16, col0, ldc); const u32x4 a4 = *(const u32x4*)(tA + boff), b4 = *(const u32x4*)(tB + boff);
                const float rs = rsa[ai][m];
                const f32x2 rs2 = {rs, rs}; unsigned ow[4];
#pragma unroll
                for (int p = 0; p < 4; ++p) {
                    const f32x4 xa = acc[ai][0][m][p >> 1], xb = acc[ai][1][m][p >> 1]; const int e = 2 * p;
                    const f32x2 pa = (f32x2){xa[2 * (p & 1)], xa[2 * (p & 1) + 1]} * rs2 + (f32x2){va[e], va[e + 1]}, pb = (f32x2){xb[2 * (p & 1)], xb[2 * (p & 1) + 1]} * rs2 + (f32x2){vb[e], vb[e + 1]};
                    const f32x2 ta2 = pa * (f32x2){-1.44269504089f, -1.44269504089f}, tb2 = pb * (f32x2){-1.44269504089f, -1.44269504089f};
                    const f32x2 da = (f32x2){__builtin_amdgcn_exp2f(ta2.x), __builtin_amdgcn_exp2f(ta2.y)} + (f32x2){1.0f, 1.0f}, db = (f32x2){__builtin_amdgcn_exp2f(tb2.x), __builtin_amdgcn_exp2f(tb2.y)} + (f32x2){1.0f, 1.0f};
                    const f32x2 tA = {hlo(a4[p]), hhi(a4[p])}, tB = {hlo(b4[p]), hhi(b4[p])};
                    const f32x2 o2 = (f32x2){__builtin_amdgcn_rcpf(da.x), __builtin_amdgcn_rcpf(da.y)} * tA + (f32x2){__builtin_amdgcn_rcpf(db.x), __builtin_amdgcn_rcpf(db.y)} * tB;
                    ow[p] = pk2b(o2.x, o2.y); }
                u32x4 w; w.x = ow[0]; w.y = ow[1]; w.z = ow[2]; w.w = ow[3];
                __builtin_nontemporal_store(w, (u32x4*)(O + blk32(row0 + ai * HALF + m * 16, col0, ldc))); }
    }
};

typedef __bf16 bf16x8 __attribute__((ext_vector_type(8)));
#define MFMA16B(a, b, c) __builtin_amdgcn_mfma_f32_16x16x32_bf16(__builtin_bit_cast(bf16x8, (a)), __builtin_bit_cast(bf16x8, (b)), (c), 0, 0, 0)
template <bool ABLK, bool BBLK, class Epi, class Sched>
__device__ __forceinline__ void gemm_phase(LAS unsigned char* lds, const Gemm g, const Sched& S, const Epi& E) {
    const int tid = fresh_tid(), wid = __builtin_amdgcn_readfirstlane(tid >> 6), lane = tid & 63, wr = wid >> 2, wc = wid & 3, fr = lane & 15, fq = lane >> 4;
    const int K = g.K, KA = g.lda ? g.lda : K; int nt = K / BK; asm volatile("" : "+s"(nt));
    unsigned voffA, voffB;
    { int R, C; stage_rc(tid * 16, R, C); const int Rb = Epi::PERM ? ((R & ~31) + perm32(R & 31)) : R;
      voffA = ABLK ? (unsigned)blk32(R, C, KA) * 2u : (unsigned)(R * KA + C) * 2u; voffB = BBLK ? (unsigned)blk32(Rb, C, K) * 2u : (unsigned)(Rb * K + C) * 2u; }
    const size_t sA = (size_t)64 * KA * 2, sB = (size_t)64 * K * 2;
    const size_t kstepA = ABLK ? (size_t)4096 : (size_t)(BK * 2), kstepB = BBLK ? (size_t)4096 : (size_t)(BK * 2);
    const size_t hstep = (size_t)HALF * K * 2, hstepA = (size_t)HALF * KA * 2;
    const size_t tstep = 2 * hstep, tstepA = 2 * hstepA;
    const unsigned ldsw = (unsigned)wid * 1024u;
    const int aoff = lds_byte(wr * 64 + fr, fq * 8), boff = lds_byte(wc * 32 + fr, fq * 8);
#define PG8_SA(b, h) (((b) * 2 + (h)) * HTB)
#define PG8_SB(b, h) ((4 + (b) * 2 + (h)) * HTB)
#define PG8_STAGE(bufoff, gbase, voff) do { _Pragma("unroll") for (int _i = 0; _i < 2; ++_i) \
        __builtin_amdgcn_global_load_lds((const unsigned*)((const char*)(gbase) + _i * PG8_STEP_##voff + (voff)), (LAS unsigned*)(lds + (bufoff) + ldsw + _i * 8192), 16, 0, 0); } while (0)
#define PG8_STEP_voffA sA
#define PG8_STEP_voffB sB
#define PG8_LDA(dst, b, h) do { _Pragma("unroll") for (int m = 0; m < 4; ++m) _Pragma("unroll") for (int k = 0; k < 2; ++k) dst[m][k] = *(const LAS h16x8*)(lds + PG8_SA(b, h) + aoff + m * 2048 + k * 1024); } while (0)
#define PG8_LDB(dst, b, h) do { _Pragma("unroll") for (int n = 0; n < 2; ++n) _Pragma("unroll") for (int k = 0; k < 2; ++k) dst[n][k] = *(const LAS h16x8*)(lds + PG8_SB(b, h) + boff + n * 2048 + k * 1024); } while (0)
#define PG8_MMA(ai, bj, At, Bt) do { __builtin_amdgcn_s_setprio(1); _Pragma("unroll") for (int m = 0; m < 4; ++m) _Pragma("unroll") for (int n = 0; n < 2; ++n) _Pragma("unroll") for (int k = 0; k < 2; ++k) \
        acc[ai][bj][m][n] = MFMA16B(Bt[n][k], At[m][k], acc[ai][bj][m][n]); __builtin_amdgcn_s_setprio(0); } while (0)
#define PG8_MMAZ(ai, bj, At, Bt) do { __builtin_amdgcn_s_setprio(1); _Pragma("unroll") for (int m = 0; m < 4; ++m) _Pragma("unroll") for (int n = 0; n < 2; ++n) { \
        acc[ai][bj][m][n] = MFMA16B(Bt[n][0], At[m][0], zero4); acc[ai][bj][m][n] = MFMA16B(Bt[n][1], At[m][1], acc[ai][bj][m][n]); } __builtin_amdgcn_s_setprio(0); } while (0)
#define PG8_WAIT_V(n) asm volatile("s_waitcnt vmcnt(" #n ")" ::: "memory")
#define PG8_WAIT_VN(n) asm volatile("s_waitcnt vmcnt(%0)" :: "n"(n) : "memory")
#define PG8_WAIT_L(n) asm volatile("s_waitcnt lgkmcnt(" #n ")" ::: "memory")
#define PG8_BAR __builtin_amdgcn_s_barrier()
#define PG8_SCHED __builtin_amdgcn_sched_barrier(0)
#define PG8_H1P E.template half<1>(acc, prv, wr, wc, fr, fq, rsl + psb * 256)
#define PG8_H0C E.template half<0>(acc, cur, wr, wc, fr, fq, rsl + sb * 256)
#define PG8_ZERO(a) do { _Pragma("unroll") for (int b_ = 0; b_ < 2; ++b_) _Pragma("unroll") for (int m_ = 0; m_ < 4; ++m_) _Pragma("unroll") for (int n_ = 0; n_ < 2; ++n_) acc[a][b_][m_][n_] = zero4; } while (0)
    Unit cur, nxt, prv; int ui = 0; prv.pm = 0; prv.pn = 0;
    if (!S.next(0, cur)) return;
    f32x4 acc[2][2][4][2]; const f32x4 zero4 = {0.f, 0.f, 0.f, 0.f};
    PG8_ZERO(0); PG8_ZERO(1);
    h16x8 At[4][2], B0[2][2], B1[2][2];
    LAS float* rsl = (LAS float*)(lds + STAGE_BYTES);
    int sb = 0, psb = 0;
    if (Epi::RS_LDS) load_scales(rsl, E.rsv, cur.pm, tid);
    const char* cA = (const char*)g.A + (size_t)cur.pm * tstepA + ((g.asplit && cur.pn >= g.asplit) ? g.aofs : 0u); const char* cB = (const char*)g.Bt + (size_t)cur.pn * tstep;
    S.a_ready(cur, 0);
    PG8_STAGE(PG8_SB(0, 0), cB, voffB); PG8_STAGE(PG8_SB(0, 1), cB + hstep, voffB); PG8_STAGE(PG8_SA(0, 0), cA, voffA); PG8_STAGE(PG8_SA(0, 1), cA + hstepA, voffA);
    if (wr == 1) PG8_BAR;
    PG8_WAIT_V(2); PG8_BAR;
    PG8_STAGE(PG8_SB(1, 0), cB + kstepB, voffB); PG8_STAGE(PG8_SA(1, 0), cA + kstepA, voffA); PG8_STAGE(PG8_SB(1, 1), cB + hstep + kstepB, voffB);
    PG8_WAIT_V(6); PG8_BAR;
    for (;;) {
        const bool has_next = S.next(ui + 1, nxt);
        const char* nA = has_next ? (const char*)g.A + (size_t)nxt.pm * tstepA + ((g.asplit && nxt.pn >= g.asplit) ? g.aofs : 0u) : cA; const char* nB = has_next ? (const char*)g.Bt + (size_t)nxt.pn * tstep : cB;
        for (int t = 0; t < nt; t += 2) {
            const bool last = (t == nt - 2), fe = Epi::SPLIT && t == 0 && ui > 0;
            const char* a1 = cA + (size_t)(t + 1) * kstepA;
            const char* a2 = last ? nA : cA + (size_t)(t + 2) * kstepA; const char* b2 = last ? nB : cB + (size_t)(t + 2) * kstepB;
            const char* a3 = a2 + kstepA; const char* b3 = b2 + kstepB;
            PG8_LDB(B0, 0, 0); PG8_LDB(B1, 0, 1); PG8_SCHED; PG8_LDA(At, 0, 0); PG8_STAGE(PG8_SA(1, 1), a1 + hstepA, voffA);
            if (fe) { PG8_H1P; PG8_ZERO(1); PG8_WAIT_VN(8 + 2 * Epi::NST); } else PG8_WAIT_V(8);
            PG8_WAIT_L(0); PG8_BAR; PG8_MMA(0, 0, At, B0); PG8_MMA(0, 1, At, B1); PG8_BAR; PG8_SCHED;
            PG8_LDA(At, 0, 1); PG8_STAGE(PG8_SB(0, 0), b2, voffB); PG8_STAGE(PG8_SB(0, 1), b2 + hstep, voffB); PG8_STAGE(PG8_SA(0, 0), a2, voffA);
            if (fe) PG8_WAIT_VN(8 + 2 * Epi::NST); else PG8_WAIT_V(8);
            PG8_WAIT_L(0); PG8_BAR; PG8_MMA(1, 0, At, B0); PG8_MMA(1, 1, At, B1); PG8_BAR; PG8_SCHED;
            PG8_LDB(B0, 1, 0); PG8_LDB(B1, 1, 1); PG8_SCHED; PG8_LDA(At, 1, 0); PG8_STAGE(PG8_SA(0, 1), a2 + hstepA, voffA);
            if (fe) PG8_WAIT_VN(8 + Epi::NST); else PG8_WAIT_V(8);
            PG8_WAIT_L(0); PG8_BAR; PG8_MMA(0, 0, At, B0); PG8_MMA(0, 1, At, B1); PG8_BAR; PG8_SCHED;
            PG8_LDA(At, 1, 1); PG8_STAGE(PG8_SB(1, 0), b3, voffB); PG8_STAGE(PG8_SB(1, 1), b3 + hstep, voffB); PG8_STAGE(PG8_SA(1, 0), a3, voffA);
            if (Epi::SPLIT && last) { PG8_SCHED; PG8_H0C; PG8_ZERO(0); PG8_WAIT_VN(8 + Epi::NST); } else PG8_WAIT_V(8);
            PG8_WAIT_L(0); PG8_BAR; PG8_MMA(1, 0, At, B0); PG8_MMA(1, 1, At, B1); PG8_BAR; PG8_SCHED;
        }
        if constexpr (!Epi::SPLIT) {
            if (wr == 0) PG8_BAR;
            if constexpr (Epi::HALVES) { E.template half<0>(acc, cur, wr, wc, fr, fq, rsl + sb * 256); E.template half<1>(acc, cur, wr, wc, fr, fq, rsl + sb * 256); } else E(acc, cur, wr, wc, fr, fq, ui, rsl + sb * 256);
            if (!has_next) break;
            if (Epi::RS_LDS && nxt.pm != cur.pm) { sb ^= 1; load_scales(rsl + sb * 256, E.rsv, nxt.pm, tid); }
            cur = nxt; cA = nA; cB = nB; ++ui;
            if (wr == 1) PG8_BAR;
            PG8_SCHED; PG8_ZERO(0); PG8_ZERO(1); PG8_SCHED;
        } else {
            if (!has_next) { E.template half<1>(acc, cur, wr, wc, fr, fq, rsl + sb * 256); break; }
            prv = cur; psb = sb;
            if (Epi::RS_LDS && nxt.pm != cur.pm) { sb ^= 1; load_scales(rsl + sb * 256, E.rsv, nxt.pm, tid); }
            cur = nxt; cA = nA; cB = nB; ++ui;
        }
    }
    if (Epi::SPLIT) { if (wr == 0) PG8_BAR; }
    PG8_WAIT_V(0);
    PG8_BAR;
#undef PG8_ZERO
#undef PG8_H1P
#undef PG8_H0C
#undef PG8_NONE
#undef PG8_SA
#undef PG8_SB
#undef PG8_STAGE
#undef PG8_STEP_voffA
#undef PG8_STEP_voffB
#undef PG8_LDA
#undef PG8_LDB
#undef PG8_MMA
#undef PG8_MMAZ
#undef PG8_WAIT_V
#undef PG8_WAIT_VN
#undef PG8_WAIT_L
#undef PG8_BAR
#undef PG8_SCHED
}
}

#ifndef REP_CONV
#define REP_CONV 1
#endif
#ifndef REP_RMS
#define REP_RMS 1
#endif
#ifndef REP_MASK
#define REP_MASK 0
#endif
#define REPG(i) ((((REP_MASK) >> (i)) & 1) + 1)
#ifndef REP_G
#define REP_G 1
#endif
#ifndef REP_PREP
#define REP_PREP 1
#endif
#ifndef REP_PA
#define REP_PA 1
#endif
#ifndef REP_PB
#define REP_PB 1
#endif
#ifndef REP_POST
#define REP_POST 1
#endif
#ifndef REP_RET
#define REP_RET 1
#endif
#ifndef REP_XATT
#define REP_XATT 1
#endif
#ifndef REP_BAR
#define REP_BAR 1
#endif
constexpr int NWAVES = 8;
constexpr int D = 1024, NBATCH = 32, T = 2048, DEPTH = 4, M = NBATCH * T, MEML = 256, MM = NBATCH * MEML, DFF = 2816;
constexpr int AW = 512, INW = 6912, CH = 32, NCH = T / CH;
constexpr size_t MiB = 1u << 20;
constexpr size_t WS_CTL = 0, CTL_ZERO_BYTES = 1 * MiB;
constexpr size_t WS_WB = 1 * MiB;
constexpr size_t WB_WIN = 0, WB_WOUT = WB_WIN + 2 * (size_t)5632 * 1024 * 2, WB_WA = WB_WOUT + 2 * (size_t)1024 * 2816 * 2, WB_WBM = WB_WA + (size_t)1792 * 1024 * 2,
                 WB_WG = WB_WBM + (size_t)3072 * 1024 * 2, WB_WLR = WB_WG + (size_t)2048 * 1024 * 2, WB_PA = WB_WLR + (size_t)1536 * 256 * 2, WB_PB = WB_PA + (size_t)1024 * 512 * 2,
                 WB_WMO = WB_PB + 2 * MiB, WB_WQ = WB_WMO + 2 * MiB, WB_WK = WB_WQ + 2 * MiB, WB_WV = WB_WK + 2 * MiB, WB_WO = WB_WV + 2 * MiB, WB_END = WB_WO + 2 * MiB;
static_assert(WB_END <= 62 * MiB, "weights region");
static_assert(pg8::H16_OFF == 127 * MiB && pg8::RSQ_OFF == 255 * MiB, "EpiResid offsets");
constexpr size_t WS_MEMN = 63 * MiB, WS_KM = 79 * MiB, WS_VTM = 95 * MiB, WS_COS = 111 * MiB, WS_SIN = 119 * MiB, WS_XN = 127 * MiB, WS_RSQ = 255 * MiB, WS_AR = 259 * MiB;
constexpr size_t AR_ZA = 0, AR_YS = 192 * MiB, AR_ALR = 224 * MiB, AR_WAG = 256 * MiB, AR_PAO = 448 * MiB, AR_ST = 641 * MiB, AR_YA = 645 * MiB, AR_END = 709 * MiB;
constexpr size_t AR_ZB = 0, AR_YB = 384 * MiB, AR_TMPA = 0, AR_TMPB = 128 * MiB, AR_MRG = 256 * MiB, AR_Q = 0, AR_O = 128 * MiB, AR_ACT = 0;
constexpr size_t WS_END = WS_AR + AR_END;
constexpr int CW_BAR = 4096;
constexpr int LDS_BYTES = 163840, LDSCTL_OFF = LDS_BYTES - 256, LDS_RS_OFF = 131072;

__constant__ float c_invfreq[32] = {
    1.0f, 0.7498942093324559f, 0.5623413251903491f, 0.4216965034285822f, 0.31622776601683794f, 0.23713737056616552f, 0.1778279410038923f, 0.1333521432163324f,
    0.1f, 0.07498942093324559f, 0.05623413251903491f, 0.04216965034285822f, 0.031622776601683794f, 0.023713737056616552f, 0.01778279410038923f, 0.01333521432163324f,
    0.01f, 0.007498942093324559f, 0.005623413251903491f, 0.004216965034285822f, 0.0031622776601683794f, 0.0023713737056616554f, 0.001778279410038923f, 0.001333521432163324f,
    0.001f, 0.0007498942093324559f, 0.0005623413251903491f, 0.0004216965034285822f, 0.00031622776601683794f, 0.00023713737056616554f, 0.0001778279410038923f, 0.0001333521432163324f };

#define XB_TMO      128
#define XB_XCNT(j)  (256  + 64 * (j))
#define XB_XSUB(j)  (1280 + 64 * (j))
#define XB_XGEN(j)  (2304 + 64 * (j))
#define XB_TOP      3328
#define XB_TOPGEN   3392
#define XCD_BAR_WORDS 3456
#define XB_SPIN_CAP (1u << 18)
__device__ __forceinline__ unsigned xb_ld(unsigned* p)              { return __hip_atomic_load(p, __ATOMIC_RELAXED, __HIP_MEMORY_SCOPE_AGENT); }
__device__ __forceinline__ unsigned xb_add(unsigned* p, unsigned v) { return __hip_atomic_fetch_add(p, v, __ATOMIC_RELAXED, __HIP_MEMORY_SCOPE_AGENT); }
__device__ __forceinline__ unsigned xb_xcc_id() { return (unsigned)__builtin_amdgcn_s_getreg((3 << 11) | 20) & 0xFu; }
#define XB_SPIN(cond, bar) do { unsigned _sp = 0; while (cond) { __builtin_amdgcn_s_sleep(1); \
    if ((++_sp & 255u) == 0u) { if (xb_ld(&(bar)[XB_TMO])) break; if (_sp > XB_SPIN_CAP) { atomicAdd(&(bar)[XB_TMO], 1u); break; } } } } while (0)
struct XcdBarrier { unsigned* bar; unsigned x; volatile LAS unsigned* st; };
__device__ __forceinline__ XcdBarrier xcd_barrier_post(unsigned* bar, volatile LAS unsigned* st) {
    XcdBarrier b; b.bar = bar; b.x = xb_xcc_id(); b.st = st;
    if (threadIdx.x == 0) (void)xb_add(&bar[XB_XCNT(b.x)], 1u);
    return b;
}
__device__ __forceinline__ void xcd_barrier_complete(unsigned* bar, unsigned x, unsigned& nloc, unsigned& nx) {
    const unsigned G = gridDim.x * gridDim.y * gridDim.z;
    unsigned sum, cnt, mine, sp = 0u;
    for (;;) {
        sum = 0u; cnt = 0u; mine = 0u;
#pragma unroll
        for (unsigned j = 0; j < 16; ++j) { const unsigned c = xb_ld(&bar[XB_XCNT(j)]); sum += c; cnt += (c > 0u) ? 1u : 0u; mine = (j == x) ? c : mine; }
        if (sum == G) break;
        __builtin_amdgcn_s_sleep(1);
        if ((++sp & 255u) == 0u) { if (xb_ld(&bar[XB_TMO])) break; if (sp > XB_SPIN_CAP) { atomicAdd(&bar[XB_TMO], 1u); break; } }
    }
    nloc = mine > 0u ? mine : 1u; nx = cnt > 0u ? cnt : 1u;
}
__device__ __forceinline__ void xcd_barrier(const XcdBarrier& b) {
    asm volatile("s_waitcnt vmcnt(0)" ::: "memory");
    __syncthreads();
    if (threadIdx.x == 0) {
        unsigned* bar = b.bar;
        __builtin_amdgcn_s_waitcnt(0);
        unsigned nloc = b.st[0], nx = b.st[1];
        if (nloc == 0u) { xcd_barrier_complete(bar, b.x, nloc, nx); b.st[0] = nloc; b.st[1] = nx; }
        const unsigned old = xb_add(&bar[XB_XSUB(b.x)], 1u);
        const unsigned gen = old / nloc;
        if (old + 1u == (gen + 1u) * nloc) {
            __builtin_amdgcn_fence(__ATOMIC_RELEASE, "agent");
            asm volatile("s_waitcnt vmcnt(0)" ::: "memory");
            const unsigned og = xb_add(&bar[XB_TOP], 1u);
            const unsigned tg = og / nx;
            if (og + 1u == (tg + 1u) * nx) xb_add(&bar[XB_TOPGEN], 1u);
            else XB_SPIN(xb_ld(&bar[XB_TOPGEN]) == tg, bar);
            __builtin_amdgcn_fence(__ATOMIC_ACQUIRE, "agent");
            xb_add(&bar[XB_XGEN(b.x)], 1u);
            asm volatile("s_waitcnt vmcnt(0)" ::: "memory");
        } else {
            XB_SPIN(xb_ld(&bar[XB_XGEN(b.x)]) == gen, bar);
            __builtin_amdgcn_fence(__ATOMIC_ACQUIRE, "agent");
            asm volatile("s_waitcnt vmcnt(0)" ::: "memory");
        }
    }
    __syncthreads();
}

struct Args { const void* in[27]; float* out; unsigned char* ws; int pad0, pad1; };
#define KBASE() const CAS char* kbase_ = (const CAS char*)__builtin_amdgcn_kernarg_segment_ptr(); asm volatile("" : "+s"(kbase_))
#define KARG(k) (*(void* const CAS*)(kbase_ + 8 * (k)))
struct Frame { LAS unsigned char* lds; int G; };
#define PHASE_IDS() KBASE(); const int tid = fresh_tid(), lane = tid & 63, wave = __builtin_amdgcn_readfirstlane(tid >> 6), gw = (int)blockIdx.x * NWAVES + wave, NGW = F.G * NWAVES; (void)lane; (void)gw; (void)NGW
#define LDS_WAIT() asm volatile("s_waitcnt lgkmcnt(0)" ::: "memory")
#define LDS_BARRIER() do { asm volatile("s_waitcnt lgkmcnt(0)" ::: "memory"); __builtin_amdgcn_s_barrier(); asm volatile("" ::: "memory"); } while (0)

__device__ __forceinline__ void conv_matrix(const Frame& F, const float* W, int ldw, int coff, int K, int N, u16* WT, int mode, int NH, const float* gain) {
    for (int rep = 0; rep < REP_CONV; ++rep) {
    PHASE_IDS();
    LAS float* scr = (LAS float*)(F.lds + wave * 8448);
    const int nblk = N / 32, nitems = (K / 64) * nblk;
    for (int item = gw; item < nitems; item += NGW) {
        const int kb = item / nblk, nb = item % nblk, k0 = 64 * kb, n0 = 32 * nb;
        int d0 = n0;
        if (mode == 1) { d0 = (n0 < NH) ? (n0 / 128) * 256 + (n0 % 128) : ((n0 - NH) / 128) * 256 + 128 + ((n0 - NH) % 128); }
#pragma unroll
        for (int i = 0; i < 8; ++i) { const int kk = 8 * i + (lane >> 3), n4 = 4 * (lane & 7);
            f32x4 w4 = *(const f32x4*)(W + (size_t)(k0 + kk) * ldw + coff + n0 + n4); if (gain) w4 = w4 * gain[k0 + kk];
            scr[kk * 33 + n4] = w4[0]; scr[kk * 33 + n4 + 1] = w4[1]; scr[kk * 33 + n4 + 2] = w4[2]; scr[kk * 33 + n4 + 3] = w4[3]; }
        LDS_WAIT(); asm volatile("" ::: "memory");
        const int c = lane & 7;
#pragma unroll
        for (int j = 0; j < 4; ++j) { const int n = (lane >> 3) + 8 * j; const LAS float* s = scr + (8 * c) * 33 + n;
            u32x4 o; o.x = pk2b(s[0 * 33], s[1 * 33]); o.y = pk2b(s[2 * 33], s[3 * 33]); o.z = pk2b(s[4 * 33], s[5 * 33]); o.w = pk2b(s[6 * 33], s[7 * 33]);
            *(u32x4*)(WT + pg8::blk32(d0 + n, k0 + 8 * c, K)) = o; }
        LDS_WAIT(); asm volatile("" ::: "memory");
    }
    }
}
__device__ __forceinline__ void rms_row_h(const float* xrow, const float* g, u16* obase, int row, int lane) {
    const f32x4* xr = (const f32x4*)xrow + lane; const f32x4* gr = (const f32x4*)g + lane;
    f32x4 v[4]; float s = 0.f;
#pragma unroll
    for (int j = 0; j < 4; ++j) { v[j] = xr[64 * j]; s += (v[j].x * v[j].x + v[j].y * v[j].y) + (v[j].z * v[j].z + v[j].w * v[j].w); }
    const float r = __builtin_amdgcn_rsqf(wave_sum(s) * (1.f / D) + 1e-6f);
#pragma unroll
    for (int j = 0; j < 4; ++j) { const f32x4 gg = gr[64 * j]; u32x2 w; w.x = pk2b(v[j].x * r * gg.x, v[j].y * r * gg.y); w.y = pk2b(v[j].z * r * gg.z, v[j].w * r * gg.w); *(u32x2*)(obase + pg8::blk32(row, 4 * lane + 256 * j, D)) = w; }
}
__device__ __forceinline__ void rms_phase(const Frame& F, const float* src, const float* g, u16* dst, int rows) {
    for (int rep = 0; rep < REP_RMS; ++rep) {
    PHASE_IDS();
    for (int m = gw; m < rows; m += NGW) rms_row_h(src + (size_t)m * D, g, dst, m, lane);
    }
}


typedef float f32x8 __attribute__((ext_vector_type(8)));
typedef float f32x16 __attribute__((ext_vector_type(16)));
#define SLOAD8(dst, base, off) asm volatile("s_load_dwordx8 %0, %1, " #off : "=s"(dst) : "s"(base))
#define SLOAD16(dst, base, off) asm volatile("s_load_dwordx16 %0, %1, " #off : "=s"(dst) : "s"(base))
__device__ __forceinline__ int rsv_index(int row) { const int pm = row >> 8, R = row & 255; return ((pm * 2 + ((R >> 6) & 1)) * 16 + (R & 15)) * 8 + (R >> 7) * 4 + ((R >> 4) & 3); }
#define RS_PASS() do { KBASE(); for (int m_ = (int)blockIdx.x * (NWAVES * 64) + fresh_tid(); m_ < M; m_ += F.G * NWAVES * 64) { const f32x4* p_ = (const f32x4*)(RSQ + (size_t)m_ * 16); \
        const f32x4 a_ = p_[0], b_ = p_[1], c_ = p_[2], d_ = p_[3]; const f32x4 t_ = (a_ + b_) + (c_ + d_); \
        RSV[rsv_index(m_)] = __builtin_amdgcn_rsqf(((t_[0] + t_[1]) + (t_[2] + t_[3])) * (1.0f / 1024.0f) + 1e-6f); } } while (0)
__device__ __forceinline__ size_t za_idx(int m, int col) { return (size_t)(col >> 8) * ((size_t)M * 256) + (size_t)m * 256 + (col & 255); }


#define x_in        ((const float*)KARG(0))
#define mem_in      ((const float*)KARG(1))
#define pos_in      ((const int*)KARG(2))
#define norm_g      ((const float*)KARG(3))
#define ffn_w_in    ((const float*)KARG(4))
#define ffn_w_out   ((const float*)KARG(5))
#define mix_w_in    ((const float*)KARG(6))
#define mix_gate_b  ((const float*)KARG(7))
#define shift_mu    ((const float*)KARG(8))
#define a_w0        ((const float*)KARG(9))
#define a_w_up      ((const float*)KARG(10))
#define a_a0        ((const float*)KARG(11))
#define a_a_up      ((const float*)KARG(12))
#define a_g_up      ((const float*)KARG(13))
#define a_k_k       ((const float*)KARG(14))
#define a_k_a       ((const float*)KARG(15))
#define a_r_k       ((const float*)KARG(16))
#define a_ln        ((const float*)KARG(17))
#define b_gn        ((const float*)KARG(18))
#define w_branch_a  ((const float*)KARG(19))
#define w_branch_b  ((const float*)KARG(20))
#define mix_w_out   ((const float*)KARG(21))
#define mem_norm    ((const float*)KARG(22))
#define cross_w_q   ((const float*)KARG(23))
#define cross_w_kv  ((const float*)KARG(24))
#define cross_w_o   ((const float*)KARG(25))
#define final_norm  ((const float*)KARG(26))
#define WSP(TY, off) ((TY*)((unsigned char*)KARG(28) + (off)))
#define W_in_t  WSP(u16, WS_WB + WB_WIN)
#define W_out_t WSP(u16, WS_WB + WB_WOUT)
#define W_A_t   WSP(u16, WS_WB + WB_WA)
#define W_B_t   WSP(u16, WS_WB + WB_WBM)
#define W_G_t   WSP(u16, WS_WB + WB_WG)
#define W_LR_t  WSP(u16, WS_WB + WB_WLR)
#define P_A_t   WSP(u16, WS_WB + WB_PA)
#define P_B_t   WSP(u16, WS_WB + WB_PB)
#define W_MO_t  WSP(u16, WS_WB + WB_WMO)
#define W_Q_t   WSP(u16, WS_WB + WB_WQ)
#define W_K_t   WSP(u16, WS_WB + WB_WK)
#define W_V_t   WSP(u16, WS_WB + WB_WV)
#define W_O_t   WSP(u16, WS_WB + WB_WO)
#define MEMN    WSP(u16, WS_MEMN)
#define KM      WSP(u16, WS_KM)
#define VTM     WSP(u16, WS_VTM)
#define COS     WSP(float, WS_COS)
#define SIN     WSP(float, WS_SIN)
#define H16     WSP(u16, WS_XN)
#define YS      WSP(u16, WS_AR + AR_YS)
#define RSQ     WSP(float, WS_RSQ)
#define RSV     WSP(float, WS_CTL + 512 * 1024)
#define ZA      WSP(u16, WS_AR + AR_ZA)
#define ALR     WSP(u16, WS_AR + AR_ALR)
#define WAG     WSP(u16, WS_AR + AR_WAG)
#define YA      WSP(u16, WS_AR + AR_YA)
#define ZB      WSP(u16, WS_AR + AR_ZB)
#define YB      WSP(u16, WS_AR + AR_YB)
#define TMPA    WSP(u16, WS_AR + AR_TMPA)
#define TMPB    WSP(u16, WS_AR + AR_TMPB)
#define MRG     WSP(u16, WS_AR + AR_MRG)
#define QX      WSP(u16, WS_AR + AR_Q)
#define OX      WSP(u16, WS_AR + AR_O)
#define ACT     WSP(u16, WS_AR + AR_ACT)
#define H       ((float*)KARG(27))

__global__ void __launch_bounds__(NWAVES * 64, 2) fwd_kernel(Args args) {
    extern __shared__ __attribute__((aligned(16))) unsigned char lds_raw[];
    Frame F;
    F.lds = (LAS unsigned char*)lds_raw;
    F.G = gridDim.x;
    volatile LAS unsigned* MISC = (volatile LAS unsigned*)(F.lds + LDSCTL_OFF);
    for (int u = threadIdx.x; u < 64; u += NWAVES * 64) MISC[u] = 0u;
    __syncthreads();
    XcdBarrier bar; { KBASE(); bar = xcd_barrier_post((unsigned*)((unsigned char*)KARG(28) + WS_CTL) + CW_BAR, MISC + 8); }
#define GRID_BAR() do { for (int rb_ = 0; rb_ < REP_BAR; ++rb_) xcd_barrier(bar); } while (0)


    { KBASE();
    for (int i = blockIdx.x * (NWAVES * 64) + threadIdx.x; i < M * 32; i += F.G * NWAVES * 64) {
        const int m = i >> 5, f = i & 31;
        const double a = (double)pos_in[m] * (double)c_invfreq[f] * 0.15915494309189535;
        const float fr = (float)(a - __builtin_rint(a));
        COS[i] = __builtin_amdgcn_cosf(fr); SIN[i] = __builtin_amdgcn_sinf(fr);
    }
    }

    {
        PHASE_IDS();
        for (int m = gw; m < M; m += NGW) {
            const f32x4* xr = (const f32x4*)(x_in + (size_t)m * D) + lane; float sq = 0.f;
#pragma unroll
            for (int j = 0; j < 4; ++j) { const f32x4 v = xr[64 * j]; sq += (v.x * v.x + v.y * v.y) + (v.z * v.z + v.w * v.w); u32x2 w; w.x = pk2b(v.x, v.y); w.y = pk2b(v.z, v.w); *(u32x2*)(H16 + pg8::blk32(m, 4 * lane + 256 * j, D)) = w; }
            sq = wave_sum(sq);
            if (lane < 16) RSQ[(size_t)m * 16 + lane] = (lane == 0) ? sq : 0.f;
        }
    }
    for (int l = 0; l < DEPTH; ++l) {
        { KBASE();
            for (int s = 0; s < 2; ++s) {
                conv_matrix(F, ffn_w_in + ((size_t)l * 2 + s) * D * 2 * DFF, 2 * DFF, 0, D, 2 * DFF, W_in_t + (size_t)s * 5632 * 1024, 1, DFF, norm_g + ((size_t)l * 4 + 3 * s) * D);
                conv_matrix(F, ffn_w_out + ((size_t)l * 2 + s) * DFF * D, D, 0, DFF, D, W_out_t + (size_t)s * 1024 * 2816, 0, 0, nullptr);
            }
            const float* mw = mix_w_in + (size_t)l * D * INW;
            conv_matrix(F, mw, INW, 0, D, 1792, W_A_t, 0, 0, norm_g + ((size_t)l * 4 + 1) * D);
            conv_matrix(F, mw, INW, 1792, D, 3072, W_B_t, 0, 0, norm_g + ((size_t)l * 4 + 1) * D);
            conv_matrix(F, mw, INW, 4864, D, 2048, W_G_t, 1, 1024, norm_g + ((size_t)l * 4 + 1) * D);
            conv_matrix(F, w_branch_a + (size_t)l * AW * D, D, 0, AW, D, P_A_t, 0, 0, nullptr);
            conv_matrix(F, w_branch_b + (size_t)l * D * D, D, 0, D, D, P_B_t, 0, 0, nullptr);
            conv_matrix(F, mix_w_out + (size_t)l * D * D, D, 0, D, D, W_MO_t, 0, 0, nullptr);
            conv_matrix(F, cross_w_q + (size_t)l * D * D, D, 0, D, D, W_Q_t, 0, 0, norm_g + ((size_t)l * 4 + 2) * D);
            conv_matrix(F, cross_w_kv + (size_t)l * D * 2 * D, 2 * D, 0, D, D, W_K_t, 0, 0, nullptr);
            conv_matrix(F, cross_w_kv + (size_t)l * D * 2 * D, 2 * D, D, D, D, W_V_t, 0, 0, nullptr);
            conv_matrix(F, cross_w_o + (size_t)l * D * D, D, 0, D, D, W_O_t, 0, 0, nullptr);
            for (int i = blockIdx.x * (NWAVES * 64) + fresh_tid(); i < 1536 * 128; i += F.G * NWAVES * 64) {
                const int n = i >> 7, k = i & 127; float v = 0.f;
                if (n < 512) { if (k < 64) v = a_w_up[((size_t)l * 64 + k) * 512 + n]; }
                else if (n < 1024) { if (k >= 64) v = a_a_up[((size_t)l * 64 + (k - 64)) * 512 + (n - 512)]; }
                else v = a_g_up[((size_t)l * 128 + k) * 512 + (n - 1024)];
                W_LR_t[pg8::blk32(n, k, 128)] = f2b(v);
            }
            rms_phase(F, mem_in, mem_norm + (size_t)l * D, MEMN, MM);
        }
        GRID_BAR();
        {
            { KBASE(); pg8::Gemm g{H16, W_in_t, M, 2 * DFF, D}; pg8::StaticOrder S; S.init(M, 2 * DFF, F.G, (int)blockIdx.x); pg8::EpiSwiglu E{ACT, DFF, RSQ};
              for (int rep = 0; rep < REPG(0); ++rep) pg8::gemm_phase<true, true>(F.lds, g, S, E); }
            { KBASE(); pg8::Gemm g{MEMN, W_K_t, MM, D, D}; pg8::StaticOrder S; S.init(MM, D, F.G, (int)blockIdx.x); pg8::EpiStoreH<false> E{KM, D, 0, 0, nullptr};
              for (int rep = 0; rep < REPG(1); ++rep) pg8::gemm_phase<true, true>(F.lds, g, S, E); }
            { KBASE(); pg8::Gemm g{W_V_t, MEMN, D, MM, D}; pg8::StaticOrder S; S.init(D, MM, F.G, (int)((blockIdx.x + 128) % F.G)); pg8::EpiStoreH<false> E{VTM, MM, 0, 0, nullptr};
              for (int rep = 0; rep < REPG(2); ++rep) pg8::gemm_phase<true, true>(F.lds, g, S, E); }
        }
        GRID_BAR();
        { KBASE(); pg8::Gemm g{ACT, W_out_t, M, D, DFF}; pg8::StaticOrder S; S.init(M, D, F.G, (int)blockIdx.x); pg8::EpiResid E{(unsigned char*)KARG(28), 0.5f};
          pg8::gemm_phase<true, true>(F.lds, g, S, E); }
        GRID_BAR();
        { KBASE(); pg8::Gemm g{H16, W_A_t, M, 1792, D}; pg8::StaticOrder S; S.init(M, 1792, F.G, (int)blockIdx.x); pg8::EpiStoreH<true> E{ZA, 256, 256, (size_t)M * 256, RSQ};
          for (int rep = 0; rep < REPG(3); ++rep) pg8::gemm_phase<true, true>(F.lds, g, S, E); }
        GRID_BAR();
        {
            PHASE_IDS();
            const u16* T6 = ZA + (size_t)6 * M * 256; const float* mu = shift_mu + (size_t)l * 1792 + 1536;
            for (int m = gw; m < M; m += NGW) {
                const int c0 = 4 * lane; const bool first = (m % T) == 0;
                const u32x2 zc = *(const u32x2*)(T6 + pg8::blk32(m, c0, 256));
                u32x2 zp = {0u, 0u}; if (!first) zp = *(const u32x2*)(T6 + pg8::blk32(m - 1, c0, 256));
                const f32x4 mm = *(const f32x4*)(mu + c0);
                float v[4] = {hlo(zc.x), hhi(zc.x), hlo(zc.y), hhi(zc.y)}; const float p[4] = {hlo(zp.x), hhi(zp.x), hlo(zp.y), hhi(zp.y)};
#pragma unroll
                for (int j = 0; j < 4; ++j) { float s = v[j] + (p[j] - v[j]) * mm[j];
                    if (c0 < 64) { const float e = __builtin_amdgcn_exp2f(2.88539008178f * s); s = 1.0f - 2.0f * __builtin_amdgcn_rcpf(1.0f + e); }
                    else if (c0 >= 128) s = fsigmoid(s);
                    v[j] = s; }
                u32x2 o; o.x = pk2b(v[0], v[1]); o.y = pk2b(v[2], v[3]);
                *(u32x2*)(ALR + pg8::blk32(m, c0, 256)) = o;
            }
        }
        GRID_BAR();
        { KBASE(); pg8::Gemm g{ALR, W_LR_t, M, 1536, 128, 256, 4, 8192u}; pg8::StaticOrder S; S.init(M, 1536, F.G, (int)blockIdx.x); pg8::EpiStoreH<false> E{WAG, 1536, 0, 0, nullptr};
          for (int rep = 0; rep < REPG(4); ++rep) pg8::gemm_phase<true, true>(F.lds, g, S, E); }
        GRID_BAR();
        {
            for (int rep = 0; rep < REP_PA; ++rep) {
                PHASE_IDS();
                const int fr_o = lane & 15, fq_o = lane >> 4;
                LAS u16* Bh = (LAS u16*)F.lds;  LAS u16* Kh = Bh + 32 * 72; LAS u16* Kt = Kh + 32 * 72; LAS u16* Rt = Kt + 32 * 72;
                LAS u16* Ktx = Rt + 32 * 72;    LAS u16* Rx = Ktx + 32 * 72;
                LAS u16* Bg = Rx + 32 * 72;     LAS u16* Vr = Bg + 32 * 72; LAS u16* Kg = Vr + 32 * 72;
                LAS u16* AbrT = Kg + 32 * 72;   LAS u16* AkkT = AbrT + 32 * 40; LAS u16* AkrT = AkkT + 32 * 40;
                LAS float* ATt = (LAS float*)(F.lds + 49152);
                LAS float* Uf = (LAS float*)(F.lds + 53760);
                LAS u16* Zh = (LAS u16*)(F.lds + 62976);
                LAS float* YL = (LAS float*)(F.lds + 68096);
                LAS u16* Sh = (LAS u16*)(F.lds + 76800);
                LAS float* Lgrp = (LAS float*)(F.lds + 86016);
                LAS float* PRE = (LAS float*)(F.lds + 88064);
                LAS float* CMl = (LAS float*)(F.lds + 92160);
                LAS float* CMIl = CMl + 128; LAS float* CEl = CMIl + 128;
                for (int bh = blockIdx.x; bh < NBATCH * 8; bh += F.G) {
                    const int b = bh >> 3, h = bh & 7, row4 = lane >> 4, tt = 4 * wave + row4, j0 = 4 * (lane & 15), col0 = 64 * h + j0;
                    const u16* zrp = ZA + (size_t)(col0 >> 8) * M * 256; const u16* zkp = zrp + (size_t)2 * M * 256; const u16* zvp = zrp + (size_t)4 * M * 256;
                    u32x2 nzr[2], nzk[2], nzv[2], nwd, nad, ngd;
#define PA_LOAD(cc_) do { const int t1_ = CH * (cc_) + tt; int m1_ = b * T + t1_; asm volatile("" : "+v"(m1_)); \
        const size_t zb_ = pg8::blk32(m1_, col0 & 255, 256), zp_ = (m1_ & 31) ? zb_ - 32 : zb_ - 8 * 1024 + 31 * 32;     \
        const bool ok_ = t1_ > 0; const u32x2 z0_ = {0u, 0u}; \
        nzr[0] = ok_ ? *(const u32x2*)(zrp + zp_) : z0_; nzk[0] = ok_ ? *(const u32x2*)(zkp + zp_) : z0_; nzv[0] = ok_ ? *(const u32x2*)(zvp + zp_) : z0_; \
        nzr[1] = *(const u32x2*)(zrp + zb_); nzk[1] = *(const u32x2*)(zkp + zb_); nzv[1] = *(const u32x2*)(zvp + zb_); \
        const size_t wb_ = pg8::blk32(m1_, col0, 1536); \
        nwd = *(const u32x2*)(WAG + wb_); nad = *(const u32x2*)(WAG + wb_ + (size_t)16 * 1024); ngd = *(const u32x2*)(WAG + wb_ + (size_t)32 * 1024); } while (0)
                    float lw[4], bb[4], kp[4], rr[4], vv[4], kq[4], c[4]; f32x4 cvn, ggn, cvc = {0.f, 0.f, 0.f, 0.f}, ggc = {0.f, 0.f, 0.f, 0.f};
                    const float* mu = shift_mu + (size_t)l * 1792;
                    const f32x4 mur = *(const f32x4*)(mu + col0), muk = *(const f32x4*)(mu + 512 + col0), muv = *(const f32x4*)(mu + 1024 + col0);
                    const f32x4 w0c = *(const f32x4*)(a_w0 + (size_t)l * 512 + col0), a0c = *(const f32x4*)(a_a0 + (size_t)l * 512 + col0);
                    const f32x4 kkc = *(const f32x4*)(a_k_k + (size_t)l * 512 + col0), kac = *(const f32x4*)(a_k_a + (size_t)l * 512 + col0), rkc = *(const f32x4*)(a_r_k + (size_t)l * 512 + col0);
                    const f32x4 ln0 = *(const f32x4*)(a_ln + ((size_t)l * 2 + 0) * 512 + col0), ln1 = *(const f32x4*)(a_ln + ((size_t)l * 2 + 1) * 512 + col0);
#define PA_UNPK(dst_, w_) do { dst_[0] = hlo((w_).x); dst_[1] = hhi((w_).x); dst_[2] = hlo((w_).y); dst_[3] = hhi((w_).y); } while (0)
#define PA_FIRST() do { \
        float zr0[4], zr1[4], zk0[4], zk1[4], zv0[4], zv1[4], wd_[4], ad_[4], gd_[4], kx_[4], a_[4], kk_[4]; \
        PA_UNPK(zr0, nzr[0]); PA_UNPK(zr1, nzr[1]); PA_UNPK(zk0, nzk[0]); PA_UNPK(zk1, nzk[1]); PA_UNPK(zv0, nzv[0]); PA_UNPK(zv1, nzv[1]); PA_UNPK(wd_, nwd); PA_UNPK(ad_, nad); PA_UNPK(gd_, ngd); \
        float ss_ = 0.f; \
        _Pragma("unroll") for (int i = 0; i < 4; ++i) { \
            rr[i] = zr1[i] + (zr0[i] - zr1[i]) * mur[i]; kx_[i] = zk1[i] + (zk0[i] - zk1[i]) * muk[i]; vv[i] = zv1[i] + (zv0[i] - zv1[i]) * muv[i]; \
            a_[i] = fsigmoid(a0c[i] + ad_[i]); \
            lw[i] = -0.60653065971f * 1.44269504089f * fsigmoid(w0c[i] + wd_[i]);            \
            kk_[i] = kx_[i] * kkc[i]; ss_ = fmaf(kk_[i], kk_[i], ss_); } \
        const float inv_ = __builtin_amdgcn_rsqf(fmaxf(sum16(ss_), 1e-24f)); float cs_ = 0.f; \
        _Pragma("unroll") for (int i = 0; i < 4; ++i) { kq[i] = kk_[i] * inv_; bb[i] = kq[i] * a_[i]; kp[i] = kx_[i] * (1.0f + (a_[i] - 1.0f) * kac[i]); cs_ = fmaf(rr[i] * kp[i], rkc[i], cs_); } \
        cs_ = sum16(cs_); f32x4 tot_; \
        _Pragma("unroll") for (int i = 0; i < 4; ++i) { cvn[i] = cs_ * vv[i]; ggn[i] = gd_[i];       \
            const float s_ = xsum16(lw[i]), t_ = xsum32(s_), p_ = (row4 & 1) ? s_ : lw[i];            \
            c[i] = (row4 >= 2) ? p_ + (t_ - s_) : p_; tot_[i] = t_; } \
        if (lane < 16) *(LAS f32x4*)(Lgrp + wave * 64 + j0) = tot_; } while (0)
#define PA_HELPER(par_) do { float pre_ = 0.f, Lmid_ = 0.f, Lend_ = 0.f; \
        _Pragma("unroll") for (int g2 = 0; g2 < 8; ++g2) { const float x = Lgrp[g2 * 64 + lane]; if (g2 < wave) pre_ += x; if (g2 < 4) Lmid_ += x; Lend_ += x; } \
        PRE[(par_) * 512 + wave * 64 + lane] = pre_; \
        if (wave == 0) { CMl[(par_) * 64 + lane] = __builtin_amdgcn_exp2f(-Lmid_); CMIl[(par_) * 64 + lane] = __builtin_amdgcn_exp2f(Lmid_); CEl[(par_) * 64 + lane] = __builtin_amdgcn_exp2f(Lend_); } } while (0)
                    PA_LOAD(0);
                    for (int e = tid; e < 64 * 72; e += NWAVES * 64) Sh[e] = 0;
                    f32x4 Sreg[2] = {{0.f, 0.f, 0.f, 0.f}, {0.f, 0.f, 0.f, 0.f}};
                    PA_FIRST();
                    LDS_BARRIER();
                    PA_HELPER(0);
                    LDS_BARRIER();
                    for (int cc = 0; cc < NCH; ++cc) {
                        int fr = fr_o, fq = fq_o; asm volatile("" : "+v"(fr), "+v"(fq));
                        const int ib = wave >> 1, hb = wave & 1, par = cc & 1;
                        {
                            cvc = cvn; ggc = ggn;
                            if (cc + 1 < NCH) PA_LOAD(cc + 1);
                            const f32x4 pre4 = *(const LAS f32x4*)(PRE + par * 512 + wave * 64 + j0), cM4 = *(const LAS f32x4*)(CMl + par * 64 + j0), cMi4 = *(const LAS f32x4*)(CMIl + par * 64 + j0), cE4 = *(const LAS f32x4*)(CEl + par * 64 + j0);
                            float x1[4], x2[4], x3[4], x4[4], x5[4], x6[4], xg[4], xk[4];
#pragma unroll
                            for (int i = 0; i < 4; ++i) { const float L = pre4[i] + c[i];
                                const float e5 = __builtin_amdgcn_exp2f(L), e4 = __builtin_amdgcn_exp2f(L - lw[i]), r5 = __builtin_amdgcn_rcpf(e5);
                                const float e3 = e5 * cM4[i], e2 = e4 * cM4[i], e1 = fminf(cMi4[i] * r5, 8192.f), e6 = cE4[i] * r5;
                                x1[i] = bb[i] * e1; x2[i] = kp[i] * e1; x3[i] = kq[i] * e2; x4[i] = rr[i] * e3; x5[i] = kq[i] * e4; x6[i] = rr[i] * e5; xg[i] = bb[i] * e6; xk[i] = kp[i] * e6; }
                            const int io = tt * 72 + j0; u32x2 w;
                            w.x = pk2(x1[0], x1[1]); w.y = pk2(x1[2], x1[3]); *(LAS u32x2*)(Bh + io) = w;
                            w.x = pk2(x2[0], x2[1]); w.y = pk2(x2[2], x2[3]); *(LAS u32x2*)(Kh + io) = w;
                            w.x = pk2(x3[0], x3[1]); w.y = pk2(x3[2], x3[3]); *(LAS u32x2*)(Kt + io) = w;
                            w.x = pk2(x4[0], x4[1]); w.y = pk2(x4[2], x4[3]); *(LAS u32x2*)(Rt + io) = w;
                            w.x = pk2(x5[0], x5[1]); w.y = pk2(x5[2], x5[3]); *(LAS u32x2*)(Ktx + io) = w;
                            w.x = pk2(x6[0], x6[1]); w.y = pk2(x6[2], x6[3]); *(LAS u32x2*)(Rx + io) = w;
                            w.x = pk2(xg[0], xg[1]); w.y = pk2(xg[2], xg[3]); *(LAS u32x2*)(Bg + io) = w;
                            w.x = pk2(vv[0], vv[1]); w.y = pk2(vv[2], vv[3]); *(LAS u32x2*)(Vr + io) = w;
                            w.x = pk2(xk[0], xk[1]); w.y = pk2(xk[2], xk[3]); *(LAS u32x2*)(Kg + io) = w;
                        }
                        LDS_BARRIER();
                        f32x4 accU = {0.f, 0.f, 0.f, 0.f}, accY = {0.f, 0.f, 0.f, 0.f}, accS[2] = {{0.f, 0.f, 0.f, 0.f}, {0.f, 0.f, 0.f, 0.f}};
                        h16x8 aV;
                        {
                            const int mt = wave >> 2, sb = (wave >> 1) & 1, tb = wave & 1;
                            const LAS u16* X = mt ? Kh : Bh;
                            const h16x8 a0 = *(const LAS h16x8*)(X + (16 * sb + fr) * 72 + 8 * fq), a1 = *(const LAS h16x8*)(X + (16 * sb + fr) * 72 + 32 + 8 * fq);
                            const h16x8 k0 = *(const LAS h16x8*)(Kt + (16 * tb + fr) * 72 + 8 * fq), k1 = *(const LAS h16x8*)(Kt + (16 * tb + fr) * 72 + 32 + 8 * fq);
                            const h16x8 r0 = *(const LAS h16x8*)(Rt + (16 * tb + fr) * 72 + 8 * fq), r1 = *(const LAS h16x8*)(Rt + (16 * tb + fr) * 72 + 32 + 8 * fq);
                            const h16x8 s0 = *(const LAS h16x8*)(Sh + (16 * ib + fr) * 72 + 8 * fq), s1 = *(const LAS h16x8*)(Sh + (16 * ib + fr) * 72 + 32 + 8 * fq);
                            const h16x8 x0 = *(const LAS h16x8*)(Ktx + (16 * hb + fr) * 72 + 8 * fq), x1 = *(const LAS h16x8*)(Ktx + (16 * hb + fr) * 72 + 32 + 8 * fq);
                            const h16x8 y0 = *(const LAS h16x8*)(Rx + (16 * hb + fr) * 72 + 8 * fq), y1 = *(const LAS h16x8*)(Rx + (16 * hb + fr) * 72 + 32 + 8 * fq);
                            aV = lds_tr16(Vr, 72, 0, 16 * ib, lane);
                            const h16x8 g0 = lds_tr16(Kg, 72, 0, 16 * (2 * hb), lane), g1 = lds_tr16(Kg, 72, 0, 16 * (2 * hb + 1), lane);
                            f32x4 aK = {0.f, 0.f, 0.f, 0.f}, aR = {0.f, 0.f, 0.f, 0.f};
                            aK = MFMA16(a0, k0, aK); aK = MFMA16(a1, k1, aK); aR = MFMA16(a0, r0, aR); aR = MFMA16(a1, r1, aR);
                            accU = MFMA16(s0, x0, accU); accU = MFMA16(s1, x1, accU); accY = MFMA16(s0, y0, accY); accY = MFMA16(s1, y1, accY);
                            accS[0] = MFMA16(aV, g0, accS[0]); accS[1] = MFMA16(aV, g1, accS[1]);
                            const int t = 16 * tb + fr, s0i = 16 * sb + 4 * fq;
#pragma unroll
                            for (int rg = 0; rg < 4; ++rg) { if (s0i + rg >= t) aK[rg] = 0.f; if (s0i + rg > t) aR[rg] = 0.f; }
                            u32x2 wK, wR; wK.x = pk2(aK[0], aK[1]); wK.y = pk2(aK[2], aK[3]); wR.x = pk2(aR[0], aR[1]); wR.y = pk2(aR[2], aR[3]);
                            if (mt == 0) {
#pragma unroll
                                for (int rg = 0; rg < 4; ++rg) ATt[(s0i + rg) * 36 + t] = aK[rg];
                                *(LAS u32x2*)(AbrT + t * 40 + s0i) = wR; }
                            else { *(LAS u32x2*)(AkkT + t * 40 + s0i) = wK; *(LAS u32x2*)(AkrT + t * 40 + s0i) = wR; }
                        }
                        LDS_BARRIER();
                        {
                            const h16x8 bK = *(const LAS h16x8*)(AkkT + (16 * hb + fr) * 40 + 8 * fq), bR = *(const LAS h16x8*)(AkrT + (16 * hb + fr) * 40 + 8 * fq);
                            accU = MFMA16(aV, bK, accU); accY = MFMA16(aV, bR, accY);
#pragma unroll
                            for (int rg = 0; rg < 4; ++rg) Uf[(16 * ib + 4 * fq + rg) * 36 + 16 * hb + fr] = accU[rg];
                        }
                        LDS_BARRIER();
                        if (wave < 4) {
                            const int ri = 16 * wave + (lane >> 2), q = lane & 3;
                            f32x2 z2[4];
#pragma unroll
                            for (int k = 0; k < 2; ++k) { const f32x4 v = *(const LAS f32x4*)(Uf + ri * 36 + 16 * k + 4 * q); z2[2 * k] = (f32x2){v[0], v[1]}; z2[2 * k + 1] = (f32x2){v[2], v[3]}; }
#pragma unroll
                            for (int sx = 0; sx < 31; ++sx) {
                                f32x4 a4[2];
#pragma unroll
                                for (int k = sx >> 4; k < 2; ++k) a4[k] = *(const LAS f32x4*)(ATt + sx * 36 + 16 * k + 4 * q);
                                const float zs = quad_bcast(z2[2 * (sx >> 4) + ((sx & 3) >> 1)][sx & 1], (sx >> 2) & 3);
                                const f32x2 nz = {-zs, -zs};
#pragma unroll
                                for (int k = sx >> 4; k < 2; ++k) { z2[2 * k] = nz * (f32x2){a4[k][0], a4[k][1]} + z2[2 * k]; z2[2 * k + 1] = nz * (f32x2){a4[k][2], a4[k][3]} + z2[2 * k + 1]; }
                            }
#pragma unroll
                            for (int k = 0; k < 2; ++k) { u32x2 w; w.x = pk2(-z2[2 * k][0], -z2[2 * k][1]); w.y = pk2(-z2[2 * k + 1][0], -z2[2 * k + 1][1]); *(LAS u32x2*)(Zh + ri * 40 + 16 * k + 4 * q) = w; }
                        }
                        if (cc + 1 < NCH) PA_FIRST();
                        LDS_BARRIER();
                        {
                            const h16x8 aZ = *(const LAS h16x8*)(Zh + (16 * ib + fr) * 40 + 8 * fq);
                            const h16x8 bA = *(const LAS h16x8*)(AbrT + (16 * hb + fr) * 40 + 8 * fq);
                            const h16x8 b0 = lds_tr16(Bg, 72, 0, 16 * (2 * hb), lane), b1 = lds_tr16(Bg, 72, 0, 16 * (2 * hb + 1), lane);
                            const float gc0 = CEl[par * 64 + 16 * (2 * hb) + fr], gc1 = CEl[par * 64 + 16 * (2 * hb + 1) + fr];
                            if (cc + 1 < NCH) PA_HELPER(par ^ 1);
                            accY = MFMA16(aZ, bA, accY); accS[0] = MFMA16(aZ, b0, accS[0]); accS[1] = MFMA16(aZ, b1, accS[1]);
                            const int i0 = 16 * ib + 4 * fq;
                            *(LAS f32x4*)(YL + (16 * hb + fr) * 68 + i0) = accY;
                            Sreg[0] = Sreg[0] * gc0 + accS[0]; Sreg[1] = Sreg[1] * gc1 + accS[1];
#pragma unroll
                            for (int rg = 0; rg < 4; ++rg) { Sh[(i0 + rg) * 72 + 16 * (2 * hb) + fr] = f2h(Sreg[0][rg]); Sh[(i0 + rg) * 72 + 16 * (2 * hb + 1) + fr] = f2h(Sreg[1][rg]); }
                        }
                        LDS_BARRIER();
                        {
                            const int t = tt, i4 = j0, colo = col0;
                            const f32x4 y4 = *(const LAS f32x4*)(YL + t * 68 + i4), cv4 = cvc, g4 = ggc;
                            const float mean = sum16((y4[0] + y4[1]) + (y4[2] + y4[3])) * (1.f / 64.f); const f32x4 d4 = y4 - mean;
                            const float rstd = __builtin_amdgcn_rsqf(sum16((d4[0] * d4[0] + d4[1] * d4[1]) + (d4[2] * d4[2] + d4[3] * d4[3])) * (1.f / 64.f) + 64e-5f);
                            const f32x4 o4 = (d4 * rstd * ln0 + ln1 + cv4) * g4;
                            u32x2 w; w.x = pk2b(o4[0], o4[1]); w.y = pk2b(o4[2], o4[3]);
                            *(u32x2*)(YA + pg8::blk32(b * T + CH * cc + t, colo, 512)) = w;
                        }
                    }
                    LDS_BARRIER();
#undef PA_LOAD
#undef PA_FIRST
#undef PA_UNPK
#undef PA_HELPER
                }
            }
            GRID_BAR();
        }
        { KBASE(); pg8::Gemm g{H16, W_B_t, M, 3072, D}; pg8::StaticOrder S; S.init(M, 3072, F.G, (int)blockIdx.x); pg8::EpiStoreH<true> E{ZB, 3072, 0, 0, RSQ};
          for (int rep = 0; rep < REPG(5); ++rep) pg8::gemm_phase<true, true>(F.lds, g, S, E); }
        GRID_BAR();
        for (int rep = 0; rep < REP_RET; ++rep) {
            PHASE_IDS();
            LAS u16* Qd = (LAS u16*)(F.lds + 0);
            LAS u16* Kd = (LAS u16*)(F.lds + 18432);
            LAS u16* RTL = (LAS u16*)(F.lds + 36864);
            LAS u16* Vr = (LAS u16*)(F.lds + 72704);
            LAS u16* PL = (LAS u16*)(F.lds + 107520);
            const int fr = lane & 15, fq = lane >> 4;
            for (int bh = blockIdx.x; bh < NBATCH * 8; bh += F.G) {
                const int b = bh >> 3, h = bh & 7;
                const float lg = __builtin_log2f(1.0f - __builtin_amdgcn_exp2f(-5.0f - (float)h));
                const float gC = __builtin_amdgcn_exp2f(128.0f * lg);
                f32x4 rt[4];
#pragma unroll
                for (int i = 0; i < 4; ++i) rt[i] = (f32x4){0.f, 0.f, 0.f, 0.f};
                u32x4 nq1, nq2, nk1, nk2, nv8[4]; f32x4 nc0, nc1, ns0, ns1;
#define RET_LOAD(n_) do { const int s_ = 16 * wave + (lane >> 2), ci_ = lane & 3;     const size_t tok_ = (size_t)b * T + 128 * (n_) + s_; const u16* zp_ = ZB + pg8::blk32((int)tok_, 64 * h + 8 * ci_, 3072); \
        nq1 = *(const u32x4*)(zp_); nq2 = *(const u32x4*)(zp_ + 1024); nk1 = *(const u32x4*)(zp_ + 16 * 1024); nk2 = *(const u32x4*)(zp_ + 17 * 1024); \
        const float* cp_ = COS + tok_ * 32 + 8 * ci_; const float* sp_ = SIN + tok_ * 32 + 8 * ci_; nc0 = *(const f32x4*)cp_; nc1 = *(const f32x4*)(cp_ + 4); ns0 = *(const f32x4*)sp_; ns1 = *(const f32x4*)(sp_ + 4); \
        const u16* vp_ = ZB + pg8::blk32((int)tok_, 1024 + 128 * h + 8 * ci_, 3072); _Pragma("unroll") for (int i = 0; i < 4; ++i) nv8[i] = *(const u32x4*)(vp_ + i * 1024); } while (0)
                RET_LOAD(0);
                for (int n = 0; n < T / 128; ++n) {
                    const int m0 = b * T + 128 * n;
                    {
                        const int s = 16 * wave + (lane >> 2), ci = lane & 3;
                        const u32x4 q1 = nq1, q2 = nq2, k1 = nk1, k2 = nk2; const f32x4 c0 = nc0, c1 = nc1, s0 = ns0, s1 = ns1;
                        u32x4 cv8[4];
#pragma unroll
                        for (int i = 0; i < 4; ++i) cv8[i] = nv8[i];
                        if (n + 1 < T / 128) RET_LOAD(n + 1);
                        const float fqs = __builtin_amdgcn_exp2f((float)(s + 1) * lg), fks = 0.125f * __builtin_amdgcn_exp2f(-(float)(s + 1) * lg);
                        float qa[8], qb[8], ka[8], kbv[8];
#pragma unroll
                        for (int j = 0; j < 8; ++j) { const float cs = (j < 4) ? c0[j & 3] : c1[j & 3], sn = (j < 4) ? s0[j & 3] : s1[j & 3];
                            const float x1 = (j & 1) ? hhi(q1[j >> 1]) : hlo(q1[j >> 1]), x2 = (j & 1) ? hhi(q2[j >> 1]) : hlo(q2[j >> 1]);
                            const float y1 = (j & 1) ? hhi(k1[j >> 1]) : hlo(k1[j >> 1]), y2 = (j & 1) ? hhi(k2[j >> 1]) : hlo(k2[j >> 1]);
                            qa[j] = (x1 * cs - x2 * sn) * fqs; qb[j] = (x1 * sn + x2 * cs) * fqs; ka[j] = (y1 * cs - y2 * sn) * fks; kbv[j] = (y1 * sn + y2 * cs) * fks; }
                        u32x4 w;
                        w.x = pk2(qa[0], qa[1]); w.y = pk2(qa[2], qa[3]); w.z = pk2(qa[4], qa[5]); w.w = pk2(qa[6], qa[7]); *(LAS u32x4*)(Qd + s * 72 + 8 * ci) = w;
                        w.x = pk2(qb[0], qb[1]); w.y = pk2(qb[2], qb[3]); w.z = pk2(qb[4], qb[5]); w.w = pk2(qb[6], qb[7]); *(LAS u32x4*)(Qd + s * 72 + 32 + 8 * ci) = w;
                        w.x = pk2(ka[0], ka[1]); w.y = pk2(ka[2], ka[3]); w.z = pk2(ka[4], ka[5]); w.w = pk2(ka[6], ka[7]); *(LAS u32x4*)(Kd + s * 72 + 8 * ci) = w;
                        w.x = pk2(kbv[0], kbv[1]); w.y = pk2(kbv[2], kbv[3]); w.z = pk2(kbv[4], kbv[5]); w.w = pk2(kbv[6], kbv[7]); *(LAS u32x4*)(Kd + s * 72 + 32 + 8 * ci) = w;
#pragma unroll
                        for (int i = 0; i < 4; ++i) *(LAS u32x4*)(Vr + s * 136 + 8 * (ci + 4 * i)) = cv8[i];
#pragma unroll
                        for (int db = 0; db < 4; ++db)
#pragma unroll
                            for (int r = 0; r < 4; ++r) RTL[(16 * wave + 4 * fq + r) * 72 + 16 * db + fr] = f2h(rt[db][r]);
                    }
                    LDS_BARRIER();
                    {
                        const h16x8 bq0 = *(const LAS h16x8*)(Qd + (16 * wave + fr) * 72 + 8 * fq), bq1 = *(const LAS h16x8*)(Qd + (16 * wave + fr) * 72 + 32 + 8 * fq);
#pragma unroll
                        for (int sb = 0; sb < 8; ++sb) {
                            u32x2 pw = {0u, 0u};
                            if (sb <= wave) {
                                f32x4 acc = {0.f, 0.f, 0.f, 0.f};
                                const h16x8 a0 = *(const LAS h16x8*)(Kd + (16 * sb + fr) * 72 + 8 * fq), a1 = *(const LAS h16x8*)(Kd + (16 * sb + fr) * 72 + 32 + 8 * fq);
                                acc = MFMA16(a0, bq0, acc); acc = MFMA16(a1, bq1, acc);
                                const int cc = 16 * wave + fr, s0i = 16 * sb + 4 * fq;
#pragma unroll
                                for (int r = 0; r < 4; ++r) if (s0i + r > cc) acc[r] = 0.f;
                                pw.x = pk2(acc[0], acc[1]); pw.y = pk2(acc[2], acc[3]);
                            }
                            *(LAS u32x2*)(PL + (16 * wave + fr) * 136 + 16 * sb + 4 * fq) = pw;
                        }
                    }
                    asm volatile("" ::: "memory");
                    {
                        h16x8 pf[4], qf[2];
#pragma unroll
                        for (int ks = 0; ks < 4; ++ks) pf[ks] = *(const LAS h16x8*)(PL + (16 * wave + fr) * 136 + 32 * ks + 8 * fq);
#pragma unroll
                        for (int ks = 0; ks < 2; ++ks) qf[ks] = *(const LAS h16x8*)(Qd + (16 * wave + fr) * 72 + 32 * ks + 8 * fq);
                        f32x4 oacc[8];
#pragma unroll
                        for (int eb = 0; eb < 8; ++eb) { f32x4 acc = {0.f, 0.f, 0.f, 0.f};
#pragma unroll
                            for (int ks = 0; ks < 4; ++ks) { const h16x8 a = lds_tr16(Vr, 136, 32 * ks, 16 * eb, lane); acc = MFMA16(a, pf[ks], acc); }
#pragma unroll
                            for (int ks = 0; ks < 2; ++ks) { const h16x8 a = *(const LAS h16x8*)(RTL + (16 * eb + fr) * 72 + 32 * ks + 8 * fq); acc = MFMA16(a, qf[ks], acc); }
                            oacc[eb] = acc; }
                        float sm = 0.f;
#pragma unroll
                        for (int eb = 0; eb < 8; ++eb) sm += (oacc[eb][0] + oacc[eb][1]) + (oacc[eb][2] + oacc[eb][3]);
                        sm = xsum16(sm); sm = xsum32(sm);
                        const float mean = sm * (1.f / 128.f); float vs = 0.f;
#pragma unroll
                        for (int eb = 0; eb < 8; ++eb)
#pragma unroll
                            for (int r = 0; r < 4; ++r) { const float dd = oacc[eb][r] - mean; vs += dd * dd; }
                        vs = xsum16(vs); vs = xsum32(vs);
                        const float inv = __builtin_amdgcn_rsqf(vs * (1.f / 128.f) + 1e-5f);
                        const int m = m0 + 16 * wave + fr, eo = 16 * (fq & 1) + 8 * (fq >> 1);
                        const u16* gp = ZB + pg8::blk32(m, 2048 + 128 * h + eo, 3072); u16* yp = YB + pg8::blk32(m, 128 * h + eo, 1024);
#pragma unroll
                        for (int p = 0; p < 4; ++p) {
                            f32x4 xa = oacc[2 * p], xb = oacc[2 * p + 1];
#pragma unroll
                            for (int r = 0; r < 4; ++r) { float pa_ = xa[r], pb_ = xb[r]; pair16(pa_, pb_); xa[r] = pa_; xb[r] = pb_; }
                            const int e0 = 16 * (2 * p + (fq & 1)) + 8 * (fq >> 1);
                            const u32x4 g4 = *(const u32x4*)(gp + p * 1024);
                            const f32x4 gn0 = *(const f32x4*)(b_gn + (size_t)l * 1024 + 128 * h + e0), gn1 = *(const f32x4*)(b_gn + (size_t)l * 1024 + 128 * h + e0 + 4);
                            float o[8];
#pragma unroll
                            for (int r = 0; r < 4; ++r) { const float ga = (r & 1) ? hhi(g4[r >> 1]) : hlo(g4[r >> 1]), gb = (r & 1) ? hhi(g4[2 + (r >> 1)]) : hlo(g4[2 + (r >> 1)]);
                                o[r] = (xa[r] - mean) * inv * gn0[r] * fsilu(ga); o[4 + r] = (xb[r] - mean) * inv * gn1[r] * fsilu(gb); }
                            u32x4 w; w.x = pk2b(o[0], o[1]); w.y = pk2b(o[2], o[3]); w.z = pk2b(o[4], o[5]); w.w = pk2b(o[6], o[7]);
                            *(u32x4*)(yp + p * 1024) = w; }
                    }
                    {
#pragma unroll
                        for (int ks = 0; ks < 4; ++ks) { const h16x8 a = lds_tr16(Vr, 136, 32 * ks, 16 * wave, lane);
#pragma unroll
                            for (int db = 0; db < 4; ++db) { const h16x8 bb = lds_tr16(Kd, 72, 32 * ks, 16 * db, lane); rt[db] = MFMA16(a, bb, rt[db]); } }
#pragma unroll
                        for (int db = 0; db < 4; ++db) rt[db] = rt[db] * gC;
                    }
                    LDS_BARRIER();
                }
            }
        }
        #undef RET_LOAD
        GRID_BAR();
        {
            { KBASE(); pg8::Gemm g{YA, P_A_t, M, D, AW}; pg8::StaticOrder S; S.init(M, D, F.G, (int)blockIdx.x); pg8::EpiStoreH<false> E{TMPA, D, 0, 0, nullptr}; for (int rep = 0; rep < REPG(6); ++rep) pg8::gemm_phase<true, true>(F.lds, g, S, E); }
            { KBASE(); pg8::Gemm g{YB, P_B_t, M, D, D}; pg8::StaticOrder S; S.init(M, D, F.G, (int)blockIdx.x); pg8::EpiStoreH<false> E{TMPB, D, 0, 0, nullptr}; for (int rep = 0; rep < REPG(7); ++rep) pg8::gemm_phase<true, true>(F.lds, g, S, E); }
        }
        GRID_BAR();
        { KBASE(); pg8::Gemm g{H16, W_G_t, M, 2048, D}; pg8::StaticOrder S; S.init(M, 2048, F.G, (int)blockIdx.x);
          pg8::EpiGate E{mix_gate_b + (size_t)l * 2048, mix_gate_b + (size_t)l * 2048 + 1024, TMPA, TMPB, MRG, D, RSQ};
          for (int rep = 0; rep < REPG(8); ++rep) pg8::gemm_phase<true, true>(F.lds, g, S, E); }
        GRID_BAR();
        { KBASE(); pg8::Gemm g{MRG, W_MO_t, M, D, D}; pg8::StaticOrder S; S.init(M, D, F.G, (int)blockIdx.x); pg8::EpiResid E{(unsigned char*)KARG(28), 1.0f}; pg8::gemm_phase<true, true>(F.lds, g, S, E); }
        GRID_BAR();
        { KBASE(); pg8::Gemm g{H16, W_Q_t, M, D, D}; pg8::StaticOrder S; S.init(M, D, F.G, (int)blockIdx.x); pg8::EpiStoreH<true> E{QX, D, 0, 0, RSQ}; for (int rep = 0; rep < REPG(9); ++rep) pg8::gemm_phase<true, true>(F.lds, g, S, E); }
        GRID_BAR();
        for (int rep = 0; rep < REP_XATT; ++rep) {
            PHASE_IDS();
            LAS u16* KL = (LAS u16*)(F.lds + 0);
            LAS u16* PL = (LAS u16*)(F.lds + 69632);
            const int fr_o = lane & 15, fq_o = lane >> 4;
            const int NU = NBATCH * 4 * 16, per = (NU + F.G - 1) / F.G;
            for (int uj = 0; uj < per;) {
                const int un = (int)blockIdx.x * per + uj; if (un >= NU) break;
                const bool two = (uj + 1 < per) && (un + 1 < NU) && (((un + 1) >> 4) == (un >> 4));
                uj += two ? 2 : 1;
                int fr = fr_o, fq = fq_o, tl = tid; asm volatile("" : "+v"(fr), "+v"(fq), "+v"(tl));
                const int b = un >> 6, hx = (un >> 4) & 3, qtA = un & 15, qtB = two ? qtA + 1 : qtA;
                const int mqA = b * T + qtA * 128 + 16 * wave + fr, mqB = b * T + qtB * 128 + 16 * wave + fr;
                f32x4 sA[16], sB[16];
#pragma unroll
                for (int kb2 = 0; kb2 < 16; ++kb2) { sA[kb2] = (f32x4){0.f, 0.f, 0.f, 0.f}; sB[kb2] = (f32x4){0.f, 0.f, 0.f, 0.f}; }
#pragma unroll 1
                for (int hh = 0; hh < 2; ++hh) {
                    h16x8 qfA[4], qfB[4];
                    const u16* qpa = QX + pg8::blk32(mqA, 256 * hx + 128 * hh + 8 * fq, D); const u16* qpb = QX + pg8::blk32(mqB, 256 * hx + 128 * hh + 8 * fq, D);
#pragma unroll
                    for (int k4 = 0; k4 < 4; ++k4) { qfA[k4] = *(const h16x8*)(qpa + k4 * 1024); qfB[k4] = *(const h16x8*)(qpb + k4 * 1024); }
                    const u16* kp0 = KM + pg8::blk32(b * MEML + (tl >> 4), 256 * hx + 128 * hh + 8 * (tl & 15), D);
#pragma unroll
                    for (int i = 0; i < 8; ++i) { const int c = tl + 512 * i, row = c >> 4, cc = c & 15;
                        *(LAS u32x4*)(KL + row * 136 + 8 * cc) = *(const u32x4*)(kp0 + (size_t)i * (D / 32) * 1024); }
                    __syncthreads();
#pragma unroll
                    for (int kb2 = 0; kb2 < 16; ++kb2)
#pragma unroll
                        for (int k4 = 0; k4 < 4; ++k4) { const h16x8 a = *(const LAS h16x8*)(KL + (16 * kb2 + fr) * 136 + 32 * k4 + 8 * fq);
                            sA[kb2] = MFMA16(a, qfA[k4], sA[kb2]); sB[kb2] = MFMA16(a, qfB[k4], sB[kb2]); }
                    __syncthreads();
                }
                h16x8 pfA[8], pfB[8]; float isA, isB;
#define XA_SOFTMAX(sacc, pf, isum_) do { float mx = -3.0e38f; \
        _Pragma("unroll") for (int kb2 = 0; kb2 < 16; ++kb2) mx = fmaxf(mx, fmaxf(fmaxf(sacc[kb2][0], sacc[kb2][1]), fmaxf(sacc[kb2][2], sacc[kb2][3]))); \
        mx = xmax16(mx); mx = xmax32(mx); float sum = 0.f; const float sc = 0.0625f * 1.44269504089f; \
        _Pragma("unroll") for (int kb2 = 0; kb2 < 16; ++kb2) { float p[4]; \
            _Pragma("unroll") for (int r = 0; r < 4; ++r) { p[r] = __builtin_amdgcn_exp2f((sacc[kb2][r] - mx) * sc); sum += p[r]; } \
            u32x2 w; w.x = pk2(p[0], p[1]); w.y = pk2(p[2], p[3]); *(LAS u32x2*)(PL + (16 * wave + fr) * 264 + 16 * kb2 + 4 * fq) = w; } \
        sum = xsum16(sum); sum = xsum32(sum); isum_ = __builtin_amdgcn_rcpf(sum); \
        asm volatile("" ::: "memory"); \
        _Pragma("unroll") for (int ks = 0; ks < 8; ++ks) pf[ks] = *(const LAS h16x8*)(PL + (16 * wave + fr) * 264 + 32 * ks + 8 * fq); \
        asm volatile("" ::: "memory"); } while (0)
                XA_SOFTMAX(sA, pfA, isA);
                XA_SOFTMAX(sB, pfB, isB);
#undef XA_SOFTMAX
#pragma unroll 1
                for (int dh = 0; dh < 2; ++dh) {
                    const u16* vp0 = VTM + pg8::blk32(256 * hx + 128 * dh + (tl >> 5), b * MEML + 8 * (tl & 31), MM);
#pragma unroll
                    for (int i = 0; i < 8; ++i) { const int c = tl + 512 * i, row = c >> 5, cc = c & 31;
                        *(LAS u32x4*)(KL + row * 264 + 8 * cc) = *(const u32x4*)(vp0 + (size_t)(i >> 1) * (MM / 32) * 1024 + (i & 1) * 16 * 32); }
                    __syncthreads();
                    u16* opa = OX + pg8::blk32(mqA, 256 * hx + 128 * dh + 16 * (fq & 1) + 8 * (fq >> 1), D); u16* opb = OX + pg8::blk32(mqB, 256 * hx + 128 * dh + 16 * (fq & 1) + 8 * (fq >> 1), D);
#pragma unroll
                    for (int dp = 0; dp < 4; ++dp) {
                        f32x4 xa = {0.f, 0.f, 0.f, 0.f}, xb = {0.f, 0.f, 0.f, 0.f}, ya = {0.f, 0.f, 0.f, 0.f}, yb = {0.f, 0.f, 0.f, 0.f};
#pragma unroll
                        for (int ks = 0; ks < 8; ++ks) { const h16x8 a = *(const LAS h16x8*)(KL + (16 * (2 * dp) + fr) * 264 + 32 * ks + 8 * fq); xa = MFMA16(a, pfA[ks], xa); ya = MFMA16(a, pfB[ks], ya); }
#pragma unroll
                        for (int ks = 0; ks < 8; ++ks) { const h16x8 a = *(const LAS h16x8*)(KL + (16 * (2 * dp + 1) + fr) * 264 + 32 * ks + 8 * fq); xb = MFMA16(a, pfA[ks], xb); yb = MFMA16(a, pfB[ks], yb); }
#pragma unroll
                        for (int r = 0; r < 4; ++r) { float pa_ = xa[r], pb_ = xb[r]; pair16(pa_, pb_); xa[r] = pa_; xb[r] = pb_; float qa_ = ya[r], qb_ = yb[r]; pair16(qa_, qb_); ya[r] = qa_; yb[r] = qb_; }
                        u32x4 w; w.x = pk2b(xa[0] * isA, xa[1] * isA); w.y = pk2b(xa[2] * isA, xa[3] * isA); w.z = pk2b(xb[0] * isA, xb[1] * isA); w.w = pk2b(xb[2] * isA, xb[3] * isA);
                        *(u32x4*)(opa + dp * 1024) = w;
                        if (two) { u32x4 v; v.x = pk2b(ya[0] * isB, ya[1] * isB); v.y = pk2b(ya[2] * isB, ya[3] * isB); v.z = pk2b(yb[0] * isB, yb[1] * isB); v.w = pk2b(yb[2] * isB, yb[3] * isB);
                            *(u32x4*)(opb + dp * 1024) = v; }
                    }
                    __syncthreads();
                }
            }
        }
        GRID_BAR();
        { KBASE(); pg8::Gemm g{OX, W_O_t, M, D, D}; pg8::StaticOrder S; S.init(M, D, F.G, (int)blockIdx.x); pg8::EpiResid E{(unsigned char*)KARG(28), 1.0f}; pg8::gemm_phase<true, true>(F.lds, g, S, E); }
        GRID_BAR();
        { KBASE(); pg8::Gemm g{H16, W_in_t + (size_t)5632 * 1024, M, 2 * DFF, D}; pg8::StaticOrder S; S.init(M, 2 * DFF, F.G, (int)blockIdx.x); pg8::EpiSwiglu E{ACT, DFF, RSQ};
          for (int rep = 0; rep < REPG(10); ++rep) pg8::gemm_phase<true, true>(F.lds, g, S, E); }
        GRID_BAR();
        { KBASE(); pg8::Gemm g{ACT, W_out_t + (size_t)1024 * 2816, M, D, DFF}; pg8::StaticOrder S; S.init(M, D, F.G, (int)blockIdx.x); pg8::EpiResid E{(unsigned char*)KARG(28), 0.5f};
          pg8::gemm_phase<true, true>(F.lds, g, S, E); }
        GRID_BAR();
    }
    PHASE_IDS();
    for (int m = gw; m < M; m += NGW) {
        f32x4* xr = (f32x4*)(H + (size_t)m * D) + lane; const f32x4* gr = (const f32x4*)final_norm + lane;
        f32x4 v[4]; float ss = 0.f;
#pragma unroll
        for (int j = 0; j < 4; ++j) { const u32x2 w = *(const u32x2*)(H16 + pg8::blk32(m, 4 * lane + 256 * j, D)); v[j] = (f32x4){blo(w.x), bhi(w.x), blo(w.y), bhi(w.y)}; ss += (v[j].x * v[j].x + v[j].y * v[j].y) + (v[j].z * v[j].z + v[j].w * v[j].w); }
        const float r = __builtin_amdgcn_rsqf(wave_sum(ss) * (1.f / D) + 1e-6f);
#pragma unroll
        for (int j = 0; j < 4; ++j) xr[64 * j] = v[j] * r * gr[64 * j];
    }
}

extern "C" void kernel_launch(void* const* d_in, const int* in_sizes, int n_in, void* d_out, int out_size, void* d_ws, size_t ws_size, hipStream_t stream) {
    static int grid = 0;
    if (grid == 0) {
        if (n_in != 27 || out_size != M * D || ws_size < WS_END) { fprintf(stderr, "kernel_launch: unexpected problem (n_in %d, out %d, ws %zu < %zu)\n", n_in, out_size, ws_size, (size_t)WS_END); grid = -1; return; }
        int dev = 0, cus = 0, per_cu = 0;
        if (hipGetDevice(&dev) != hipSuccess || hipDeviceGetAttribute(&cus, hipDeviceAttributeMultiprocessorCount, dev) != hipSuccess) { grid = -1; return; }
        if (hipFuncSetAttribute((const void*)fwd_kernel, hipFuncAttributeMaxDynamicSharedMemorySize, LDS_BYTES) != hipSuccess) { fprintf(stderr, "kernel_launch: hipFuncSetAttribute failed\n"); grid = -1; return; }
        if (hipOccupancyMaxActiveBlocksPerMultiprocessor(&per_cu, (const void*)fwd_kernel, NWAVES * 64, LDS_BYTES) != hipSuccess || per_cu < 1) { fprintf(stderr, "kernel_launch: occupancy query says %d\n", per_cu); }
        (void)hipGetLastError();
        grid = cus;
    }
    if (grid < 0) return;
    if (hipMemsetAsync((char*)d_ws + WS_CTL, 0, CTL_ZERO_BYTES, stream) != hipSuccess) return;
    Args a{};
    for (int i = 0; i < 27; ++i) a.in[i] = d_in[i];
    a.out = (float*)d_out; a.ws = (unsigned char*)d_ws; a.pad0 = 0; a.pad1 = 0;
    hipLaunchKernelGGL(fwd_kernel, dim3(grid), dim3(NWAVES * 64), LDS_BYTES, stream, a);
}
```

```cpp
#include <hip/hip_runtime.h>
#include <cstdio>
#include <cstdint>

#define GAS __attribute__((address_space(1)))
#define LAS __attribute__((address_space(3)))
#define CAS __attribute__((address_space(4)))
typedef unsigned short u16;
typedef _Float16 h16x8 __attribute__((ext_vector_type(8)));
typedef _Float16 h16x4 __attribute__((ext_vector_type(4)));
typedef _Float16 h16x2 __attribute__((ext_vector_type(2)));
typedef float f32x4 __attribute__((ext_vector_type(4)));
typedef float f32x2 __attribute__((ext_vector_type(2)));
typedef unsigned u32x4 __attribute__((ext_vector_type(4)));
typedef unsigned u32x2 __attribute__((ext_vector_type(2)));

__device__ __forceinline__ unsigned pk2(float lo, float hi) { f32x2 v = {lo, hi}; h16x2 h = __builtin_convertvector(v, h16x2); return __builtin_bit_cast(unsigned, h); }
typedef __bf16 b16x2 __attribute__((ext_vector_type(2)));
__device__ __forceinline__ unsigned pk2b(float lo, float hi) { f32x2 v = {lo, hi}; b16x2 h = __builtin_convertvector(v, b16x2); return __builtin_bit_cast(unsigned, h); }
__device__ __forceinline__ u16 f2b(float f) { return (u16)(pk2b(f, 0.f) & 0xffffu); }
__device__ __forceinline__ float blo(unsigned u) { return __builtin_bit_cast(float, u << 16); }
__device__ __forceinline__ float bhi(unsigned u) { return __builtin_bit_cast(float, u & 0xffff0000u); }
__device__ __forceinline__ u16 f2h(float f) { _Float16 h = (_Float16)f; return __builtin_bit_cast(u16, h); }
__device__ __forceinline__ float h2f(u16 u) { return (float)__builtin_bit_cast(_Float16, u); }
__device__ __forceinline__ float hlo(unsigned u) { return (float)__builtin_bit_cast(h16x2, u)[0]; }
__device__ __forceinline__ float hhi(unsigned u) { return (float)__builtin_bit_cast(h16x2, u)[1]; }
__device__ __forceinline__ float fsigmoid(float x) { return __builtin_amdgcn_rcpf(1.0f + __builtin_amdgcn_exp2f(-1.44269504089f * x)); }
__device__ __forceinline__ float fsilu(float x) { return x * fsigmoid(x); }
#define DPP_ADD_(v, ctrl, rmask) (v) += __builtin_bit_cast(float, __builtin_amdgcn_update_dpp(0, __builtin_bit_cast(int, (v)), (ctrl), (rmask), 0xf, false))
__device__ __forceinline__ float sum16(float v) {
    DPP_ADD_(v, 0xB1, 0xf); DPP_ADD_(v, 0x4E, 0xf); DPP_ADD_(v, 0x141, 0xf); DPP_ADD_(v, 0x140, 0xf); return v; }
__device__ __forceinline__ float wave_sum(float v) {
    v = sum16(v); DPP_ADD_(v, 0x142, 0xa); DPP_ADD_(v, 0x143, 0xc);
    return __builtin_bit_cast(float, __builtin_amdgcn_readlane(__builtin_bit_cast(int, v), 63)); }
__device__ __forceinline__ float xsum32(float v) {
    const unsigned u = __builtin_bit_cast(unsigned, v); auto r = __builtin_amdgcn_permlane32_swap(u, u, false, false); const unsigned a = r[0], b = r[1];
    return __builtin_bit_cast(float, a) + __builtin_bit_cast(float, b); }
__device__ __forceinline__ float xsum16(float v) {
    const unsigned u = __builtin_bit_cast(unsigned, v); auto r = __builtin_amdgcn_permlane16_swap(u, u, false, false); const unsigned a = r[0], b = r[1];
    return __builtin_bit_cast(float, a) + __builtin_bit_cast(float, b); }
__device__ __forceinline__ void pair16(float& a, float& b) {
    auto r = __builtin_amdgcn_permlane16_swap(__builtin_bit_cast(unsigned, a), __builtin_bit_cast(unsigned, b), false, false); const unsigned x = r[0], y = r[1];
    a = __builtin_bit_cast(float, x); b = __builtin_bit_cast(float, y); }
__device__ __forceinline__ float xmax32(float v) { const unsigned u = __builtin_bit_cast(unsigned, v); auto r = __builtin_amdgcn_permlane32_swap(u, u, false, false); const unsigned a = r[0], b = r[1];
    return fmaxf(__builtin_bit_cast(float, a), __builtin_bit_cast(float, b)); }
__device__ __forceinline__ float xmax16(float v) { const unsigned u = __builtin_bit_cast(unsigned, v); auto r = __builtin_amdgcn_permlane16_swap(u, u, false, false); const unsigned a = r[0], b = r[1];
    return fmaxf(__builtin_bit_cast(float, a), __builtin_bit_cast(float, b)); }
__device__ __forceinline__ float quad_bcast(float v, int src) {
    const int x = __builtin_bit_cast(int, v); int r;
    switch (src) { case 0: r = __builtin_amdgcn_update_dpp(0, x, 0x00, 0xF, 0xF, true); break; case 1: r = __builtin_amdgcn_update_dpp(0, x, 0x55, 0xF, 0xF, true); break;
                   case 2: r = __builtin_amdgcn_update_dpp(0, x, 0xAA, 0xF, 0xF, true); break; default: r = __builtin_amdgcn_update_dpp(0, x, 0xFF, 0xF, 0xF, true); break; }
    return __builtin_bit_cast(float, r);
}
__device__ __forceinline__ int fresh_tid() { int t = threadIdx.x; asm volatile("" : "+v"(t)); return t; }
#define MFMA16(a, b, c) __builtin_amdgcn_mfma_f32_16x16x32_f16((a), (b), (c), 0, 0, 0)
typedef short s16x4 __attribute__((ext_vector_type(4)));
typedef short s16x8 __attribute__((ext_vector_type(8)));
__device__ __forceinline__ h16x8 lds_tr16(const __attribute__((address_space(3))) unsigned short* img, int pitch, int k0, int n0, int lane) {
    const int g = lane >> 4, q = (lane & 15) >> 2, p = lane & 3;
    const __attribute__((address_space(3))) unsigned short* a = img + (k0 + 8 * g + q) * pitch + n0 + 4 * p;
    const s16x4 r0 = __builtin_amdgcn_ds_read_tr16_b64_v4i16((__attribute__((address_space(3))) s16x4*)a);
    const s16x4 r1 = __builtin_amdgcn_ds_read_tr16_b64_v4i16((__attribute__((address_space(3))) s16x4*)(a + 4 * pitch));
    return __builtin_bit_cast(h16x8, __builtin_shufflevector(r0, r1, 0, 1, 2, 3, 4, 5, 6, 7));
}

namespace pg8 {
#ifndef PG8_ZC
#define PG8_ZC 1
#endif
#ifndef PG8_SPLIT
#define PG8_SPLIT false
#endif
constexpr int BM = 256, BK = 64, HALF = 128, HTB = HALF * BK * 2, STAGE_BYTES = 8 * HTB, NXCD = 8, WGM = 8;
__host__ __device__ __forceinline__ int lds_byte(int r, int c) { const int st = (r >> 4) * 2 + (c >> 5), rr = r & 15, cc = c & 31, ob = rr * 64 + cc * 2; return st * 1024 + (ob ^ (((ob >> 9) & 1) << 5)); }
__host__ __device__ __forceinline__ void stage_rc(int b, int& R, int& C) { const int st = b / 1024, sb = b % 1024, swz = sb ^ (((sb >> 9) & 1) << 5); R = (st >> 1) * 16 + swz / 64; C = (st & 1) * 32 + (swz % 64) / 2; }
__host__ __device__ __forceinline__ int perm32(int rho) { const int n = rho >> 4, i = rho & 15; return 8 * (i >> 2) + 4 * n + (i & 3); }
__host__ __device__ __forceinline__ size_t blk32(int row, int col, int K) { return ((size_t)(row >> 5) * (K >> 5) + (col >> 5)) * 1024 + (row & 31) * 32 + (col & 31); }
struct Unit { int pm, pn; };
struct Gemm { const u16* A; const u16* Bt; int M, N, K; int lda, asplit; unsigned aofs; };
struct StaticOrder {
    int nM, nN, nwg, G, c;
    __host__ __device__ void init(int M, int N, int G_, int c_) { nM = M / BM; nN = N / BM; nwg = nM * nN; G = G_; c = c_; }
    __host__ __device__ bool next(int i, Unit& u) const {
        const long L = (long)i * G + c; if (L >= nwg) return false;
        int wgid = (int)L; { const int q = nwg / NXCD, r = nwg % NXCD, xcd = wgid % NXCD, off = wgid / NXCD; wgid = (xcd < r ? xcd * (q + 1) : r * (q + 1) + (xcd - r) * q) + off; }
        const int nig = WGM * nN, gid = wgid / nig, fm = gid * WGM, gsz = (nM - fm) < WGM ? (nM - fm) : WGM;
        u.pm = fm + ((wgid % nig) % gsz); u.pn = (wgid % nig) / gsz; return true;
    }
    __device__ __forceinline__ void a_ready(const Unit&, int) const {}
    __device__ __forceinline__ void done(const Unit&) const {}
};
struct PairedOrder {
    StaticOrder base;
    __host__ __device__ void init(int M, int Nhalf, int G_, int c_) { base.init(M, Nhalf, G_, c_); }
    __host__ __device__ bool next(int i, Unit& u) const { Unit t; if (!base.next(i >> 1, t)) return false; u.pm = t.pm; u.pn = 2 * t.pn + (i & 1); return true; }
    __device__ __forceinline__ void a_ready(const Unit&, int) const {}
    __device__ __forceinline__ void done(const Unit&) const {}
};
__device__ __forceinline__ void load_scales(LAS float* dst, const float* rsq, int pm, int tid) {
    const int r = tid >> 1, hf = tid & 1;
    const f32x4* p = (const f32x4*)(rsq + (size_t)pm * 4096) + (unsigned)(tid * 2);
    const f32x4 a = p[0], b = p[1]; const f32x4 t = a + b; float s = (t[0] + t[1]) + (t[2] + t[3]);
    s += __builtin_bit_cast(float, __builtin_amdgcn_update_dpp(0, __builtin_bit_cast(int, s), 0xB1, 0xF, 0xF, true));
    if (hf == 0) dst[(((r >> 6) & 1) * 16 + (r & 15)) * 8 + (r >> 7) * 4 + ((r >> 4) & 3)] = __builtin_amdgcn_rsqf(s * (1.0f / 1024.0f) + 1e-6f);
}
template <bool RS> struct EpiStoreH {
    static constexpr bool PERM = true, SPLIT = PG8_SPLIT, HALVES = true, RS_LDS = RS;
    static constexpr int NST = 8;
    u16* O; int ldc; int split_cols; size_t split_stride; const float* rsv;
    u16* O2; int ldc2; int n1;
    template <int AI> __device__ __forceinline__ void half(const f32x4 (&acc)[2][2][4][2], const Unit& u, int wr, int wc, int fr_in, int fq_in, const LAS float* rs) const {
        int fr = fr_in, fq = fq_in; asm volatile("" : "+v"(fr), "+v"(fq));
        const int row0 = u.pm * BM + wr * 64 + fr + AI * HALF; int colt = u.pn * BM; u16* base = O; int ld = ldc;
        if (n1 && u.pn >= n1) { base = O2; colt = (u.pn - n1) * BM; ld = ldc2; }
        else if (split_cols) { const int t = colt / split_cols; base += (size_t)t * split_stride; colt -= t * split_cols; }
        const int col0 = colt + wc * 32 + 8 * fq;
        f32x4 rsa = {1.f, 1.f, 1.f, 1.f};
        if (RS) rsa = *(const LAS f32x4*)(rs + (wr * 16 + fr) * 8 + AI * 4);
        u16* p0 = base + blk32(row0, col0, ld);
#pragma unroll
        for (int m = 0; m < 4; ++m) {
            const float rsc = rsa[m];
#pragma unroll
            for (int bj = 0; bj < 2; ++bj) { const f32x4 v0 = acc[AI][bj][m][0] * rsc, v1 = acc[AI][bj][m][1] * rsc;
                u32x4 w; w.x = pk2(v0[0], v0[1]); w.y = pk2(v0[2], v0[3]); w.z = pk2(v1[0], v1[1]); w.w = pk2(v1[2], v1[3]);
                __builtin_nontemporal_store(w, (u32x4*)(p0 + (size_t)(m >> 1) * (ld >> 5) * 1024 + (m & 1) * 512 + bj * (HALF / 32) * 1024)); } }
    }
};
struct EpiSwiglu {
    static constexpr bool PERM = true, SPLIT = PG8_SPLIT, HALVES = true, RS_LDS = true;
    static constexpr int NST = 4;
    u16* O; int ldc; const float* rsv;
    template <int AI> __device__ __forceinline__ void half(const f32x4 (&acc)[2][2][4][2], const Unit& u, int wr, int wc, int fr_in, int fq_in, const LAS float* rs) const {
        int fr = fr_in, fq = fq_in; asm volatile("" : "+v"(fr), "+v"(fq));
        const int row0 = u.pm * BM + wr * 64 + fr + AI * HALF, col0 = u.pn * HALF + wc * 32 + 8 * fq;
        const f32x4 rsa = *(const LAS f32x4*)(rs + (wr * 16 + fr) * 8 + AI * 4);
        u16* p0 = O + blk32(row0, col0, ldc);
#pragma unroll
        for (int m = 0; m < 4; ++m) { u16* rowp = p0 + (size_t)(m >> 1) * (ldc >> 5) * 1024 + (m & 1) * 512;
            const float rsc = rsa[m]; const f32x2 rs2 = {rsc, rsc};
            unsigned ow[4];
#pragma unroll
            for (int p = 0; p < 4; ++p) {
                const f32x4 ga = acc[AI][0][m][p >> 1], ua = acc[AI][1][m][p >> 1];
                const f32x2 g2 = (f32x2){ga[2 * (p & 1)], ga[2 * (p & 1) + 1]} * rs2, u2 = (f32x2){ua[2 * (p & 1)], ua[2 * (p & 1) + 1]} * rs2;
                const f32x2 t2 = g2 * (f32x2){-1.44269504089f, -1.44269504089f};
                const f32x2 d2 = (f32x2){__builtin_amdgcn_exp2f(t2.x), __builtin_amdgcn_exp2f(t2.y)} + (f32x2){1.0f, 1.0f};
                const f32x2 o2 = (g2 * (f32x2){__builtin_amdgcn_rcpf(d2.x), __builtin_amdgcn_rcpf(d2.y)}) * u2;
                ow[p] = pk2b(o2.x, o2.y); }
            u32x4 w; w.x = ow[0]; w.y = ow[1]; w.z = ow[2]; w.w = ow[3];
            __builtin_nontemporal_store(w, (u32x4*)rowp); }
    }
};
constexpr size_t H16_OFF = (size_t)127 << 20, RSQ_OFF = (size_t)255 << 20;
struct EpiResid {
    static constexpr bool PERM = true, SPLIT = false, HALVES = false, RS_LDS = false;
    static constexpr int NST = 0;
    static constexpr int ldc = 1024;
    static constexpr const float* rsv = nullptr;
    template <int AI> __device__ __forceinline__ void half(const f32x4 (&)[2][2][4][2], const Unit&, int, int, int, int, const LAS float*) const {}
    unsigned char* wsb; float scale;
    __device__ __forceinline__ void operator()(const f32x4 (&acc)[2][2][4][2], const Unit& u, int wr, int wc, int fr_in, int fq_in, int, const LAS float*) const {
        int fr = fr_in, fq = fq_in; asm volatile("" : "+v"(fr), "+v"(fq));
        const int row0 = u.pm * BM + wr * 64 + fr, col0 = u.pn * BM + wc * 32 + 8 * fq;
        u16* h16 = (u16*)(wsb + H16_OFF); float* rsq = (float*)(wsb + RSQ_OFF);
#pragma unroll
        for (int ai = 0; ai < 2; ++ai) {
            u32x4 hva[4][2];
#pragma unroll
            for (int m = 0; m < 4; ++m)
#pragma unroll
                for (int bj = 0; bj < 2; ++bj) hva[m][bj] = *(const u32x4*)(h16 + blk32(row0 + ai * HALF + m * 16, col0 + bj * HALF, ldc));
#pragma unroll
            for (int m = 0; m < 4; ++m) { const int rw = row0 + ai * HALF + m * 16; float sq = 0.f;
                u32x4 hv[2];
#pragma unroll
                for (int bj = 0; bj < 2; ++bj) hv[bj] = hva[m][bj];
#pragma unroll
                for (int bj = 0; bj < 2; ++bj) { unsigned ow[4];
#pragma unroll
                    for (int n = 0; n < 2; ++n) { const unsigned w0 = hv[bj][2 * n], w1 = hv[bj][2 * n + 1];
                        const f32x4 bs = {blo(w0), bhi(w0), blo(w1), bhi(w1)}; const f32x4 o = bs + acc[ai][bj][m][n] * scale;
                        ow[2 * n] = pk2b(o[0], o[1]); ow[2 * n + 1] = pk2b(o[2], o[3]);
                        sq += (o[0] * o[0] + o[1] * o[1]) + (o[2] * o[2] + o[3] * o[3]); }
                    u32x4 w; w.x = ow[0]; w.y = ow[1]; w.z = ow[2]; w.w = ow[3]; *(u32x4*)(h16 + blk32(rw, col0 + bj * HALF, ldc)) = w; }
                sq = xsum16(sq); sq = xsum32(sq);
                if (fq == 0) rsq[(size_t)(row0 + ai * HALF + m * 16) * 16 + 4 * u.pn + wc] = sq;
                asm volatile("" ::: "memory"); }
        }
    }
};
struct EpiGate {
    static constexpr bool PERM = true, SPLIT = false, HALVES = false, RS_LDS = true;
    static constexpr int NST = 0;
    template <int AI> __device__ __forceinline__ void half(const f32x4 (&)[2][2][4][2], const Unit&, int, int, int, int, const LAS float*) const {}
    const float* ba; const float* bb; const u16* tA; const u16* tB; u16* O; int ldc; const float* rsv;
    __device__ __forceinline__ void operator()(const f32x4 (&acc)[2][2][4][2], const Unit& u, int wr, int wc, int fr_in, int fq_in, int ui, const LAS float* rs) const {
        int fr = fr_in, fq = fq_in; asm volatile("" : "+v"(fr), "+v"(fq));
        const int row0 = u.pm * BM + wr * 64 + fr, col0 = u.pn * HALF + wc * 32 + 8 * fq;
        float va[8], vb[8];
#pragma unroll
        for (int j = 0; j < 8; ++j) { va[j] = ba[col0 + j]; vb[j] = bb[col0 + j]; }
        f32x4 rsa[2]; { const LAS f32x4* rp = (const LAS f32x4*)(rs + (wr * 16 + fr) * 8); rsa[0] = rp[0]; rsa[1] = rp[1]; }
#pragma unroll
        for (int ai = 0; ai < 2; ++ai) {
            u32x4 a4g[4], b4g[4];
#pragma unroll
            for (int m = 0; m < 4; ++m) { const size_t boff = blk32(row0 + ai * HALF + m * 16, col0, ldc); a4g[m] = *(const u32x4*)(tA + boff); b4g[m] = *(const u32x4*)(tB + boff); }
#pragma unroll
            for (int m = 0; m < 4; ++m) { const u32x4 a4 = a4g[m], b4 = b4g[m];
                const float rs = rsa[ai][m];
                const f32x2 rs2 = {rs, rs}; unsigned ow[4];
#pragma unroll
                for (int p = 0; p < 4; ++p) {
                    const f32x4 xa = acc[ai][0][m][p >> 1], xb = acc[ai][1][m][p >> 1]; const int e = 2 * p;
                    const f32x2 pa = (f32x2){xa[2 * (p & 1)], xa[2 * (p & 1) + 1]} * rs2 + (f32x2){va[e], va[e + 1]}, pb = (f32x2){xb[2 * (p & 1)], xb[2 * (p & 1) + 1]} * rs2 + (f32x2){vb[e], vb[e + 1]};
                    const f32x2 ta2 = pa * (f32x2){-1.44269504089f, -1.44269504089f}, tb2 = pb * (f32x2){-1.44269504089f, -1.44269504089f};
                    const f32x2 da = (f32x2){__builtin_amdgcn_exp2f(ta2.x), __builtin_amdgcn_exp2f(ta2.y)} + (f32x2){1.0f, 1.0f}, db = (f32x2){__builtin_amdgcn_exp2f(tb2.x), __builtin_amdgcn_exp2f(tb2.y)} + (f32x2){1.0f, 1.0f};
                    const f32x2 tA = {hlo(a4[p]), hhi(a4[p])}, tB = {hlo(b4[p]), hhi(b4[p])};
                    const f32x2 o2 = (f32x2){__builtin_amdgcn_rcpf(da.x), __builtin_amdgcn_rcpf(da.y)} * tA + (f32x2){__builtin_amdgcn_rcpf(db.x), __builtin_amdgcn_rcpf(db.y)} * tB;
                    ow[p] = pk2b(o2.x, o2.y); }
                u32x4 w; w.x = ow[0]; w.y = ow[1]; w.z = ow[2]; w.w = ow[3];
                __builtin_nontemporal_store(w, (u32x4*)(O + blk32(row0 + ai * HALF + m * 16, col0, ldc))); }
        }
    }
};

typedef __bf16 bf16x8 __attribute__((ext_vector_type(8)));
#define MFMA16B(a, b, c) __builtin_amdgcn_mfma_f32_16x16x32_bf16(__builtin_bit_cast(pg8::bf16x8, (a)), __builtin_bit_cast(pg8::bf16x8, (b)), (c), 0, 0, 0)
template <bool ABLK, bool BBLK, class Epi, class Sched>
__device__ __forceinline__ void gemm_phase(LAS unsigned char* lds, const Gemm g, const Sched& S, const Epi& E) {
    const int tid = fresh_tid(), wid = __builtin_amdgcn_readfirstlane(tid >> 6), lane = tid & 63, wr = wid >> 2, wc = wid & 3, fr = lane & 15, fq = lane >> 4;
    const int K = g.K, KA = g.lda ? g.lda : K; int nt = K / BK; asm volatile("" : "+s"(nt));
    unsigned voffA, voffB;
    { int R, C; stage_rc(tid * 16, R, C); const int Rb = Epi::PERM ? ((R & ~31) + perm32(R & 31)) : R;
      voffA = ABLK ? (unsigned)blk32(R, C, KA) * 2u : (unsigned)(R * KA + C) * 2u; voffB = BBLK ? (unsigned)blk32(Rb, C, K) * 2u : (unsigned)(Rb * K + C) * 2u; }
    const size_t sA = (size_t)64 * KA * 2, sB = (size_t)64 * K * 2;
    const size_t kstepA = ABLK ? (size_t)4096 : (size_t)(BK * 2), kstepB = BBLK ? (size_t)4096 : (size_t)(BK * 2);
    const size_t hstep = (size_t)HALF * K * 2, hstepA = (size_t)HALF * KA * 2;
    const size_t tstep = 2 * hstep, tstepA = 2 * hstepA;
    const unsigned ldsw = (unsigned)wid * 1024u;
    const int aoff = lds_byte(wr * 64 + fr, fq * 8), boff = lds_byte(wc * 32 + fr, fq * 8);
#define PG8_SA(b, h) (((b) * 2 + (h)) * HTB)
#define PG8_SB(b, h) ((4 + (b) * 2 + (h)) * HTB)
#define PG8_STAGE(bufoff, gbase, voff) do { _Pragma("unroll") for (int _i = 0; _i < 2; ++_i) \
        __builtin_amdgcn_global_load_lds((const unsigned*)((const char*)(gbase) + _i * PG8_STEP_##voff + (voff)), (LAS unsigned*)(lds + (bufoff) + ldsw + _i * 8192), 16, 0, 0); } while (0)
#define PG8_STEP_voffA sA
#define PG8_STEP_voffB sB
#define PG8_LDA(dst, b, h) do { _Pragma("unroll") for (int m = 0; m < 4; ++m) _Pragma("unroll") for (int k = 0; k < 2; ++k) dst[m][k] = *(const LAS h16x8*)(lds + PG8_SA(b, h) + aoff + m * 2048 + k * 1024); } while (0)
#define PG8_LDB(dst, b, h) do { _Pragma("unroll") for (int n = 0; n < 2; ++n) _Pragma("unroll") for (int k = 0; k < 2; ++k) dst[n][k] = *(const LAS h16x8*)(lds + PG8_SB(b, h) + boff + n * 2048 + k * 1024); } while (0)
#define PG8_MMA(ai, bj, At, Bt) do { __builtin_amdgcn_s_setprio(1); _Pragma("unroll") for (int m = 0; m < 4; ++m) _Pragma("unroll") for (int n = 0; n < 2; ++n) _Pragma("unroll") for (int k = 0; k < 2; ++k) \
        acc[ai][bj][m][n] = MFMA16B(Bt[n][k], At[m][k], acc[ai][bj][m][n]); __builtin_amdgcn_s_setprio(0); } while (0)
#define PG8_MMAZ(ai, bj, At, Bt) do { __builtin_amdgcn_s_setprio(1); _Pragma("unroll") for (int m = 0; m < 4; ++m) _Pragma("unroll") for (int n = 0; n < 2; ++n) { \
        acc[ai][bj][m][n] = MFMA16B(Bt[n][0], At[m][0], zero4); acc[ai][bj][m][n] = MFMA16B(Bt[n][1], At[m][1], acc[ai][bj][m][n]); } __builtin_amdgcn_s_setprio(0); } while (0)
#define PG8_WAIT_V(n) asm volatile("s_waitcnt vmcnt(" #n ")" ::: "memory")
#define PG8_WAIT_VN(n) asm volatile("s_waitcnt vmcnt(%0)" :: "n"(n) : "memory")
#define PG8_WAIT_L(n) asm volatile("s_waitcnt lgkmcnt(" #n ")" ::: "memory")
#define PG8_BAR __builtin_amdgcn_s_barrier()
#define PG8_SCHED __builtin_amdgcn_sched_barrier(0)
#define PG8_H1P E.template half<1>(acc, prv, wr, wc, fr, fq, rsl + psb * 256)
#define PG8_H0C E.template half<0>(acc, cur, wr, wc, fr, fq, rsl + sb * 256)
#define PG8_ZERO(a) do { _Pragma("unroll") for (int b_ = 0; b_ < 2; ++b_) _Pragma("unroll") for (int m_ = 0; m_ < 4; ++m_) _Pragma("unroll") for (int n_ = 0; n_ < 2; ++n_) acc[a][b_][m_][n_] = zero4; } while (0)
    Unit cur, nxt, prv; int ui = 0; prv.pm = 0; prv.pn = 0;
    if (!S.next(0, cur)) return;
    f32x4 acc[2][2][4][2]; const f32x4 zero4 = {0.f, 0.f, 0.f, 0.f};
    PG8_ZERO(0); PG8_ZERO(1);
    h16x8 At[4][2], B0[2][2], B1[2][2];
    LAS float* rsl = (LAS float*)(lds + STAGE_BYTES);
    int sb = 0, psb = 0;
    if (Epi::RS_LDS) load_scales(rsl, E.rsv, cur.pm, tid);
    const char* cA = (const char*)g.A + (size_t)cur.pm * tstepA + ((g.asplit && cur.pn >= g.asplit) ? g.aofs : 0u); const char* cB = (const char*)g.Bt + (size_t)cur.pn * tstep;
    S.a_ready(cur, 0);
    PG8_STAGE(PG8_SB(0, 0), cB, voffB); PG8_STAGE(PG8_SB(0, 1), cB + hstep, voffB); PG8_STAGE(PG8_SA(0, 0), cA, voffA); PG8_STAGE(PG8_SA(0, 1), cA + hstepA, voffA);
    if (wr == 1) PG8_BAR;
    PG8_WAIT_V(2); PG8_BAR;
    PG8_STAGE(PG8_SB(1, 0), cB + kstepB, voffB); PG8_STAGE(PG8_SA(1, 0), cA + kstepA, voffA); PG8_STAGE(PG8_SB(1, 1), cB + hstep + kstepB, voffB);
    PG8_WAIT_V(6); PG8_BAR;
    for (;;) {
        const bool has_next = S.next(ui + 1, nxt);
        const char* nA = has_next ? (const char*)g.A + (size_t)nxt.pm * tstepA + ((g.asplit && nxt.pn >= g.asplit) ? g.aofs : 0u) : cA; const char* nB = has_next ? (const char*)g.Bt + (size_t)nxt.pn * tstep : cB;
        for (int t = 0; t < nt; t += 2) {
            const bool last = (t == nt - 2), fe = Epi::SPLIT && t == 0 && ui > 0;
            const bool dead = !Epi::SPLIT && last && !has_next;
            const char* a1 = cA + (size_t)(t + 1) * kstepA;
            const char* a2 = last ? nA : cA + (size_t)(t + 2) * kstepA; const char* b2 = last ? nB : cB + (size_t)(t + 2) * kstepB;
            const char* a3 = a2 + kstepA; const char* b3 = b2 + kstepB;
            PG8_LDB(B0, 0, 0); PG8_LDB(B1, 0, 1); PG8_SCHED; PG8_LDA(At, 0, 0); PG8_STAGE(PG8_SA(1, 1), a1 + hstepA, voffA);
            if (fe) { PG8_H1P; PG8_ZERO(1); PG8_WAIT_VN(8 + 2 * Epi::NST); } else PG8_WAIT_V(8);
            PG8_WAIT_L(0); PG8_BAR; PG8_MMA(0, 0, At, B0); PG8_MMA(0, 1, At, B1); PG8_BAR; PG8_SCHED;
            PG8_LDA(At, 0, 1);
            if (dead) PG8_WAIT_V(2);
            else { PG8_STAGE(PG8_SB(0, 0), b2, voffB); PG8_STAGE(PG8_SB(0, 1), b2 + hstep, voffB); PG8_STAGE(PG8_SA(0, 0), a2, voffA);
                if (fe) PG8_WAIT_VN(8 + 2 * Epi::NST); else PG8_WAIT_V(8); }
            PG8_WAIT_L(0); PG8_BAR; PG8_MMA(1, 0, At, B0); PG8_MMA(1, 1, At, B1); PG8_BAR; PG8_SCHED;
            PG8_LDB(B0, 1, 0); PG8_LDB(B1, 1, 1); PG8_SCHED; PG8_LDA(At, 1, 0);
            if (dead) PG8_WAIT_V(0);
            else { PG8_STAGE(PG8_SA(0, 1), a2 + hstepA, voffA);
                if (fe) PG8_WAIT_VN(8 + Epi::NST); else PG8_WAIT_V(8); }
            PG8_WAIT_L(0); PG8_BAR; PG8_MMA(0, 0, At, B0); PG8_MMA(0, 1, At, B1); PG8_BAR; PG8_SCHED;
            PG8_LDA(At, 1, 1);
            if (!dead) { PG8_STAGE(PG8_SB(1, 0), b3, voffB); PG8_STAGE(PG8_SB(1, 1), b3 + hstep, voffB); PG8_STAGE(PG8_SA(1, 0), a3, voffA);
                if (Epi::SPLIT && last) { PG8_SCHED; PG8_H0C; PG8_ZERO(0); PG8_WAIT_VN(8 + Epi::NST); } else PG8_WAIT_V(8); }
            PG8_WAIT_L(0); PG8_BAR; PG8_MMA(1, 0, At, B0); PG8_MMA(1, 1, At, B1); PG8_BAR; PG8_SCHED;
        }
        if constexpr (!Epi::SPLIT) {
            if (wr == 0) PG8_BAR;
            if constexpr (Epi::HALVES) { E.template half<0>(acc, cur, wr, wc, fr, fq, rsl + sb * 256); E.template half<1>(acc, cur, wr, wc, fr, fq, rsl + sb * 256); } else E(acc, cur, wr, wc, fr, fq, ui, rsl + sb * 256);
            if (!has_next) break;
            if (Epi::RS_LDS && nxt.pm != cur.pm) { sb ^= 1; load_scales(rsl + sb * 256, E.rsv, nxt.pm, tid); }
            cur = nxt; cA = nA; cB = nB; ++ui;
            if (wr == 1) PG8_BAR;
            PG8_SCHED; PG8_ZERO(0); PG8_ZERO(1); PG8_SCHED;
        } else {
            if (!has_next) { E.template half<1>(acc, cur, wr, wc, fr, fq, rsl + sb * 256); break; }
            prv = cur; psb = sb;
            if (Epi::RS_LDS && nxt.pm != cur.pm) { sb ^= 1; load_scales(rsl + sb * 256, E.rsv, nxt.pm, tid); }
            cur = nxt; cA = nA; cB = nB; ++ui;
        }
    }
    if (Epi::SPLIT) { if (wr == 0) PG8_BAR; }
    PG8_WAIT_V(0);
    PG8_BAR;
#undef PG8_ZERO
#undef PG8_H1P
#undef PG8_H0C
#undef PG8_NONE
#undef PG8_SA
#undef PG8_SB
#undef PG8_STAGE
#undef PG8_STEP_voffA
#undef PG8_STEP_voffB
#undef PG8_LDA
#undef PG8_LDB
#undef PG8_MMA
#undef PG8_MMAZ
#undef PG8_WAIT_V
#undef PG8_WAIT_VN
#undef PG8_WAIT_L
#undef PG8_BAR
#undef PG8_SCHED
}
}

#ifndef REP_CONV
#define REP_CONV 1
#endif
#ifndef REP_RMS
#define REP_RMS 1
#endif
#ifndef REP_MASK
#define REP_MASK 0
#endif
#define REPG(i) ((((REP_MASK) >> (i)) & 1) + 1)
#ifndef REP_G
#define REP_G 1
#endif
#ifndef REP_PREP
#define REP_PREP 1
#endif
#ifndef REP_PA
#define REP_PA 1
#endif
#ifndef REP_PB
#define REP_PB 1
#endif
#ifndef REP_POST
#define REP_POST 1
#endif
#ifndef REP_RET
#define REP_RET 1
#endif
#ifndef REP_XATT
#define REP_XATT 1
#endif
#ifndef REP_BAR
#define REP_BAR 1
#endif
constexpr int NWAVES = 8;
constexpr int D = 1024, NBATCH = 32, T = 2048, DEPTH = 4, M = NBATCH * T, MEML = 256, MM = NBATCH * MEML, DFF = 2816;
constexpr int AW = 512, INW = 6912, CH = 32, NCH = T / CH;
constexpr size_t MiB = 1u << 20;
constexpr size_t WS_CTL = 0, CTL_ZERO_BYTES = 1 * MiB;
constexpr size_t WS_WB = 1 * MiB;
constexpr size_t WB_WIN = 0, WB_WOUT = WB_WIN + 2 * (size_t)5632 * 1024 * 2, WB_WA = WB_WOUT + 2 * (size_t)1024 * 2816 * 2, WB_WBM = WB_WA + (size_t)1792 * 1024 * 2,
                 WB_WG = WB_WBM + (size_t)3072 * 1024 * 2, WB_WLR = WB_WG + (size_t)2048 * 1024 * 2, WB_PA = WB_WLR + (size_t)1536 * 256 * 2, WB_PB = WB_PA + (size_t)1024 * 512 * 2,
                 WB_WMO = WB_PB + 2 * MiB, WB_WQ = WB_WMO + 2 * MiB, WB_WK = WB_WQ + 2 * MiB, WB_WV = WB_WK + 2 * MiB, WB_WO = WB_WV + 2 * MiB, WB_END = WB_WO + 2 * MiB;
static_assert(WB_END <= 62 * MiB, "weights region");
static_assert(pg8::H16_OFF == 127 * MiB && pg8::RSQ_OFF == 255 * MiB, "EpiResid offsets");
constexpr size_t WS_MEMN = 63 * MiB, WS_KM = 79 * MiB, WS_VTM = 95 * MiB, WS_COS = 111 * MiB, WS_SIN = 119 * MiB, WS_XN = 127 * MiB, WS_RSQ = 255 * MiB, WS_AR = 259 * MiB;
constexpr size_t AR_ZA = 0, AR_YS = 192 * MiB, AR_ALR = 224 * MiB, AR_WAG = 256 * MiB, AR_PAO = 448 * MiB, AR_ST = 641 * MiB, AR_YA = 645 * MiB, AR_END = 709 * MiB;
constexpr size_t AR_ZB = 256 * MiB, AR_YB = 0, AR_TMPA = 256 * MiB, AR_TMPB = 384 * MiB, AR_MRG = 0, AR_Q = 0, AR_O = 128 * MiB, AR_ACT = 0;
constexpr size_t WS_END = WS_AR + AR_END;
constexpr int CW_BAR = 4096;
constexpr int LDS_BYTES = 163840, LDSCTL_OFF = LDS_BYTES - 256, LDS_RS_OFF = 131072;

__constant__ float c_invfreq[32] = {
    1.0f, 0.7498942093324559f, 0.5623413251903491f, 0.4216965034285822f, 0.31622776601683794f, 0.23713737056616552f, 0.1778279410038923f, 0.1333521432163324f,
    0.1f, 0.07498942093324559f, 0.05623413251903491f, 0.04216965034285822f, 0.031622776601683794f, 0.023713737056616552f, 0.01778279410038923f, 0.01333521432163324f,
    0.01f, 0.007498942093324559f, 0.005623413251903491f, 0.004216965034285822f, 0.0031622776601683794f, 0.0023713737056616554f, 0.001778279410038923f, 0.001333521432163324f,
    0.001f, 0.0007498942093324559f, 0.0005623413251903491f, 0.0004216965034285822f, 0.00031622776601683794f, 0.00023713737056616554f, 0.0001778279410038923f, 0.0001333521432163324f };

#define XB_TMO      128
#define XB_XCNT(j)  (256  + 64 * (j))
#define XB_XSUB(j)  (1280 + 64 * (j))
#define XB_XGEN(j)  (2304 + 64 * (j))
#define XB_TOP      3328
#define XB_TOPGEN   3392
#define XCD_BAR_WORDS 3456
#define XB_SPIN_CAP (1u << 18)
__device__ __forceinline__ unsigned xb_ld(unsigned* p)              { return __hip_atomic_load(p, __ATOMIC_RELAXED, __HIP_MEMORY_SCOPE_AGENT); }
__device__ __forceinline__ unsigned xb_add(unsigned* p, unsigned v) { return __hip_atomic_fetch_add(p, v, __ATOMIC_RELAXED, __HIP_MEMORY_SCOPE_AGENT); }
__device__ __forceinline__ unsigned xb_xcc_id() { return (unsigned)__builtin_amdgcn_s_getreg((3 << 11) | 20) & 0xFu; }
#define XB_SPIN(cond, bar) do { unsigned _sp = 0; while (cond) { __builtin_amdgcn_s_sleep(1); \
    if ((++_sp & 255u) == 0u) { if (xb_ld(&(bar)[XB_TMO])) break; if (_sp > XB_SPIN_CAP) { atomicAdd(&(bar)[XB_TMO], 1u); break; } } } } while (0)
struct XcdBarrier { unsigned* bar; unsigned x; volatile LAS unsigned* st; };
__device__ __forceinline__ XcdBarrier xcd_barrier_post(unsigned* bar, volatile LAS unsigned* st) {
    XcdBarrier b; b.bar = bar; b.x = xb_xcc_id(); b.st = st;
    if (threadIdx.x == 0) (void)xb_add(&bar[XB_XCNT(b.x)], 1u);
    return b;
}
__device__ __forceinline__ void xcd_barrier_complete(unsigned* bar, unsigned x, unsigned& nloc, unsigned& nx) {
    const unsigned G = gridDim.x * gridDim.y * gridDim.z;
    unsigned sum, cnt, mine, sp = 0u;
    for (;;) {
        sum = 0u; cnt = 0u; mine = 0u;
#pragma unroll
        for (unsigned j = 0; j < 16; ++j) { const unsigned c = xb_ld(&bar[XB_XCNT(j)]); sum += c; cnt += (c > 0u) ? 1u : 0u; mine = (j == x) ? c : mine; }
        if (sum == G) break;
        __builtin_amdgcn_s_sleep(1);
        if ((++sp & 255u) == 0u) { if (xb_ld(&bar[XB_TMO])) break; if (sp > XB_SPIN_CAP) { atomicAdd(&bar[XB_TMO], 1u); break; } }
    }
    nloc = mine > 0u ? mine : 1u; nx = cnt > 0u ? cnt : 1u;
}
__device__ __forceinline__ void xcd_barrier(const XcdBarrier& b) {
    asm volatile("s_waitcnt vmcnt(0)" ::: "memory");
    __syncthreads();
    if (threadIdx.x == 0) {
        unsigned* bar = b.bar;
        __builtin_amdgcn_s_waitcnt(0);
        unsigned nloc = b.st[0], nx = b.st[1];
        if (nloc == 0u) { xcd_barrier_complete(bar, b.x, nloc, nx); b.st[0] = nloc; b.st[1] = nx; }
        const unsigned old = xb_add(&bar[XB_XSUB(b.x)], 1u);
        const unsigned gen = old / nloc;
        if (old + 1u == (gen + 1u) * nloc) {
            __builtin_amdgcn_fence(__ATOMIC_RELEASE, "agent");
            asm volatile("s_waitcnt vmcnt(0)" ::: "memory");
            const unsigned og = xb_add(&bar[XB_TOP], 1u);
            const unsigned tg = og / nx;
            if (og + 1u == (tg + 1u) * nx) xb_add(&bar[XB_TOPGEN], 1u);
            else XB_SPIN(xb_ld(&bar[XB_TOPGEN]) == tg, bar);
            __builtin_amdgcn_fence(__ATOMIC_ACQUIRE, "agent");
            xb_add(&bar[XB_XGEN(b.x)], 1u);
            asm volatile("s_waitcnt vmcnt(0)" ::: "memory");
        } else {
            XB_SPIN(xb_ld(&bar[XB_XGEN(b.x)]) == gen, bar);
            __builtin_amdgcn_fence(__ATOMIC_ACQUIRE, "agent");
            asm volatile("s_waitcnt vmcnt(0)" ::: "memory");
        }
    }
    __syncthreads();
}

struct Args { const void* in[27]; float* out; unsigned char* ws; int pad0, pad1; };
#define KBASE() const CAS char* kbase_ = (const CAS char*)__builtin_amdgcn_kernarg_segment_ptr(); asm volatile("" : "+s"(kbase_))
#define KARG(k) (*(void* const CAS*)(kbase_ + 8 * (k)))
struct Frame { LAS unsigned char* lds; int G; };
#define PHASE_IDS() KBASE(); const int tid = fresh_tid(), lane = tid & 63, wave = __builtin_amdgcn_readfirstlane(tid >> 6), gw = (int)blockIdx.x * NWAVES + wave, NGW = F.G * NWAVES; (void)lane; (void)gw; (void)NGW
#define LDS_WAIT() asm volatile("s_waitcnt lgkmcnt(0)" ::: "memory")
#define LDS_BARRIER() do { asm volatile("s_waitcnt lgkmcnt(0)" ::: "memory"); __builtin_amdgcn_s_barrier(); asm volatile("" ::: "memory"); } while (0)

__device__ __forceinline__ void conv_matrix(const Frame& F, const float* W, int ldw, int coff, int K, int N, u16* WT, int mode, int NH, const float* gain, int& rot) {
    for (int rep = 0; rep < REP_CONV; ++rep) {
    PHASE_IDS();
    LAS float* scr = (LAS float*)(F.lds + wave * 8448);
    const int nblk = N / 32, nitems = (K / 64) * nblk;
    int first = gw - rot; if (first < 0) first += NGW;
    rot = (rot + nitems) % NGW;
    for (int item = first; item < nitems; item += NGW) {
        const int kb = item / nblk, nb = item % nblk, k0 = 64 * kb, n0 = 32 * nb;
        int d0 = n0;
        if (mode == 1) { d0 = (n0 < NH) ? (n0 / 128) * 256 + (n0 % 128) : ((n0 - NH) / 128) * 256 + 128 + ((n0 - NH) % 128); }
#pragma unroll
        for (int i = 0; i < 8; ++i) { const int kk = 8 * i + (lane >> 3), n4 = 4 * (lane & 7);
            f32x4 w4 = *(const f32x4*)(W + (size_t)(k0 + kk) * ldw + coff + n0 + n4); if (gain) w4 = w4 * gain[k0 + kk];
            scr[kk * 33 + n4] = w4[0]; scr[kk * 33 + n4 + 1] = w4[1]; scr[kk * 33 + n4 + 2] = w4[2]; scr[kk * 33 + n4 + 3] = w4[3]; }
        LDS_WAIT(); asm volatile("" ::: "memory");
        const int c = lane & 7;
#pragma unroll
        for (int j = 0; j < 4; ++j) { const int n = (lane >> 3) + 8 * j; const LAS float* s = scr + (8 * c) * 33 + n;
            u32x4 o; o.x = pk2b(s[0 * 33], s[1 * 33]); o.y = pk2b(s[2 * 33], s[3 * 33]); o.z = pk2b(s[4 * 33], s[5 * 33]); o.w = pk2b(s[6 * 33], s[7 * 33]);
            *(u32x4*)(WT + pg8::blk32(d0 + n, k0 + 8 * c, K)) = o; }
        LDS_WAIT(); asm volatile("" ::: "memory");
    }
    }
}
__device__ __forceinline__ void rms_row_h(const float* xrow, const float* g, u16* obase, int row, int lane) {
    const f32x4* xr = (const f32x4*)xrow + lane; const f32x4* gr = (const f32x4*)g + lane;
    f32x4 v[4]; float s = 0.f;
#pragma unroll
    for (int j = 0; j < 4; ++j) { v[j] = xr[64 * j]; s += (v[j].x * v[j].x + v[j].y * v[j].y) + (v[j].z * v[j].z + v[j].w * v[j].w); }
    const float r = __builtin_amdgcn_rsqf(wave_sum(s) * (1.f / D) + 1e-6f);
#pragma unroll
    for (int j = 0; j < 4; ++j) { const f32x4 gg = gr[64 * j]; u32x2 w; w.x = pk2b(v[j].x * r * gg.x, v[j].y * r * gg.y); w.y = pk2b(v[j].z * r * gg.z, v[j].w * r * gg.w); *(u32x2*)(obase + pg8::blk32(row, 4 * lane + 256 * j, D)) = w; }
}
__device__ __forceinline__ void rms_phase(const Frame& F, const float* src, const float* g, u16* dst, int rows) {
    for (int rep = 0; rep < REP_RMS; ++rep) {
    PHASE_IDS();
    for (int m = gw; m < rows; m += NGW) rms_row_h(src + (size_t)m * D, g, dst, m, lane);
    }
}


typedef float f32x8 __attribute__((ext_vector_type(8)));
typedef float f32x16 __attribute__((ext_vector_type(16)));
#define SLOAD8(dst, base, off) asm volatile("s_load_dwordx8 %0, %1, " #off : "=s"(dst) : "s"(base))
#define SLOAD16(dst, base, off) asm volatile("s_load_dwordx16 %0, %1, " #off : "=s"(dst) : "s"(base))
__device__ __forceinline__ int rsv_index(int row) { const int pm = row >> 8, R = row & 255; return ((pm * 2 + ((R >> 6) & 1)) * 16 + (R & 15)) * 8 + (R >> 7) * 4 + ((R >> 4) & 3); }
#define RS_PASS() do { KBASE(); for (int m_ = (int)blockIdx.x * (NWAVES * 64) + fresh_tid(); m_ < M; m_ += F.G * NWAVES * 64) { const f32x4* p_ = (const f32x4*)(RSQ + (size_t)m_ * 16); \
        const f32x4 a_ = p_[0], b_ = p_[1], c_ = p_[2], d_ = p_[3]; const f32x4 t_ = (a_ + b_) + (c_ + d_); \
        RSV[rsv_index(m_)] = __builtin_amdgcn_rsqf(((t_[0] + t_[1]) + (t_[2] + t_[3])) * (1.0f / 1024.0f) + 1e-6f); } } while (0)
__device__ __forceinline__ size_t za_idx(int m, int col) { return (size_t)(col >> 8) * ((size_t)M * 256) + (size_t)m * 256 + (col & 255); }


#define x_in        ((const float*)KARG(0))
#define mem_in      ((const float*)KARG(1))
#define pos_in      ((const int*)KARG(2))
#define norm_g      ((const float*)KARG(3))
#define ffn_w_in    ((const float*)KARG(4))
#define ffn_w_out   ((const float*)KARG(5))
#define mix_w_in    ((const float*)KARG(6))
#define mix_gate_b  ((const float*)KARG(7))
#define shift_mu    ((const float*)KARG(8))
#define a_w0        ((const float*)KARG(9))
#define a_w_up      ((const float*)KARG(10))
#define a_a0        ((const float*)KARG(11))
#define a_a_up      ((const float*)KARG(12))
#define a_g_up      ((const float*)KARG(13))
#define a_k_k       ((const float*)KARG(14))
#define a_k_a       ((const float*)KARG(15))
#define a_r_k       ((const float*)KARG(16))
#define a_ln        ((const float*)KARG(17))
#define b_gn        ((const float*)KARG(18))
#define w_branch_a  ((const float*)KARG(19))
#define w_branch_b  ((const float*)KARG(20))
#define mix_w_out   ((const float*)KARG(21))
#define mem_norm    ((const float*)KARG(22))
#define cross_w_q   ((const float*)KARG(23))
#define cross_w_kv  ((const float*)KARG(24))
#define cross_w_o   ((const float*)KARG(25))
#define final_norm  ((const float*)KARG(26))
#define WSP(TY, off) ((TY*)((unsigned char*)KARG(28) + (off)))
#define W_in_t  WSP(u16, WS_WB + WB_WIN)
#define W_out_t WSP(u16, WS_WB + WB_WOUT)
#define W_A_t   WSP(u16, WS_WB + WB_WA)
#define W_B_t   WSP(u16, WS_WB + WB_WBM)
#define W_G_t   WSP(u16, WS_WB + WB_WG)
#define W_LR_t  WSP(u16, WS_WB + WB_WLR)
#define P_A_t   WSP(u16, WS_WB + WB_PA)
#define P_B_t   WSP(u16, WS_WB + WB_PB)
#define W_MO_t  WSP(u16, WS_WB + WB_WMO)
#define W_Q_t   WSP(u16, WS_WB + WB_WQ)
#define W_K_t   WSP(u16, WS_WB + WB_WK)
#define W_V_t   WSP(u16, WS_WB + WB_WV)
#define W_O_t   WSP(u16, WS_WB + WB_WO)
#define MEMN    WSP(u16, WS_MEMN)
#define KM      WSP(u16, WS_KM)
#define VTM     WSP(u16, WS_VTM)
#define COS     WSP(float, WS_COS)
#define SIN     WSP(float, WS_SIN)
#define H16     WSP(u16, WS_XN)
#define YS      WSP(u16, WS_AR + AR_YS)
#define RSQ     WSP(float, WS_RSQ)
#define RSV     WSP(float, WS_CTL + 512 * 1024)
#define ZA      WSP(u16, WS_AR + AR_ZA)
#define ALR     WSP(u16, WS_AR + AR_ALR)
#define WAG     WSP(u16, WS_AR + AR_WAG)
#define YA      WSP(u16, WS_AR + AR_YA)
#define ZB      WSP(u16, WS_AR + AR_ZB)
#define YB      WSP(u16, WS_AR + AR_YB)
#define TMPA    WSP(u16, WS_AR + AR_TMPA)
#define TMPB    WSP(u16, WS_AR + AR_TMPB)
#define MRG     WSP(u16, WS_AR + AR_MRG)
#define QX      WSP(u16, WS_AR + AR_Q)
#define OX      WSP(u16, WS_AR + AR_O)
#define ACT     WSP(u16, WS_AR + AR_ACT)
#define H       ((float*)KARG(27))

__global__ void __launch_bounds__(NWAVES * 64, 2) fwd_kernel(Args args) {
    extern __shared__ __attribute__((aligned(16))) unsigned char lds_raw[];
    Frame F;
    F.lds = (LAS unsigned char*)lds_raw;
    F.G = gridDim.x;
    volatile LAS unsigned* MISC = (volatile LAS unsigned*)(F.lds + LDSCTL_OFF);
    for (int u = threadIdx.x; u < 64; u += NWAVES * 64) MISC[u] = 0u;
    __syncthreads();
    XcdBarrier bar; { KBASE(); bar = xcd_barrier_post((unsigned*)((unsigned char*)KARG(28) + WS_CTL) + CW_BAR, MISC + 8); }
#define GRID_BAR() do { for (int rb_ = 0; rb_ < REP_BAR; ++rb_) xcd_barrier(bar); } while (0)


    { KBASE();
    for (int i = blockIdx.x * (NWAVES * 64) + threadIdx.x; i < M * 32; i += F.G * NWAVES * 64) {
        const int m = i >> 5, f = i & 31;
        const double a = (double)pos_in[m] * (double)c_invfreq[f] * 0.15915494309189535;
        const float fr = (float)(a - __builtin_rint(a));
        COS[i] = __builtin_amdgcn_cosf(fr); SIN[i] = __builtin_amdgcn_sinf(fr);
    }
    }

    {
        PHASE_IDS();
        for (int mb = gw; mb < M; mb += 4 * NGW) {
            f32x4 xv[4][4];
#pragma unroll
            for (int u = 0; u < 4; ++u) { const int mr = mb + u * NGW;
#pragma unroll
                for (int j = 0; j < 4; ++j) xv[u][j] = (mr < M) ? ((const f32x4*)(x_in + (size_t)mr * D) + lane)[64 * j] : (f32x4){0.f, 0.f, 0.f, 0.f}; }
#pragma unroll
            for (int u = 0; u < 4; ++u) { const int m = mb + u * NGW;
                if (m < M) { float sq = 0.f;
#pragma unroll
                    for (int j = 0; j < 4; ++j) { const f32x4 v = xv[u][j]; sq += (v.x * v.x + v.y * v.y) + (v.z * v.z + v.w * v.w); u32x2 w; w.x = pk2b(v.x, v.y); w.y = pk2b(v.z, v.w); *(u32x2*)(H16 + pg8::blk32(m, 4 * lane + 256 * j, D)) = w; }
                    sq = wave_sum(sq);
                    if (lane < 16) RSQ[(size_t)m * 16 + lane] = (lane == 0) ? sq : 0.f; } }
        }
    }
    for (int l = 0; l < DEPTH; ++l) {
        { KBASE();
            int crot = 0;
            for (int s = 0; s < 2; ++s) {
                conv_matrix(F, ffn_w_in + ((size_t)l * 2 + s) * D * 2 * DFF, 2 * DFF, 0, D, 2 * DFF, W_in_t + (size_t)s * 5632 * 1024, 1, DFF, norm_g + ((size_t)l * 4 + 3 * s) * D, crot);
                conv_matrix(F, ffn_w_out + ((size_t)l * 2 + s) * DFF * D, D, 0, DFF, D, W_out_t + (size_t)s * 1024 * 2816, 0, 0, nullptr, crot);
            }
            const float* mw = mix_w_in + (size_t)l * D * INW;
            conv_matrix(F, mw, INW, 0, D, 1792, W_A_t, 0, 0, norm_g + ((size_t)l * 4 + 1) * D, crot);
            conv_matrix(F, mw, INW, 1792, D, 3072, W_B_t, 0, 0, norm_g + ((size_t)l * 4 + 1) * D, crot);
            conv_matrix(F, mw, INW, 4864, D, 2048, W_G_t, 1, 1024, norm_g + ((size_t)l * 4 + 1) * D, crot);
            conv_matrix(F, w_branch_a + (size_t)l * AW * D, D, 0, AW, D, P_A_t, 0, 0, nullptr, crot);
            conv_matrix(F, w_branch_b + (size_t)l * D * D, D, 0, D, D, P_B_t, 0, 0, nullptr, crot);
            conv_matrix(F, mix_w_out + (size_t)l * D * D, D, 0, D, D, W_MO_t, 0, 0, nullptr, crot);
            conv_matrix(F, cross_w_q + (size_t)l * D * D, D, 0, D, D, W_Q_t, 0, 0, norm_g + ((size_t)l * 4 + 2) * D, crot);
            conv_matrix(F, cross_w_kv + (size_t)l * D * 2 * D, 2 * D, 0, D, D, W_K_t, 0, 0, nullptr, crot);
            conv_matrix(F, cross_w_kv + (size_t)l * D * 2 * D, 2 * D, D, D, D, W_V_t, 0, 0, nullptr, crot);
            conv_matrix(F, cross_w_o + (size_t)l * D * D, D, 0, D, D, W_O_t, 0, 0, nullptr, crot);
            for (int i = blockIdx.x * (NWAVES * 64) + fresh_tid(); i < 1536 * 128; i += F.G * NWAVES * 64) {
                const int n = i >> 7, k = i & 127; float v = 0.f;
                if (n < 512) { if (k < 64) v = a_w_up[((size_t)l * 64 + k) * 512 + n]; }
                else if (n < 1024) { if (k >= 64) v = a_a_up[((size_t)l * 64 + (k - 64)) * 512 + (n - 512)]; }
                else v = a_g_up[((size_t)l * 128 + k) * 512 + (n - 1024)];
                W_LR_t[pg8::blk32(n, k, 128)] = f2b(v);
            }
            rms_phase(F, mem_in, mem_norm + (size_t)l * D, MEMN, MM);
        }
        GRID_BAR();
        {
            { KBASE(); pg8::Gemm g{H16, W_in_t, M, 2 * DFF, D}; pg8::StaticOrder S; S.init(M, 2 * DFF, F.G, (int)blockIdx.x); pg8::EpiSwiglu E{ACT, DFF, RSQ};
              for (int rep = 0; rep < REPG(0); ++rep) pg8::gemm_phase<true, true>(F.lds, g, S, E); }
            { KBASE(); pg8::Gemm g{MEMN, W_K_t, MM, D, D}; pg8::StaticOrder S; S.init(MM, D, F.G, (int)blockIdx.x); pg8::EpiStoreH<false> E{KM, D, 0, 0, nullptr};
              for (int rep = 0; rep < REPG(1); ++rep) pg8::gemm_phase<true, true>(F.lds, g, S, E); }
            { KBASE(); pg8::Gemm g{W_V_t, MEMN, D, MM, D}; pg8::StaticOrder S; S.init(D, MM, F.G, (int)((blockIdx.x + 128) % F.G)); pg8::EpiStoreH<false> E{VTM, MM, 0, 0, nullptr};
              for (int rep = 0; rep < REPG(2); ++rep) pg8::gemm_phase<true, true>(F.lds, g, S, E); }
        }
        GRID_BAR();
        { KBASE(); pg8::Gemm g{ACT, W_out_t, M, D, DFF}; pg8::StaticOrder S; S.init(M, D, F.G, (int)blockIdx.x); pg8::EpiResid E{(unsigned char*)KARG(28), 0.5f};
          pg8::gemm_phase<true, true>(F.lds, g, S, E); }
        GRID_BAR();
        { KBASE(); pg8::Gemm g{H16, W_A_t, M, 1792 + 3072, D}; pg8::StaticOrder S; S.init(M, 1792 + 3072, F.G, (int)blockIdx.x); pg8::EpiStoreH<true> E{ZA, 256, 256, (size_t)M * 256, RSQ, ZB, 3072, 7};
          for (int rep = 0; rep < REPG(3); ++rep) pg8::gemm_phase<true, true>(F.lds, g, S, E); }
        GRID_BAR();
        {
            PHASE_IDS();
            const u16* T6 = ZA + (size_t)6 * M * 256; const float* mu = shift_mu + (size_t)l * 1792 + 1536;
            const f32x4 mm = *(const f32x4*)(mu + 4 * lane);
            for (int mb = gw; mb < M; mb += 8 * NGW) {
                u32x2 zc4[8], zp4[8];
#pragma unroll
                for (int u = 0; u < 8; ++u) { const int mr = mb + u * NGW; zc4[u] = (u32x2){0u, 0u}; zp4[u] = (u32x2){0u, 0u};
                    if (mr < M) { zc4[u] = *(const u32x2*)(T6 + pg8::blk32(mr, 4 * lane, 256)); if ((mr % T) != 0) zp4[u] = *(const u32x2*)(T6 + pg8::blk32(mr - 1, 4 * lane, 256)); } }
#pragma unroll
                for (int u = 0; u < 8; ++u) { const int m = mb + u * NGW; if (m < M) {
                const int c0 = 4 * lane; const u32x2 zc = zc4[u], zp = zp4[u];
                float v[4] = {hlo(zc.x), hhi(zc.x), hlo(zc.y), hhi(zc.y)}; const float p[4] = {hlo(zp.x), hhi(zp.x), hlo(zp.y), hhi(zp.y)};
#pragma unroll
                for (int j = 0; j < 4; ++j) { float s = v[j] + (p[j] - v[j]) * mm[j];
                    if (c0 < 64) { const float e = __builtin_amdgcn_exp2f(2.88539008178f * s); s = 1.0f - 2.0f * __builtin_amdgcn_rcpf(1.0f + e); }
                    else if (c0 >= 128) s = fsigmoid(s);
                    v[j] = s; }
                u32x2 o; o.x = pk2b(v[0], v[1]); o.y = pk2b(v[2], v[3]);
                *(u32x2*)(ALR + pg8::blk32(m, c0, 256)) = o;
                } }
            }
        }
        GRID_BAR();
        {
            for (int rep = 0; rep < REP_PA; ++rep) {
                PHASE_IDS();
                const int fr_o = lane & 15, fq_o = lane >> 4;
                LAS u16* Bh = (LAS u16*)F.lds;  LAS u16* Kh = Bh + 32 * 72; LAS u16* Kt = Kh + 32 * 72; LAS u16* Rt = Kt + 32 * 72;
                LAS u16* Ktx = Rt + 32 * 72;    LAS u16* Rx = Ktx + 32 * 72;
                LAS u16* Bg = Rx + 32 * 72;     LAS u16* Vr = Bg + 32 * 72; LAS u16* Kg = Vr + 32 * 72;
                LAS u16* AbrT = Kg + 32 * 72;   LAS u16* AkkT = AbrT + 32 * 40; LAS u16* AkrT = AkkT + 32 * 40;
                LAS float* ATt = (LAS float*)(F.lds + 49152);
                LAS float* Uf = (LAS float*)(F.lds + 53760);
                LAS u16* Zh = (LAS u16*)(F.lds + 62976);
                LAS float* YL = (LAS float*)(F.lds + 68096);
                LAS u16* Sh = (LAS u16*)(F.lds + 76800);
                LAS float* Lgrp = (LAS float*)(F.lds + 86016);
                LAS float* PRE = (LAS float*)(F.lds + 88064);
                LAS float* CMl = (LAS float*)(F.lds + 92160);
                LAS float* CMIl = CMl + 128; LAS float* CEl = CMIl + 128;
                LAS u16* ALc = (LAS u16*)(F.lds + 93696);
                LAS u16* Dw = (LAS u16*)(F.lds + 110592); LAS u16* Da = Dw + 32 * 72; LAS u16* Dg = Da + 32 * 72;
                for (int bh = blockIdx.x; bh < NBATCH * 8; bh += F.G) {
                    const int b = bh >> 3, h = bh & 7, row4 = lane >> 4, tt = 4 * wave + row4, j0 = 4 * (lane & 15), col0 = 64 * h + j0;
                    const u16* zrp = ZA + (size_t)(col0 >> 8) * M * 256; const u16* zkp = zrp + (size_t)2 * M * 256; const u16* zvp = zrp + (size_t)4 * M * 256;
                    u32x2 nzr[2], nzk[2], nzv[2];
                    u32x4 nal[2];
#define PA_LOAD(cc_) do { const int t1_ = CH * (cc_) + tt; int m1_ = b * T + t1_; asm volatile("" : "+v"(m1_)); \
        const size_t zb_ = pg8::blk32(m1_, col0 & 255, 256), zp_ = (m1_ & 31) ? zb_ - 32 : zb_ - 8 * 1024 + 31 * 32;     \
        const bool ok_ = t1_ > 0; const u32x2 z0_ = {0u, 0u}; \
        nzr[0] = ok_ ? *(const u32x2*)(zrp + zp_) : z0_; nzk[0] = ok_ ? *(const u32x2*)(zkp + zp_) : z0_; nzv[0] = ok_ ? *(const u32x2*)(zvp + zp_) : z0_; \
        nzr[1] = *(const u32x2*)(zrp + zb_); nzk[1] = *(const u32x2*)(zkp + zb_); nzv[1] = *(const u32x2*)(zvp + zb_); } while (0)
#define PA_ALOAD(cc_) do { const u32x4* ap_ = (const u32x4*)(ALR + ((size_t)b * T + CH * (cc_)) * 256) + 2 * tid; nal[0] = ap_[0]; nal[1] = ap_[1]; } while (0)
#define PA_ASTORE() do { LAS u32x4* ad_ = (LAS u32x4*)(ALc + (lane >> 1) * 264 + 32 * wave + 16 * (lane & 1)); ad_[0] = nal[0]; ad_[1] = nal[1]; } while (0)
                    const int utb = wave & 1, ucb = wave >> 1;
                    h16x8 uw[2], ua[2], ug[4];
                    { const int nr = 64 * h + 16 * ucb + (lane & 15), kq8 = 8 * (lane >> 4);
#pragma unroll
                      for (int ks = 0; ks < 2; ++ks) { uw[ks] = *(const h16x8*)(W_LR_t + pg8::blk32(nr, 32 * ks + kq8, 128)); ua[ks] = *(const h16x8*)(W_LR_t + pg8::blk32(512 + nr, 64 + 32 * ks + kq8, 128)); }
#pragma unroll
                      for (int ks = 0; ks < 4; ++ks) ug[ks] = *(const h16x8*)(W_LR_t + pg8::blk32(1024 + nr, 32 * ks + kq8, 128)); }
#define PA_UPROJ() do { const LAS u16* ar_ = ALc + (16 * utb + (lane & 15)) * 264 + 8 * (lane >> 4); f32x4 dw_ = {0.f, 0.f, 0.f, 0.f}, da_ = {0.f, 0.f, 0.f, 0.f}, dg_ = {0.f, 0.f, 0.f, 0.f}; \
        _Pragma("unroll") for (int ks = 0; ks < 2; ++ks) { dw_ = MFMA16B(uw[ks], *(const LAS h16x8*)(ar_ + 32 * ks), dw_); da_ = MFMA16B(ua[ks], *(const LAS h16x8*)(ar_ + 64 + 32 * ks), da_); } \
        _Pragma("unroll") for (int ks = 0; ks < 4; ++ks) dg_ = MFMA16B(ug[ks], *(const LAS h16x8*)(ar_ + 128 + 32 * ks), dg_); \
        const int do_ = (16 * utb + (lane & 15)) * 72 + 16 * ucb + 4 * (lane >> 4); u32x2 w_; \
        w_.x = pk2(dw_[0], dw_[1]); w_.y = pk2(dw_[2], dw_[3]); *(LAS u32x2*)(Dw + do_) = w_; w_.x = pk2(da_[0], da_[1]); w_.y = pk2(da_[2], da_[3]); *(LAS u32x2*)(Da + do_) = w_; \
        w_.x = pk2(dg_[0], dg_[1]); w_.y = pk2(dg_[2], dg_[3]); *(LAS u32x2*)(Dg + do_) = w_; } while (0)
                    float lw[4], bb[4], kp[4], rr[4], vv[4], kq[4], c[4]; f32x4 cvn, ggn, cvc = {0.f, 0.f, 0.f, 0.f}, ggc = {0.f, 0.f, 0.f, 0.f};
                    const float* mu = shift_mu + (size_t)l * 1792;
                    const f32x4 mur = *(const f32x4*)(mu + col0), muk = *(const f32x4*)(mu + 512 + col0), muv = *(const f32x4*)(mu + 1024 + col0);
                    const f32x4 w0c = *(const f32x4*)(a_w0 + (size_t)l * 512 + col0), a0c = *(const f32x4*)(a_a0 + (size_t)l * 512 + col0);
                    const f32x4 kkc = *(const f32x4*)(a_k_k + (size_t)l * 512 + col0), kac = *(const f32x4*)(a_k_a + (size_t)l * 512 + col0), rkc = *(const f32x4*)(a_r_k + (size_t)l * 512 + col0);
                    const f32x4 ln0 = *(const f32x4*)(a_ln + ((size_t)l * 2 + 0) * 512 + col0), ln1 = *(const f32x4*)(a_ln + ((size_t)l * 2 + 1) * 512 + col0);
#define PA_UNPK(dst_, w_) do { dst_[0] = hlo((w_).x); dst_[1] = hhi((w_).x); dst_[2] = hlo((w_).y); dst_[3] = hhi((w_).y); } while (0)
#define PA_FIRST() do { \
        float zr0[4], zr1[4], zk0[4], zk1[4], zv0[4], zv1[4], wd_[4], ad_[4], gd_[4], kx_[4], a_[4], kk_[4]; \
        PA_UNPK(zr0, nzr[0]); PA_UNPK(zr1, nzr[1]); PA_UNPK(zk0, nzk[0]); PA_UNPK(zk1, nzk[1]); PA_UNPK(zv0, nzv[0]); PA_UNPK(zv1, nzv[1]); { const u32x2 nwd = *(const LAS u32x2*)(Dw + tt * 72 + j0), nad = *(const LAS u32x2*)(Da + tt * 72 + j0), ngd = *(const LAS u32x2*)(Dg + tt * 72 + j0); PA_UNPK(wd_, nwd); PA_UNPK(ad_, nad); PA_UNPK(gd_, ngd); } \
        float ss_ = 0.f; \
        _Pragma("unroll") for (int i = 0; i < 4; ++i) { \
            rr[i] = zr1[i] + (zr0[i] - zr1[i]) * mur[i]; kx_[i] = zk1[i] + (zk0[i] - zk1[i]) * muk[i]; vv[i] = zv1[i] + (zv0[i] - zv1[i]) * muv[i]; \
            a_[i] = fsigmoid(a0c[i] + ad_[i]); \
            lw[i] = -0.60653065971f * 1.44269504089f * fsigmoid(w0c[i] + wd_[i]);            \
            kk_[i] = kx_[i] * kkc[i]; ss_ = fmaf(kk_[i], kk_[i], ss_); } \
        const float inv_ = __builtin_amdgcn_rsqf(fmaxf(sum16(ss_), 1e-24f)); float cs_ = 0.f; \
        _Pragma("unroll") for (int i = 0; i < 4; ++i) { kq[i] = kk_[i] * inv_; bb[i] = kq[i] * a_[i]; kp[i] = kx_[i] * (1.0f + (a_[i] - 1.0f) * kac[i]); cs_ = fmaf(rr[i] * kp[i], rkc[i], cs_); } \
        cs_ = sum16(cs_); f32x4 tot_; \
        _Pragma("unroll") for (int i = 0; i < 4; ++i) { cvn[i] = cs_ * vv[i]; ggn[i] = gd_[i];       \
            const float s_ = xsum16(lw[i]), t_ = xsum32(s_), p_ = (row4 & 1) ? s_ : lw[i];            \
            c[i] = (row4 >= 2) ? p_ + (t_ - s_) : p_; tot_[i] = t_; } \
        if (lane < 16) *(LAS f32x4*)(Lgrp + wave * 64 + j0) = tot_; } while (0)
#define PA_HELPER(par_) do { float pre_ = 0.f, Lmid_ = 0.f, Lend_ = 0.f; \
        _Pragma("unroll") for (int g2 = 0; g2 < 8; ++g2) { const float x = Lgrp[g2 * 64 + lane]; if (g2 < wave) pre_ += x; if (g2 < 4) Lmid_ += x; Lend_ += x; } \
        PRE[(par_) * 512 + wave * 64 + lane] = pre_; \
        if (wave == 0) { CMl[(par_) * 64 + lane] = __builtin_amdgcn_exp2f(-Lmid_); CMIl[(par_) * 64 + lane] = __builtin_amdgcn_exp2f(Lmid_); CEl[(par_) * 64 + lane] = __builtin_amdgcn_exp2f(Lend_); } } while (0)
                    PA_LOAD(0); PA_ALOAD(0);
                    for (int e = tid; e < 64 * 72; e += NWAVES * 64) Sh[e] = 0;
                    PA_ASTORE(); LDS_BARRIER(); PA_UPROJ(); PA_ALOAD(1); LDS_BARRIER();
                    f32x4 Sreg[2] = {{0.f, 0.f, 0.f, 0.f}, {0.f, 0.f, 0.f, 0.f}};
                    PA_FIRST();
                    LDS_BARRIER();
                    PA_HELPER(0);
                    LDS_BARRIER();
                    for (int cc = 0; cc < NCH; ++cc) {
                        int fr = fr_o, fq = fq_o; asm volatile("" : "+v"(fr), "+v"(fq));
                        const int ib = wave >> 1, hb = wave & 1, par = cc & 1;
                        {
                            cvc = cvn; ggc = ggn;
                            if (cc + 1 < NCH) PA_LOAD(cc + 1);
                            const f32x4 pre4 = *(const LAS f32x4*)(PRE + par * 512 + wave * 64 + j0), cM4 = *(const LAS f32x4*)(CMl + par * 64 + j0), cMi4 = *(const LAS f32x4*)(CMIl + par * 64 + j0), cE4 = *(const LAS f32x4*)(CEl + par * 64 + j0);
                            float x1[4], x2[4], x3[4], x4[4], x5[4], x6[4], xg[4], xk[4];
#pragma unroll
                            for (int i = 0; i < 4; ++i) { const float L = pre4[i] + c[i];
                                const float e5 = __builtin_amdgcn_exp2f(L), e4 = __builtin_amdgcn_exp2f(L - lw[i]), r5 = __builtin_amdgcn_rcpf(e5);
                                const float e3 = e5 * cM4[i], e2 = e4 * cM4[i], e1 = fminf(cMi4[i] * r5, 8192.f), e6 = cE4[i] * r5;
                                x1[i] = bb[i] * e1; x2[i] = kp[i] * e1; x3[i] = kq[i] * e2; x4[i] = rr[i] * e3; x5[i] = kq[i] * e4; x6[i] = rr[i] * e5; xg[i] = bb[i] * e6; xk[i] = kp[i] * e6; }
                            const int io = tt * 72 + j0; u32x2 w;
                            w.x = pk2(x1[0], x1[1]); w.y = pk2(x1[2], x1[3]); *(LAS u32x2*)(Bh + io) = w;
                            w.x = pk2(x2[0], x2[1]); w.y = pk2(x2[2], x2[3]); *(LAS u32x2*)(Kh + io) = w;
                            w.x = pk2(x3[0], x3[1]); w.y = pk2(x3[2], x3[3]); *(LAS u32x2*)(Kt + io) = w;
                            w.x = pk2(x4[0], x4[1]); w.y = pk2(x4[2], x4[3]); *(LAS u32x2*)(Rt + io) = w;
                            w.x = pk2(x5[0], x5[1]); w.y = pk2(x5[2], x5[3]); *(LAS u32x2*)(Ktx + io) = w;
                            w.x = pk2(x6[0], x6[1]); w.y = pk2(x6[2], x6[3]); *(LAS u32x2*)(Rx + io) = w;
                            w.x = pk2(xg[0], xg[1]); w.y = pk2(xg[2], xg[3]); *(LAS u32x2*)(Bg + io) = w;
                            w.x = pk2(vv[0], vv[1]); w.y = pk2(vv[2], vv[3]); *(LAS u32x2*)(Vr + io) = w;
                            w.x = pk2(xk[0], xk[1]); w.y = pk2(xk[2], xk[3]); *(LAS u32x2*)(Kg + io) = w;
                            if (cc + 1 < NCH) { PA_ASTORE(); if (cc + 2 < NCH) PA_ALOAD(cc + 2); }
                        }
                        LDS_BARRIER();
                        f32x4 accU = {0.f, 0.f, 0.f, 0.f}, accY = {0.f, 0.f, 0.f, 0.f}, accS[2] = {{0.f, 0.f, 0.f, 0.f}, {0.f, 0.f, 0.f, 0.f}};
                        h16x8 aV;
                        {
                            const int mt = wave >> 2, sb = (wave >> 1) & 1, tb = wave & 1;
                            const LAS u16* X = mt ? Kh : Bh;
                            const h16x8 a0 = *(const LAS h16x8*)(X + (16 * sb + fr) * 72 + 8 * fq), a1 = *(const LAS h16x8*)(X + (16 * sb + fr) * 72 + 32 + 8 * fq);
                            const h16x8 k0 = *(const LAS h16x8*)(Kt + (16 * tb + fr) * 72 + 8 * fq), k1 = *(const LAS h16x8*)(Kt + (16 * tb + fr) * 72 + 32 + 8 * fq);
                            const h16x8 r0 = *(const LAS h16x8*)(Rt + (16 * tb + fr) * 72 + 8 * fq), r1 = *(const LAS h16x8*)(Rt + (16 * tb + fr) * 72 + 32 + 8 * fq);
                            const h16x8 s0 = *(const LAS h16x8*)(Sh + (16 * ib + fr) * 72 + 8 * fq), s1 = *(const LAS h16x8*)(Sh + (16 * ib + fr) * 72 + 32 + 8 * fq);
                            const h16x8 x0 = *(const LAS h16x8*)(Ktx + (16 * hb + fr) * 72 + 8 * fq), x1 = *(const LAS h16x8*)(Ktx + (16 * hb + fr) * 72 + 32 + 8 * fq);
                            const h16x8 y0 = *(const LAS h16x8*)(Rx + (16 * hb + fr) * 72 + 8 * fq), y1 = *(const LAS h16x8*)(Rx + (16 * hb + fr) * 72 + 32 + 8 * fq);
                            aV = lds_tr16(Vr, 72, 0, 16 * ib, lane);
                            const h16x8 g0 = lds_tr16(Kg, 72, 0, 16 * (2 * hb), lane), g1 = lds_tr16(Kg, 72, 0, 16 * (2 * hb + 1), lane);
                            f32x4 aK = {0.f, 0.f, 0.f, 0.f}, aR = {0.f, 0.f, 0.f, 0.f};
                            aK = MFMA16(a0, k0, aK); aK = MFMA16(a1, k1, aK); aR = MFMA16(a0, r0, aR); aR = MFMA16(a1, r1, aR);
                            accU = MFMA16(s0, x0, accU); accU = MFMA16(s1, x1, accU); accY = MFMA16(s0, y0, accY); accY = MFMA16(s1, y1, accY);
                            accS[0] = MFMA16(aV, g0, accS[0]); accS[1] = MFMA16(aV, g1, accS[1]);
                            const int t = 16 * tb + fr, s0i = 16 * sb + 4 * fq;
#pragma unroll
                            for (int rg = 0; rg < 4; ++rg) { if (s0i + rg >= t) aK[rg] = 0.f; if (s0i + rg > t) aR[rg] = 0.f; }
                            u32x2 wK, wR; wK.x = pk2(aK[0], aK[1]); wK.y = pk2(aK[2], aK[3]); wR.x = pk2(aR[0], aR[1]); wR.y = pk2(aR[2], aR[3]);
                            if (mt == 0) {
#pragma unroll
                                for (int rg = 0; rg < 4; ++rg) ATt[(s0i + rg) * 36 + t] = aK[rg];
                                *(LAS u32x2*)(AbrT + t * 40 + s0i) = wR; }
                            else { *(LAS u32x2*)(AkkT + t * 40 + s0i) = wK; *(LAS u32x2*)(AkrT + t * 40 + s0i) = wR; }
                            if (cc + 1 < NCH) PA_UPROJ();
                        }
                        LDS_BARRIER();
                        {
                            const h16x8 bK = *(const LAS h16x8*)(AkkT + (16 * hb + fr) * 40 + 8 * fq), bR = *(const LAS h16x8*)(AkrT + (16 * hb + fr) * 40 + 8 * fq);
                            accU = MFMA16(aV, bK, accU); accY = MFMA16(aV, bR, accY);
#pragma unroll
                            for (int rg = 0; rg < 4; ++rg) Uf[(16 * ib + 4 * fq + rg) * 36 + 16 * hb + fr] = accU[rg];
                        }
                        LDS_BARRIER();
                        if (wave < 4) {
                            const int ri = 16 * wave + (lane >> 2), q = lane & 3;
                            f32x2 z2[4];
#pragma unroll
                            for (int k = 0; k < 2; ++k) { const f32x4 v = *(const LAS f32x4*)(Uf + ri * 36 + 16 * k + 4 * q); z2[2 * k] = (f32x2){v[0], v[1]}; z2[2 * k + 1] = (f32x2){v[2], v[3]}; }
#pragma unroll
                            for (int sx = 0; sx < 31; ++sx) {
                                f32x4 a4[2];
#pragma unroll
                                for (int k = sx >> 4; k < 2; ++k) a4[k] = *(const LAS f32x4*)(ATt + sx * 36 + 16 * k + 4 * q);
                                const float zs = quad_bcast(z2[2 * (sx >> 4) + ((sx & 3) >> 1)][sx & 1], (sx >> 2) & 3);
                                const f32x2 nz = {-zs, -zs};
#pragma unroll
                                for (int k = sx >> 4; k < 2; ++k) { z2[2 * k] = nz * (f32x2){a4[k][0], a4[k][1]} + z2[2 * k]; z2[2 * k + 1] = nz * (f32x2){a4[k][2], a4[k][3]} + z2[2 * k + 1]; }
                            }
#pragma unroll
                            for (int k = 0; k < 2; ++k) { u32x2 w; w.x = pk2(-z2[2 * k][0], -z2[2 * k][1]); w.y = pk2(-z2[2 * k + 1][0], -z2[2 * k + 1][1]); *(LAS u32x2*)(Zh + ri * 40 + 16 * k + 4 * q) = w; }
                        }
                        if (cc + 1 < NCH) PA_FIRST();
                        LDS_BARRIER();
                        {
                            const h16x8 aZ = *(const LAS h16x8*)(Zh + (16 * ib + fr) * 40 + 8 * fq);
                            const h16x8 bA = *(const LAS h16x8*)(AbrT + (16 * hb + fr) * 40 + 8 * fq);
                            const h16x8 b0 = lds_tr16(Bg, 72, 0, 16 * (2 * hb), lane), b1 = lds_tr16(Bg, 72, 0, 16 * (2 * hb + 1), lane);
                            const float gc0 = CEl[par * 64 + 16 * (2 * hb) + fr], gc1 = CEl[par * 64 + 16 * (2 * hb + 1) + fr];
                            if (cc + 1 < NCH) PA_HELPER(par ^ 1);
                            accY = MFMA16(aZ, bA, accY); accS[0] = MFMA16(aZ, b0, accS[0]); accS[1] = MFMA16(aZ, b1, accS[1]);
                            const int i0 = 16 * ib + 4 * fq;
                            *(LAS f32x4*)(YL + (16 * hb + fr) * 68 + i0) = accY;
                            Sreg[0] = Sreg[0] * gc0 + accS[0]; Sreg[1] = Sreg[1] * gc1 + accS[1];
#pragma unroll
                            for (int rg = 0; rg < 4; ++rg) { Sh[(i0 + rg) * 72 + 16 * (2 * hb) + fr] = f2h(Sreg[0][rg]); Sh[(i0 + rg) * 72 + 16 * (2 * hb + 1) + fr] = f2h(Sreg[1][rg]); }
                        }
                        LDS_BARRIER();
                        {
                            const int t = tt, i4 = j0, colo = col0;
                            const f32x4 y4 = *(const LAS f32x4*)(YL + t * 68 + i4), cv4 = cvc, g4 = ggc;
                            const float mean = sum16((y4[0] + y4[1]) + (y4[2] + y4[3])) * (1.f / 64.f); const f32x4 d4 = y4 - mean;
                            const float rstd = __builtin_amdgcn_rsqf(sum16((d4[0] * d4[0] + d4[1] * d4[1]) + (d4[2] * d4[2] + d4[3] * d4[3])) * (1.f / 64.f) + 64e-5f);
                            const f32x4 o4 = (d4 * rstd * ln0 + ln1 + cv4) * g4;
                            u32x2 w; w.x = pk2b(o4[0], o4[1]); w.y = pk2b(o4[2], o4[3]);
                            *(u32x2*)(YA + pg8::blk32(b * T + CH * cc + t, colo, 512)) = w;
                        }
                    }
                    LDS_BARRIER();
#undef PA_LOAD
#undef PA_FIRST
#undef PA_ALOAD
#undef PA_ASTORE
#undef PA_UPROJ
#undef PA_UNPK
#undef PA_HELPER
                }
            }
            GRID_BAR();
        }
        for (int rep = 0; rep < REP_RET; ++rep) {
            PHASE_IDS();
            LAS u16* Qd = (LAS u16*)(F.lds + 0);
            LAS u16* Kd = (LAS u16*)(F.lds + 18432);
            LAS u16* RTL = (LAS u16*)(F.lds + 36864);
            LAS u16* Vr = (LAS u16*)(F.lds + 72704);
            LAS u16* PL = (LAS u16*)(F.lds + 107520);
            LAS float* GNL = (LAS float*)(F.lds + 142336);
            const int fr = lane & 15, fq = lane >> 4;
            for (int bh = blockIdx.x; bh < NBATCH * 8; bh += F.G) {
                const int b = bh >> 3, h = bh & 7;
                if (tid < 128) GNL[tid] = b_gn[(size_t)l * 1024 + 128 * h + tid];
                const float lg = __builtin_log2f(1.0f - __builtin_amdgcn_exp2f(-5.0f - (float)h));
                const float gC = __builtin_amdgcn_exp2f(128.0f * lg);
                f32x4 rt[4];
#pragma unroll
                for (int i = 0; i < 4; ++i) rt[i] = (f32x4){0.f, 0.f, 0.f, 0.f};
                u32x4 nq1, nq2, nk1, nk2, nv8[4]; f32x4 nc0, nc1, ns0, ns1;
#define RET_LOAD(n_) do { const int s_ = 16 * wave + (lane >> 2), ci_ = lane & 3;     const size_t tok_ = (size_t)b * T + 128 * (n_) + s_; const u16* zp_ = ZB + pg8::blk32((int)tok_, 64 * h + 8 * ci_, 3072); \
        nq1 = *(const u32x4*)(zp_); nq2 = *(const u32x4*)(zp_ + 1024); nk1 = *(const u32x4*)(zp_ + 16 * 1024); nk2 = *(const u32x4*)(zp_ + 17 * 1024); \
        const float* cp_ = COS + tok_ * 32 + 8 * ci_; const float* sp_ = SIN + tok_ * 32 + 8 * ci_; nc0 = *(const f32x4*)cp_; nc1 = *(const f32x4*)(cp_ + 4); ns0 = *(const f32x4*)sp_; ns1 = *(const f32x4*)(sp_ + 4); \
        const u16* vp_ = ZB + pg8::blk32((int)tok_, 1024 + 128 * h + 8 * ci_, 3072); _Pragma("unroll") for (int i = 0; i < 4; ++i) nv8[i] = *(const u32x4*)(vp_ + i * 1024); } while (0)
                RET_LOAD(0);
                for (int n = 0; n < T / 128; ++n) {
                    const int m0 = b * T + 128 * n;
                    {
                        const int s = 16 * wave + (lane >> 2), ci = lane & 3;
                        const u32x4 q1 = nq1, q2 = nq2, k1 = nk1, k2 = nk2; const f32x4 c0 = nc0, c1 = nc1, s0 = ns0, s1 = ns1;
                        u32x4 cv8[4];
#pragma unroll
                        for (int i = 0; i < 4; ++i) cv8[i] = nv8[i];
                        if (n + 1 < T / 128) RET_LOAD(n + 1);
                        const float fqs = __builtin_amdgcn_exp2f((float)(s + 1) * lg), fks = 0.125f * __builtin_amdgcn_exp2f(-(float)(s + 1) * lg);
                        float qa[8], qb[8], ka[8], kbv[8];
#pragma unroll
                        for (int j = 0; j < 8; ++j) { const float cs = (j < 4) ? c0[j & 3] : c1[j & 3], sn = (j < 4) ? s0[j & 3] : s1[j & 3];
                            const float x1 = (j & 1) ? hhi(q1[j >> 1]) : hlo(q1[j >> 1]), x2 = (j & 1) ? hhi(q2[j >> 1]) : hlo(q2[j >> 1]);
                            const float y1 = (j & 1) ? hhi(k1[j >> 1]) : hlo(k1[j >> 1]), y2 = (j & 1) ? hhi(k2[j >> 1]) : hlo(k2[j >> 1]);
                            qa[j] = (x1 * cs - x2 * sn) * fqs; qb[j] = (x1 * sn + x2 * cs) * fqs; ka[j] = (y1 * cs - y2 * sn) * fks; kbv[j] = (y1 * sn + y2 * cs) * fks; }
                        u32x4 w;
                        w.x = pk2(qa[0], qa[1]); w.y = pk2(qa[2], qa[3]); w.z = pk2(qa[4], qa[5]); w.w = pk2(qa[6], qa[7]); *(LAS u32x4*)(Qd + s * 72 + 8 * ci) = w;
                        w.x = pk2(qb[0], qb[1]); w.y = pk2(qb[2], qb[3]); w.z = pk2(qb[4], qb[5]); w.w = pk2(qb[6], qb[7]); *(LAS u32x4*)(Qd + s * 72 + 32 + 8 * ci) = w;
                        w.x = pk2(ka[0], ka[1]); w.y = pk2(ka[2], ka[3]); w.z = pk2(ka[4], ka[5]); w.w = pk2(ka[6], ka[7]); *(LAS u32x4*)(Kd + s * 72 + 8 * ci) = w;
                        w.x = pk2(kbv[0], kbv[1]); w.y = pk2(kbv[2], kbv[3]); w.z = pk2(kbv[4], kbv[5]); w.w = pk2(kbv[6], kbv[7]); *(LAS u32x4*)(Kd + s * 72 + 32 + 8 * ci) = w;
#pragma unroll
                        for (int i = 0; i < 4; ++i) *(LAS u32x4*)(Vr + s * 136 + 8 * (ci + 4 * i)) = cv8[i];
#pragma unroll
                        for (int db = 0; db < 4; ++db)
#pragma unroll
                            for (int r = 0; r < 4; ++r) RTL[(16 * wave + 4 * fq + r) * 72 + 16 * db + fr] = f2h(rt[db][r]);
                    }
                    LDS_BARRIER();
                    u32x4 g4v[4];
                    { const u16* gp_ = ZB + pg8::blk32(m0 + 16 * wave + fr, 2048 + 128 * h + 16 * (fq & 1) + 8 * (fq >> 1), 3072);
#pragma unroll
                      for (int p = 0; p < 4; ++p) g4v[p] = *(const u32x4*)(gp_ + p * 1024); }
                    {
                        const h16x8 bq0 = *(const LAS h16x8*)(Qd + (16 * wave + fr) * 72 + 8 * fq), bq1 = *(const LAS h16x8*)(Qd + (16 * wave + fr) * 72 + 32 + 8 * fq);
#pragma unroll
                        for (int sb = 0; sb < 8; ++sb) {
                            u32x2 pw = {0u, 0u};
                            if (sb <= wave) {
                                f32x4 acc = {0.f, 0.f, 0.f, 0.f};
                                const h16x8 a0 = *(const LAS h16x8*)(Kd + (16 * sb + fr) * 72 + 8 * fq), a1 = *(const LAS h16x8*)(Kd + (16 * sb + fr) * 72 + 32 + 8 * fq);
                                acc = MFMA16(a0, bq0, acc); acc = MFMA16(a1, bq1, acc);
                                const int cc = 16 * wave + fr, s0i = 16 * sb + 4 * fq;
#pragma unroll
                                for (int r = 0; r < 4; ++r) if (s0i + r > cc) acc[r] = 0.f;
                                pw.x = pk2(acc[0], acc[1]); pw.y = pk2(acc[2], acc[3]);
                            }
                            *(LAS u32x2*)(PL + (16 * wave + fr) * 136 + 16 * sb + 4 * fq) = pw;
                        }
                    }
                    asm volatile("" ::: "memory");
                    {
                        h16x8 pf[4], qf[2];
#pragma unroll
                        for (int ks = 0; ks < 4; ++ks) pf[ks] = *(const LAS h16x8*)(PL + (16 * wave + fr) * 136 + 32 * ks + 8 * fq);
#pragma unroll
                        for (int ks = 0; ks < 2; ++ks) qf[ks] = *(const LAS h16x8*)(Qd + (16 * wave + fr) * 72 + 32 * ks + 8 * fq);
                        f32x4 oacc[8];
#pragma unroll
                        for (int eb = 0; eb < 8; ++eb) { f32x4 acc = {0.f, 0.f, 0.f, 0.f};
#pragma unroll
                            for (int ks = 0; ks < 4; ++ks) { const h16x8 a = lds_tr16(Vr, 136, 32 * ks, 16 * eb, lane); acc = MFMA16(a, pf[ks], acc); }
#pragma unroll
                            for (int ks = 0; ks < 2; ++ks) { const h16x8 a = *(const LAS h16x8*)(RTL + (16 * eb + fr) * 72 + 32 * ks + 8 * fq); acc = MFMA16(a, qf[ks], acc); }
                            oacc[eb] = acc; }
                        float sm = 0.f;
#pragma unroll
                        for (int eb = 0; eb < 8; ++eb) sm += (oacc[eb][0] + oacc[eb][1]) + (oacc[eb][2] + oacc[eb][3]);
                        sm = xsum16(sm); sm = xsum32(sm);
                        const float mean = sm * (1.f / 128.f); float vs = 0.f;
#pragma unroll
                        for (int eb = 0; eb < 8; ++eb)
#pragma unroll
                            for (int r = 0; r < 4; ++r) { const float dd = oacc[eb][r] - mean; vs += dd * dd; }
                        vs = xsum16(vs); vs = xsum32(vs);
                        const float inv = __builtin_amdgcn_rsqf(vs * (1.f / 128.f) + 1e-5f);
                        const int m = m0 + 16 * wave + fr, eo = 16 * (fq & 1) + 8 * (fq >> 1);
                        u16* yp = YB + pg8::blk32(m, 128 * h + eo, 1024);
#pragma unroll
                        for (int p = 0; p < 4; ++p) {
                            f32x4 xa = oacc[2 * p], xb = oacc[2 * p + 1];
#pragma unroll
                            for (int r = 0; r < 4; ++r) { float pa_ = xa[r], pb_ = xb[r]; pair16(pa_, pb_); xa[r] = pa_; xb[r] = pb_; }
                            const int e0 = 16 * (2 * p + (fq & 1)) + 8 * (fq >> 1);
                            const u32x4 g4 = g4v[p];
                            const f32x4 gn0 = *(const LAS f32x4*)(GNL + e0), gn1 = *(const LAS f32x4*)(GNL + e0 + 4);
                            float o[8];
#pragma unroll
                            for (int r = 0; r < 4; ++r) { const float ga = (r & 1) ? hhi(g4[r >> 1]) : hlo(g4[r >> 1]), gb = (r & 1) ? hhi(g4[2 + (r >> 1)]) : hlo(g4[2 + (r >> 1)]);
                                o[r] = (xa[r] - mean) * inv * gn0[r] * fsilu(ga); o[4 + r] = (xb[r] - mean) * inv * gn1[r] * fsilu(gb); }
                            u32x4 w; w.x = pk2b(o[0], o[1]); w.y = pk2b(o[2], o[3]); w.z = pk2b(o[4], o[5]); w.w = pk2b(o[6], o[7]);
                            *(u32x4*)(yp + p * 1024) = w; }
                    }
                    {
#pragma unroll
                        for (int ks = 0; ks < 4; ++ks) { const h16x8 a = lds_tr16(Vr, 136, 32 * ks, 16 * wave, lane);
#pragma unroll
                            for (int db = 0; db < 4; ++db) { const h16x8 bb = lds_tr16(Kd, 72, 32 * ks, 16 * db, lane); rt[db] = MFMA16(a, bb, rt[db]); } }
#pragma unroll
                        for (int db = 0; db < 4; ++db) rt[db] = rt[db] * gC;
                    }
                    LDS_BARRIER();
                }
            }
        }
        #undef RET_LOAD
        GRID_BAR();
        {
            { KBASE(); pg8::Gemm g{YA, P_A_t, M, D, AW}; pg8::StaticOrder S; S.init(M, D, F.G, (int)blockIdx.x); pg8::EpiStoreH<false> E{TMPA, D, 0, 0, nullptr}; for (int rep = 0; rep < REPG(6); ++rep) pg8::gemm_phase<true, true>(F.lds, g, S, E); }
            { KBASE(); pg8::Gemm g{YB, P_B_t, M, D, D}; pg8::StaticOrder S; S.init(M, D, F.G, (int)blockIdx.x); pg8::EpiStoreH<false> E{TMPB, D, 0, 0, nullptr}; for (int rep = 0; rep < REPG(7); ++rep) pg8::gemm_phase<true, true>(F.lds, g, S, E); }
        }
        { KBASE(); pg8::Gemm g{H16, W_G_t, M, 2048, D}; pg8::PairedOrder S; S.init(M, D, F.G, (int)blockIdx.x);
          pg8::EpiGate E{mix_gate_b + (size_t)l * 2048, mix_gate_b + (size_t)l * 2048 + 1024, TMPA, TMPB, MRG, D, RSQ};
          for (int rep = 0; rep < REPG(8); ++rep) pg8::gemm_phase<true, true>(F.lds, g, S, E); }
        GRID_BAR();
        { KBASE(); pg8::Gemm g{MRG, W_MO_t, M, D, D}; pg8::StaticOrder S; S.init(M, D, F.G, (int)blockIdx.x); pg8::EpiResid E{(unsigned char*)KARG(28), 1.0f}; pg8::gemm_phase<true, true>(F.lds, g, S, E); }
        GRID_BAR();
        { KBASE(); pg8::Gemm g{H16, W_Q_t, M, D, D}; pg8::StaticOrder S; S.init(M, D, F.G, (int)blockIdx.x); pg8::EpiStoreH<true> E{QX, D, 0, 0, RSQ}; for (int rep = 0; rep < REPG(9); ++rep) pg8::gemm_phase<true, true>(F.lds, g, S, E); }
        GRID_BAR();
        for (int rep = 0; rep < REP_XATT; ++rep) {
            PHASE_IDS();
            LAS unsigned char* TB = F.lds;
            LAS u16* PL = (LAS u16*)(F.lds + 65536);
            const int fr_o = lane & 15, fq_o = lane >> 4;
            const int NU = NBATCH * 4 * 16, per = (NU + F.G - 1) / F.G;
            const unsigned vofk = (unsigned)pg8::blk32(4 * wave + (lane >> 4), 8 * ((lane & 15) ^ ((4 * wave + (lane >> 4)) & 15)), D) * 2u;
            const unsigned vofv = (unsigned)pg8::blk32(2 * wave + (lane >> 5), 8 * ((lane & 31) ^ ((2 * wave + (lane >> 5)) & 15)), MM) * 2u;
#define XA_DMA_K(buf_, hh_, kq_) do { const char* g_ = (const char*)(KM + pg8::blk32(b * MEML + 128 * (kq_), 256 * hx + 128 * (hh_), D)); \
        _Pragma("unroll") for (int i_ = 0; i_ < 4; ++i_) __builtin_amdgcn_global_load_lds((const unsigned*)(g_ + (size_t)i_ * ((D / 32) * 2048) + vofk), (LAS unsigned*)(TB + (buf_) * 32768 + (8 * i_ + wave) * 1024), 16, 0, 0); } while (0)
#define XA_DMA_V(buf_, dh_, vq_) do { const char* g_ = (const char*)(VTM + pg8::blk32(256 * hx + 128 * (dh_) + 64 * (vq_), b * MEML, MM)); \
        _Pragma("unroll") for (int i_ = 0; i_ < 4; ++i_) __builtin_amdgcn_global_load_lds((const unsigned*)(g_ + (size_t)(i_ >> 1) * ((MM / 32) * 2048) + (i_ & 1) * 1024 + vofv), (LAS unsigned*)(TB + (buf_) * 32768 + (8 * i_ + wave) * 1024), 16, 0, 0); } while (0)
#define XA_TILE_READY() do { asm volatile("s_waitcnt vmcnt(0)" ::: "memory"); __syncthreads(); } while (0)
            for (int uj = 0; uj < per;) {
                const int un = (int)blockIdx.x * per + uj; if (un >= NU) break;
                const bool two = (uj + 1 < per) && (un + 1 < NU) && (((un + 1) >> 4) == (un >> 4));
                uj += two ? 2 : 1;
                int fr = fr_o, fq = fq_o; asm volatile("" : "+v"(fr), "+v"(fq));
                const int b = un >> 6, hx = (un >> 4) & 3, qtA = un & 15, qtB = two ? qtA + 1 : qtA;
                const int mqA = b * T + qtA * 128 + 16 * wave + fr, mqB = b * T + qtB * 128 + 16 * wave + fr;
                f32x4 sA[16], sB[16];
#pragma unroll
                for (int kb2 = 0; kb2 < 16; ++kb2) { sA[kb2] = (f32x4){0.f, 0.f, 0.f, 0.f}; sB[kb2] = (f32x4){0.f, 0.f, 0.f, 0.f}; }
                __syncthreads();
                XA_DMA_K(0, 0, 0);
#pragma unroll 1
                for (int hh = 0; hh < 2; ++hh) {
                    h16x8 qfA[4], qfB[4];
                    const u16* qpa = QX + pg8::blk32(mqA, 256 * hx + 128 * hh + 8 * fq, D); const u16* qpb = QX + pg8::blk32(mqB, 256 * hx + 128 * hh + 8 * fq, D);
#pragma unroll
                    for (int k4 = 0; k4 < 4; ++k4) { qfA[k4] = *(const h16x8*)(qpa + k4 * 1024); qfB[k4] = *(const h16x8*)(qpb + k4 * 1024); }
#pragma unroll
                    for (int kq = 0; kq < 2; ++kq) {
                        XA_TILE_READY();
                        if (kq == 0) XA_DMA_K(1, hh, 1); else if (hh == 0) XA_DMA_K(0, 1, 0); else XA_DMA_V(0, 0, 0);
                        const LAS unsigned char* tb = TB + kq * 32768;
#pragma unroll
                        for (int kl = 0; kl < 8; ++kl)
#pragma unroll
                            for (int k4 = 0; k4 < 4; ++k4) { const h16x8 a = *(const LAS h16x8*)(tb + (16 * kl + fr) * 256 + 16 * ((4 * k4 + fq) ^ fr));
                                sA[8 * kq + kl] = MFMA16(a, qfA[k4], sA[8 * kq + kl]); sB[8 * kq + kl] = MFMA16(a, qfB[k4], sB[8 * kq + kl]); }
                    }
                }
                h16x8 pfA[8], pfB[8]; float isA, isB;
#define XA_SOFTMAX(sacc, pf, isum_) do { float mx = -3.0e38f; \
        _Pragma("unroll") for (int kb2 = 0; kb2 < 16; ++kb2) mx = fmaxf(mx, fmaxf(fmaxf(sacc[kb2][0], sacc[kb2][1]), fmaxf(sacc[kb2][2], sacc[kb2][3]))); \
        mx = xmax16(mx); mx = xmax32(mx); float sum = 0.f; const float sc = 0.0625f * 1.44269504089f; \
        _Pragma("unroll") for (int kb2 = 0; kb2 < 16; ++kb2) { float p[4]; \
            _Pragma("unroll") for (int r = 0; r < 4; ++r) { p[r] = __builtin_amdgcn_exp2f((sacc[kb2][r] - mx) * sc); sum += p[r]; } \
            u32x2 w; w.x = pk2(p[0], p[1]); w.y = pk2(p[2], p[3]); *(LAS u32x2*)(PL + (16 * wave + fr) * 264 + 16 * kb2 + 4 * fq) = w; } \
        sum = xsum16(sum); sum = xsum32(sum); isum_ = __builtin_amdgcn_rcpf(sum); \
        asm volatile("" ::: "memory"); \
        _Pragma("unroll") for (int ks = 0; ks < 8; ++ks) pf[ks] = *(const LAS h16x8*)(PL + (16 * wave + fr) * 264 + 32 * ks + 8 * fq); \
        asm volatile("" ::: "memory"); } while (0)
                XA_SOFTMAX(sA, pfA, isA);
                XA_SOFTMAX(sB, pfB, isB);
#undef XA_SOFTMAX
#pragma unroll 1
                for (int dh = 0; dh < 2; ++dh) {
                    u16* opa = OX + pg8::blk32(mqA, 256 * hx + 128 * dh + 16 * (fq & 1) + 8 * (fq >> 1), D); u16* opb = OX + pg8::blk32(mqB, 256 * hx + 128 * dh + 16 * (fq & 1) + 8 * (fq >> 1), D);
#pragma unroll
                    for (int vq = 0; vq < 2; ++vq) {
                        XA_TILE_READY();
                        if (vq == 0) XA_DMA_V(1, dh, 1); else if (dh == 0) XA_DMA_V(0, 1, 0);
                        const LAS unsigned char* tb = TB + vq * 32768;
#pragma unroll
                        for (int dl = 0; dl < 2; ++dl) {
                            const int dp = 2 * vq + dl;
                            f32x4 xa = {0.f, 0.f, 0.f, 0.f}, xb = {0.f, 0.f, 0.f, 0.f}, ya = {0.f, 0.f, 0.f, 0.f}, yb = {0.f, 0.f, 0.f, 0.f};
#pragma unroll
                            for (int ks = 0; ks < 8; ++ks) { const h16x8 a = *(const LAS h16x8*)(tb + (16 * (2 * dl) + fr) * 512 + 16 * ((4 * ks + fq) ^ fr)); xa = MFMA16(a, pfA[ks], xa); ya = MFMA16(a, pfB[ks], ya); }
#pragma unroll
                            for (int ks = 0; ks < 8; ++ks) { const h16x8 a = *(const LAS h16x8*)(tb + (16 * (2 * dl + 1) + fr) * 512 + 16 * ((4 * ks + fq) ^ fr)); xb = MFMA16(a, pfA[ks], xb); yb = MFMA16(a, pfB[ks], yb); }
#pragma unroll
                            for (int r = 0; r < 4; ++r) { float pa_ = xa[r], pb_ = xb[r]; pair16(pa_, pb_); xa[r] = pa_; xb[r] = pb_; float qa_ = ya[r], qb_ = yb[r]; pair16(qa_, qb_); ya[r] = qa_; yb[r] = qb_; }
                            u32x4 w; w.x = pk2b(xa[0] * isA, xa[1] * isA); w.y = pk2b(xa[2] * isA, xa[3] * isA); w.z = pk2b(xb[0] * isA, xb[1] * isA); w.w = pk2b(xb[2] * isA, xb[3] * isA);
                            *(u32x4*)(opa + dp * 1024) = w;
                            if (two) { u32x4 v; v.x = pk2b(ya[0] * isB, ya[1] * isB); v.y = pk2b(ya[2] * isB, ya[3] * isB); v.z = pk2b(yb[0] * isB, yb[1] * isB); v.w = pk2b(yb[2] * isB, yb[3] * isB);
                                *(u32x4*)(opb + dp * 1024) = v; }
                        }
                    }
                }
            }
            __syncthreads();
#undef XA_DMA_K
#undef XA_DMA_V
#undef XA_TILE_READY
        }
        GRID_BAR();
        { KBASE(); pg8::Gemm g{OX, W_O_t, M, D, D}; pg8::StaticOrder S; S.init(M, D, F.G, (int)blockIdx.x); pg8::EpiResid E{(unsigned char*)KARG(28), 1.0f}; pg8::gemm_phase<true, true>(F.lds, g, S, E); }
        GRID_BAR();
        { KBASE(); pg8::Gemm g{H16, W_in_t + (size_t)5632 * 1024, M, 2 * DFF, D}; pg8::StaticOrder S; S.init(M, 2 * DFF, F.G, (int)blockIdx.x); pg8::EpiSwiglu E{ACT, DFF, RSQ};
          for (int rep = 0; rep < REPG(10); ++rep) pg8::gemm_phase<true, true>(F.lds, g, S, E); }
        GRID_BAR();
        { KBASE(); pg8::Gemm g{ACT, W_out_t + (size_t)1024 * 2816, M, D, DFF}; pg8::StaticOrder S; S.init(M, D, F.G, (int)blockIdx.x); pg8::EpiResid E{(unsigned char*)KARG(28), 0.5f};
          pg8::gemm_phase<true, true>(F.lds, g, S, E); }
        GRID_BAR();
    }
    PHASE_IDS();
    f32x4 fg[4];
#pragma unroll
    for (int j = 0; j < 4; ++j) fg[j] = ((const f32x4*)final_norm + lane)[64 * j];
    for (int m = gw; m < M; m += 8 * NGW) {
        u32x2 w[8][4];
#pragma unroll
        for (int u = 0; u < 8; ++u) { const int mr = m + u * NGW;
#pragma unroll
            for (int j = 0; j < 4; ++j) w[u][j] = (mr < M) ? *(const u32x2*)(H16 + pg8::blk32(mr, 4 * lane + 256 * j, D)) : (u32x2){0u, 0u}; }
#pragma unroll
        for (int u = 0; u < 8; ++u) { const int mr = m + u * NGW;
            if (mr < M) {
                f32x4* xr = (f32x4*)(H + (size_t)mr * D) + lane;
                f32x4 v[4]; float ss = 0.f;
#pragma unroll
                for (int j = 0; j < 4; ++j) { v[j] = (f32x4){blo(w[u][j].x), bhi(w[u][j].x), blo(w[u][j].y), bhi(w[u][j].y)}; ss += (v[j].x * v[j].x + v[j].y * v[j].y) + (v[j].z * v[j].z + v[j].w * v[j].w); }
                const float r = __builtin_amdgcn_rsqf(wave_sum(ss) * (1.f / D) + 1e-6f);
#pragma unroll
                for (int j = 0; j < 4; ++j) xr[64 * j] = v[j] * r * fg[j];
            } }
    }
}

extern "C" void kernel_launch(void* const* d_in, const int* in_sizes, int n_in, void* d_out, int out_size, void* d_ws, size_t ws_size, hipStream_t stream) {
    static int grid = 0;
    if (grid == 0) {
        if (n_in != 27 || out_size != M * D || ws_size < WS_END) { fprintf(stderr, "kernel_launch: unexpected problem (n_in %d, out %d, ws %zu < %zu)\n", n_in, out_size, ws_size, (size_t)WS_END); grid = -1; return; }
        int dev = 0, cus = 0, per_cu = 0;
        if (hipGetDevice(&dev) != hipSuccess || hipDeviceGetAttribute(&cus, hipDeviceAttributeMultiprocessorCount, dev) != hipSuccess) { grid = -1; return; }
        if (hipFuncSetAttribute((const void*)fwd_kernel, hipFuncAttributeMaxDynamicSharedMemorySize, LDS_BYTES) != hipSuccess) { fprintf(stderr, "kernel_launch: hipFuncSetAttribute failed\n"); grid = -1; return; }
        if (hipOccupancyMaxActiveBlocksPerMultiprocessor(&per_cu, (const void*)fwd_kernel, NWAVES * 64, LDS_BYTES) != hipSuccess || per_cu < 1) { fprintf(stderr, "kernel_launch: occupancy query says %d\n", per_cu); }
        (void)hipGetLastError();
        grid = cus;
    }
    if (grid < 0) return;
    if (hipMemsetAsync((char*)d_ws + WS_CTL, 0, CTL_ZERO_BYTES, stream) != hipSuccess) return;
    Args a{};
    for (int i = 0; i < 27; ++i) a.in[i] = d_in[i];
    a.out = (float*)d_out; a.ws = (unsigned char*)d_ws; a.pad0 = 0; a.pad1 = 0;
    hipLaunchKernelGGL(fwd_kernel, dim3(grid), dim3(NWAVES * 64), LDS_BYTES, stream, a);
}
```
